# Optimizing an MI355X kernel written in HIP

```python
import math
import jax, jax.numpy as jnp
from jax import lax
import numpy as np

D_MODEL = 2048
BATCH = 8
SEQ = 4096
DEPTH = 2

HEAD_DIM = 128
GRID_W = 64
Q_BLOCK = 128
ROPE_THETA = 10000.0
EPS = 1e-6
NEG_INF = -1e30

A_HEADS = 8
A_KV_HEADS = 2
B_CONFIGS = ((128, 1), (512, 4), (2048, 16))
B_OUT_HEADS = 4
B_HEADS = B_OUT_HEADS * len(B_CONFIGS)
C_HEADS = 4
C_Q_RANK = 512
C_KV_RANK = 256
C_NOPE = 128
C_ROPE = 64
C_V = 128
D_FF = 5632

A_Q = A_HEADS * HEAD_DIM
A_KV = A_KV_HEADS * HEAD_DIM
A_IN = A_Q + 2 * A_KV
B_QKV = B_HEADS * HEAD_DIM
B_IN = 3 * B_QKV
C_IN = C_Q_RANK + C_KV_RANK + C_ROPE
W_IN = A_IN + B_IN + C_IN
A_OUT = A_HEADS * HEAD_DIM
B_OUT = B_OUT_HEADS * HEAD_DIM
C_OUT = C_HEADS * C_V
MIX_W = A_OUT + B_OUT + C_OUT

kernel_name = "hybrid_parallel_gqa_dilated_mla_macaron"


def rms_norm(x, g):
    xf = x.astype(jnp.float32)
    y = xf * lax.rsqrt(jnp.mean(xf * xf, axis=-1, keepdims=True) + EPS)
    return (y * g.astype(jnp.float32)).astype(x.dtype)


def rope(x, pos):
    half = x.shape[-1] // 2
    inv = ROPE_THETA ** (-jnp.arange(half, dtype=jnp.float32) / half)
    ang = pos.astype(jnp.float32)[:, None] * inv[None, :]
    cos = jnp.cos(ang).astype(x.dtype)
    sin = jnp.sin(ang).astype(x.dtype)
    x1, x2 = x[..., :half], x[..., half:]
    return jnp.concatenate([x1 * cos - x2 * sin, x1 * sin + x2 * cos], axis=-1)


def axial_rope(x, row, col):
    h = x.shape[-1] // 2
    return jnp.concatenate([rope(x[..., :h], row), rope(x[..., h:], col)], axis=-1)


def split_heads(x, n):
    b, s, _ = x.shape
    return x.reshape(b, s, n, -1).transpose(0, 2, 1, 3)


def merge_heads(x):
    b, n, s, d = x.shape
    return x.transpose(0, 2, 1, 3).reshape(b, s, n * d)


def swiglu(x, w_gu, w_down):
    g, u = jnp.split(x @ w_gu, 2, axis=-1)
    return (jax.nn.silu(g) * u) @ w_down


def block_attention(q, k, v, scale):
    b, hk, g, s, dq = q.shape
    nb = s // Q_BLOCK
    qb = jnp.moveaxis(q.reshape(b, hk, g, nb, Q_BLOCK, dq), 3, 0)

    def one(qi):
        sc = jnp.einsum('bkgqd,bksd->bkgqs', qi, k, preferred_element_type=jnp.float32) * scale
        p = jax.nn.softmax(sc, axis=-1)
        return jnp.einsum('bkgqs,bksd->bkgqd', p.astype(v.dtype), v)

    o = lax.map(one, qb)
    return jnp.moveaxis(o, 0, 3).reshape(b, hk, g, s, v.shape[-1])


def dilated_window_attention(q, k, v, dilation, half_span, slopes):
    b, h, s, dh = q.shape
    n = half_span
    L = s // dilation
    nbq = -(-L // n)
    Lp = nbq * n

    def to_sub(t):
        return jnp.swapaxes(t.reshape(b, h, L, dilation, dh), 2, 3)

    qs = jnp.pad(to_sub(q), ((0, 0), (0, 0), (0, 0), (0, Lp - L), (0, 0)))
    qs = qs.reshape(b, h, dilation, nbq, n, dh)

    def key_blocks(t):
        tp = jnp.pad(to_sub(t), ((0, 0), (0, 0), (0, 0), (n, Lp - L + n), (0, 0)))
        tp = tp.reshape(b, h, dilation, nbq + 2, n, dh)
        return jnp.concatenate([tp[:, :, :, :-2], tp[:, :, :, 1:-1], tp[:, :, :, 2:]], axis=4)

    kb, vb = key_blocks(k), key_blocks(v)
    qi = jnp.arange(n)[:, None]
    kc = jnp.arange(3 * n)[None, :]
    step = kc - n - qi
    kpos = (jnp.arange(nbq)[:, None, None] - 1) * n + kc[None]
    mask = (jnp.abs(step) <= n)[None] & (kpos >= 0) & (kpos < L)
    dist = (jnp.abs(step) * dilation).astype(jnp.float32)
    bias = -slopes.astype(jnp.float32)[:, None, None, None, None] * dist
    sc = jnp.einsum('bhrnqd,bhrnkd->bhrnqk', qs, kb, preferred_element_type=jnp.float32) * (dh ** -0.5) + bias
    sc = jnp.where(mask, sc, NEG_INF)
    lse = jax.nn.logsumexp(sc, axis=-1)
    p = jnp.exp(sc - lse[..., None])
    o = jnp.einsum('bhrnqk,bhrnkd->bhrnqd', p.astype(v.dtype), vb)
    o = jnp.swapaxes(o.reshape(b, h, dilation, Lp, dh)[:, :, :, :L], 2, 3).reshape(b, h, s, dh)
    lse = jnp.swapaxes(lse.reshape(b, h, dilation, Lp)[:, :, :, :L], 2, 3).reshape(b, h, s)
    return o, lse


def token_mix(h, t, row, col, w_in, a_q_norm, a_k_norm, b_q_norm, b_k_norm,
              c_q_a_norm, c_q_up, c_kv_a_norm, c_kv_up, c_q_norm, c_k_norm, out_norm, w_out):
    b, s, _ = h.shape
    z = h @ w_in
    za = z[..., :A_IN]
    zb = z[..., A_IN:A_IN + B_IN]
    zc = z[..., A_IN + B_IN:]

    qa = axial_rope(rms_norm(split_heads(za[..., :A_Q], A_HEADS), a_q_norm), row, col)
    ka = axial_rope(rms_norm(split_heads(za[..., A_Q:A_Q + A_KV], A_KV_HEADS), a_k_norm), row, col)
    va = split_heads(za[..., A_Q + A_KV:], A_KV_HEADS)
    qa = qa.reshape(b, A_KV_HEADS, A_HEADS // A_KV_HEADS, s, HEAD_DIM)
    oa = block_attention(qa, ka, va, HEAD_DIM ** -0.5)
    oa = merge_heads(oa.reshape(b, A_HEADS, s, HEAD_DIM))

    qb = rms_norm(split_heads(zb[..., :B_QKV], B_HEADS), b_q_norm)
    kb = rms_norm(split_heads(zb[..., B_QKV:2 * B_QKV], B_HEADS), b_k_norm)
    vb = split_heads(zb[..., 2 * B_QKV:], B_HEADS)
    slopes = 2.0 ** (-8.0 * jnp.arange(1, B_HEADS + 1, dtype=jnp.float32) / B_HEADS)
    outs, lses = [], []
    for g, (win, dil) in enumerate(B_CONFIGS):
        sl = slice(g * B_OUT_HEADS, (g + 1) * B_OUT_HEADS)
        o, lse = dilated_window_attention(qb[:, sl], kb[:, sl], vb[:, sl], dil, win // (2 * dil), slopes[sl])
        outs.append(o)
        lses.append(lse)
    wts = jax.nn.softmax(jnp.stack(lses), axis=0)
    ob = jnp.sum(wts[..., None] * jnp.stack(outs).astype(jnp.float32), axis=0).astype(h.dtype)
    ob = merge_heads(ob)

    cq = rms_norm(zc[..., :C_Q_RANK], c_q_a_norm) @ c_q_up
    ckv = rms_norm(zc[..., C_Q_RANK:C_Q_RANK + C_KV_RANK], c_kv_a_norm) @ c_kv_up
    k_rope = zc[..., C_Q_RANK + C_KV_RANK:]
    qc = rms_norm(split_heads(cq, C_HEADS), c_q_norm)
    kvc = split_heads(ckv, C_HEADS)
    kr = jnp.broadcast_to(k_rope[:, None], (b, C_HEADS, s, C_ROPE))
    kc = rms_norm(jnp.concatenate([kvc[..., :C_NOPE], kr], axis=-1), c_k_norm)
    vc = kvc[..., C_NOPE:]
    qc = jnp.concatenate([qc[..., :C_NOPE], rope(qc[..., C_NOPE:], t)], axis=-1)
    kc = jnp.concatenate([kc[..., :C_NOPE], rope(kc[..., C_NOPE:], t)], axis=-1)
    oc = block_attention(qc[:, :, None], kc, vc, (C_NOPE + C_ROPE) ** -0.5)
    oc = merge_heads(oc[:, :, 0])

    y = jnp.concatenate([
        rms_norm(oa, out_norm[:A_OUT]),
        rms_norm(ob, out_norm[A_OUT:A_OUT + B_OUT]),
        rms_norm(oc, out_norm[A_OUT + B_OUT:]),
    ], axis=-1)
    return y @ w_out


def setup_inputs(seed: int = 0) -> dict:
    key = jax.random.key(seed)
    ks = jax.random.split(key, 24)
    f32 = jnp.float32
    L = DEPTH

    def w(k, shape, fan_in):
        return jax.random.normal(k, shape, f32) * (fan_in ** -0.5)

    def g(k, shape):
        return 1.0 + 0.02 * jax.random.normal(k, shape, f32)

    return {
        "x": jax.random.normal(ks[0], (BATCH, SEQ, D_MODEL), f32),
        "ffn1_norm": g(ks[1], (L, D_MODEL)),
        "ffn1_w_gu": w(ks[2], (L, D_MODEL, 2 * D_FF), D_MODEL),
        "ffn1_w_down": w(ks[3], (L, D_FF, D_MODEL), D_FF),
        "mix_norm": g(ks[4], (L, D_MODEL)),
        "w_in": w(ks[5], (L, D_MODEL, W_IN), D_MODEL),
        "a_q_norm": g(ks[6], (L, HEAD_DIM)),
        "a_k_norm": g(ks[7], (L, HEAD_DIM)),
        "b_q_norm": g(ks[8], (L, HEAD_DIM)),
        "b_k_norm": g(ks[9], (L, HEAD_DIM)),
        "c_q_a_norm": g(ks[10], (L, C_Q_RANK)),
        "c_q_up": w(ks[11], (L, C_Q_RANK, C_HEADS * (C_NOPE + C_ROPE)), C_Q_RANK),
        "c_kv_a_norm": g(ks[12], (L, C_KV_RANK)),
        "c_kv_up": w(ks[13], (L, C_KV_RANK, C_HEADS * (C_NOPE + C_V)), C_KV_RANK),
        "c_q_norm": g(ks[14], (L, C_NOPE + C_ROPE)),
        "c_k_norm": g(ks[15], (L, C_NOPE + C_ROPE)),
        "out_norm": g(ks[16], (L, MIX_W)),
        "w_out": w(ks[17], (L, MIX_W, D_MODEL), MIX_W),
        "ffn2_norm": g(ks[18], (L, D_MODEL)),
        "ffn2_w_gu": w(ks[19], (L, D_MODEL, 2 * D_FF), D_MODEL),
        "ffn2_w_down": w(ks[20], (L, D_FF, D_MODEL), D_FF),
    }


def reference(x, ffn1_norm, ffn1_w_gu, ffn1_w_down, mix_norm, w_in, a_q_norm, a_k_norm,
              b_q_norm, b_k_norm, c_q_a_norm, c_q_up, c_kv_a_norm, c_kv_up, c_q_norm, c_k_norm,
              out_norm, w_out, ffn2_norm, ffn2_w_gu, ffn2_w_down):
    s = x.shape[1]
    rows = s // GRID_W
    t = jnp.arange(s, dtype=jnp.int32)
    row = jnp.repeat(jnp.arange(rows, dtype=jnp.int32), GRID_W)
    col = jnp.tile(jnp.arange(GRID_W, dtype=jnp.int32), rows)
    for l in range(DEPTH):
        x = x + 0.5 * swiglu(rms_norm(x, ffn1_norm[l]), ffn1_w_gu[l], ffn1_w_down[l])
        x = x + token_mix(rms_norm(x, mix_norm[l]), t, row, col, w_in[l], a_q_norm[l], a_k_norm[l],
                          b_q_norm[l], b_k_norm[l], c_q_a_norm[l], c_q_up[l], c_kv_a_norm[l], c_kv_up[l],
                          c_q_norm[l], c_k_norm[l], out_norm[l], w_out[l])
        x = x + 0.5 * swiglu(rms_norm(x, ffn2_norm[l]), ffn2_w_gu[l], ffn2_w_down[l])
    return x
```

```cpp
#include <hip/hip_runtime.h>
#include <hip/hip_bf16.h>
#include <hip/hip_cooperative_groups.h>
#include <cstdio>
#include <cstdint>
namespace cg = cooperative_groups;

namespace pg8 {
#define PG8_LAS __attribute__((address_space(3)))
#define PG8_GAS __attribute__((address_space(1)))
typedef unsigned short bf16_t;
typedef short bf16x8 __attribute__((ext_vector_type(8)));
typedef float f32x4 __attribute__((ext_vector_type(4)));
typedef unsigned u32x4 __attribute__((ext_vector_type(4)));
constexpr int BM = 256, BK = 64, HALF = 128, HTB = HALF * BK * 2  , STAGE_BYTES = 8 * HTB, NXCD = 8, WGM = 4;

__host__ __device__ __forceinline__ int lds_byte(int r, int c) { const int st = (r >> 4) * 2 + (c >> 5), rr = r & 15, cc = c & 31, ob = rr * 64 + cc * 2; return st * 1024 + (ob ^ (((ob >> 9) & 1) << 5)); }
__host__ __device__ __forceinline__ void stage_rc(int b, int& R, int& C) { const int st = b / 1024, sb = b % 1024, swz = sb ^ (((sb >> 9) & 1) << 5); R = (st >> 1) * 16 + swz / 64; C = (st & 1) * 32 + (swz % 64) / 2; }
__host__ __device__ __forceinline__ int perm32(int rho) { const int n = rho >> 4, i = rho & 15; return 8 * (i >> 2) + 4 * n + (i & 3); }

struct Unit { int pm, pn; };
struct Gemm { const bf16_t* A; const bf16_t* Bt; int M, N, K, lda; };

struct StaticOrder {
    int nM, nN, nwg, G, c, wgm;
    __host__ __device__ void init(int M, int N, int G_, int c_, int wgm_ = 4) { nM = M / BM; nN = N / BM; nwg = nM * nN; G = G_; c = c_; wgm = wgm_; }
    __host__ __device__ bool next(int i, Unit& u) const {
        const long L = (long)i * G + c; if (L >= nwg) return false;
        int wgid = (int)L; { const int q = nwg / NXCD, r = nwg % NXCD, xcd = wgid % NXCD, off = wgid / NXCD; wgid = (xcd < r ? xcd * (q + 1) : r * (q + 1) + (xcd - r) * q) + off; }
        const int nig = wgm * nN, gid = wgid / nig, fm = gid * wgm, gsz = (nM - fm) < wgm ? (nM - fm) : wgm;
        u.pm = fm + ((wgid % nig) % gsz); u.pn = (wgid % nig) / gsz; return true;
    }
};

__device__ __forceinline__ unsigned cvt_pk_bf16(float lo, float hi) { unsigned r; asm volatile("v_cvt_pk_bf16_f32 %0, %1, %2" : "=v"(r) : "v"(lo), "v"(hi)); return r; }

constexpr float SS_SCALE = 4194304.0f, SS_INV = 1.0f / 4194304.0f;
__device__ __forceinline__ float row_rstd(const float* ss, int row, float invn) { const unsigned long long v = *(const PG8_GAS unsigned long long*)((const unsigned long long*)ss + row); return __builtin_amdgcn_rsqf((float)v * SS_INV * invn + 1e-6f); }
constexpr int RSTD_TAB_OFF = 131072 + 1024;
struct EpiBf16 {
    static constexpr bool PERM = true;
    static constexpr bool RSTD_TAB = true;
    bf16_t* O; int ldc; const float* ss;
    __device__ __forceinline__ void operator()(const f32x4 (&acc)[2][2][4][2], const Unit& u, int wr, int wc, int fr, int fq, PG8_LAS unsigned char* lds) const {
        const int row0 = u.pm * BM + wr * 64 + fr; const int col0 = u.pn * BM + wc * 32 + 8 * fq;
        const PG8_LAS float* tab = (const PG8_LAS float*)(lds + RSTD_TAB_OFF) + wr * 64 + fr;
#pragma unroll
        for (int ai = 0; ai < 2; ++ai)
#pragma unroll
            for (int m = 0; m < 4; ++m) { const int row = row0 + ai * HALF + m * 16; bf16_t* rowp = O + (size_t)row * ldc + col0;
                const float r = ss ? tab[ai * HALF + m * 16] : 1.0f;
#pragma unroll
                for (int bj = 0; bj < 2; ++bj) { const f32x4 v0 = acc[ai][bj][m][0] * r, v1 = acc[ai][bj][m][1] * r;
                    u32x4 w; w.x = cvt_pk_bf16(v0[0], v0[1]); w.y = cvt_pk_bf16(v0[2], v0[3]); w.z = cvt_pk_bf16(v1[0], v1[1]); w.w = cvt_pk_bf16(v1[2], v1[3]);
                    *(PG8_GAS u32x4*)(rowp + bj * HALF) = w; } }
    }
};
__device__ __forceinline__ float silu_mul(float g, float u) { return g * u * __builtin_amdgcn_rcpf(1.0f + __builtin_amdgcn_exp2f(-1.4426950408889634f * g)); }
struct EpiSwiGLU {
    static constexpr bool PERM = true;
    static constexpr bool RSTD_TAB = true;
    bf16_t* H; int ldh; const float* ss;
    __device__ __forceinline__ void operator()(const f32x4 (&acc)[2][2][4][2], const Unit& u, int wr, int wc, int fr, int fq, PG8_LAS unsigned char* lds) const {
        const int row0 = u.pm * BM + wr * 64 + fr; const int col0 = u.pn * HALF + wc * 32 + 8 * fq;
        const PG8_LAS float* tab = (const PG8_LAS float*)(lds + RSTD_TAB_OFF) + wr * 64 + fr;
#pragma unroll
        for (int ai = 0; ai < 2; ++ai)
#pragma unroll
            for (int m = 0; m < 4; ++m) { const int row = row0 + ai * HALF + m * 16; bf16_t* rowp = H + (size_t)row * ldh + col0;
                const float r = tab[ai * HALF + m * 16];
                const f32x4 g0 = acc[ai][0][m][0] * r, g1 = acc[ai][0][m][1] * r, u0 = acc[ai][1][m][0] * r, u1 = acc[ai][1][m][1] * r;
                u32x4 w; w.x = cvt_pk_bf16(silu_mul(g0[0], u0[0]), silu_mul(g0[1], u0[1])); w.y = cvt_pk_bf16(silu_mul(g0[2], u0[2]), silu_mul(g0[3], u0[3]));
                w.z = cvt_pk_bf16(silu_mul(g1[0], u1[0]), silu_mul(g1[1], u1[1])); w.w = cvt_pk_bf16(silu_mul(g1[2], u1[2]), silu_mul(g1[3], u1[3]));
                *(PG8_GAS u32x4*)rowp = w; }
    }
};
template <int ALPHA2, size_t ROFF, size_t SSOFF, bool F32OUT>
struct EpiResid {
    static constexpr bool PERM = true;
    static constexpr int ldc = 2048; static constexpr float alpha = 0.5f * ALPHA2;
    static constexpr bool RSTD_TAB = false;
    float* out; unsigned char* ws;
    __device__ __forceinline__ void operator()(const f32x4 (&acc)[2][2][4][2], const Unit& u, int wr, int wc, int fr, int fq, PG8_LAS unsigned char*) const {
        const int row0 = u.pm * BM + wr * 64 + fr; const int col0 = u.pn * BM + wc * 32 + 8 * fq;
        bf16_t* R = (bf16_t*)(ws + ROFF); float* ssq = (float*)(ws + SSOFF);
#pragma unroll
        for (int ai = 0; ai < 2; ++ai) {
            u32x4 pre[4][2];
#pragma unroll
            for (int m = 0; m < 4; ++m) { const size_t off = (size_t)(row0 + ai * HALF + m * 16) * ldc + col0;
#pragma unroll
                for (int bj = 0; bj < 2; ++bj) pre[m][bj] = *(const PG8_GAS u32x4*)(R + off + bj * HALF); }
#pragma unroll
            for (int m = 0; m < 4; ++m) { const int row = row0 + ai * HALF + m * 16; const size_t off = (size_t)row * ldc + col0; float sq = 0.f;
#pragma unroll
                for (int bj = 0; bj < 2; ++bj) { const u32x4 b = pre[m][bj];
                    const f32x4 b0 = {__uint_as_float(b.x << 16), __uint_as_float(b.x & 0xffff0000u), __uint_as_float(b.y << 16), __uint_as_float(b.y & 0xffff0000u)};
                    const f32x4 b1 = {__uint_as_float(b.z << 16), __uint_as_float(b.z & 0xffff0000u), __uint_as_float(b.w << 16), __uint_as_float(b.w & 0xffff0000u)};
                    const f32x4 o0 = b0 + acc[ai][bj][m][0] * alpha, o1 = b1 + acc[ai][bj][m][1] * alpha;
                    if constexpr (F32OUT) { __builtin_nontemporal_store(o0, (PG8_GAS f32x4*)(out + off + bj * HALF)); __builtin_nontemporal_store(o1, (PG8_GAS f32x4*)(out + off + bj * HALF + 4)); }
                    u32x4 w; w.x = cvt_pk_bf16(o0[0], o0[1]); w.y = cvt_pk_bf16(o0[2], o0[3]); w.z = cvt_pk_bf16(o1[0], o1[1]); w.w = cvt_pk_bf16(o1[2], o1[3]);
                    *(PG8_GAS u32x4*)(R + off + bj * HALF) = w;
                    sq += ((o0[0] * o0[0] + o0[1] * o0[1]) + (o0[2] * o0[2] + o0[3] * o0[3])) + ((o1[0] * o1[0] + o1[1] * o1[1]) + (o1[2] * o1[2] + o1[3] * o1[3])); }
                sq += __shfl_xor(sq, 16); sq += __shfl_xor(sq, 32);
                if (fq == 0) __hip_atomic_fetch_add((PG8_GAS unsigned long long*)((unsigned long long*)ssq + row), (unsigned long long)(sq * SS_SCALE), __ATOMIC_RELAXED, __HIP_MEMORY_SCOPE_AGENT); }
        }
    }
};

template <class Epi, class Sched>
__device__ __forceinline__ void gemm_phase(PG8_LAS unsigned char* lds, const Gemm g, const Sched& S, const Epi& E) {
    int tid_ = threadIdx.x; asm volatile("" : "+v"(tid_));
    const int tid = tid_, wid = __builtin_amdgcn_readfirstlane(tid >> 6), lane = tid & 63, wr = wid >> 2, wc = wid & 3, fr = lane & 15, fq = lane >> 4;
    const int K = g.K, nt = K / BK, lda = g.lda;
    unsigned voffA[2], voffB[2];
#pragma unroll
    for (int i = 0; i < 2; ++i) { int R, C; stage_rc(tid * 16 + i * 8192, R, C); const int Rb = Epi::PERM ? ((R & ~31) + perm32(R & 31)) : R;
        voffA[i] = (unsigned)(R * lda + C) * 2u; voffB[i] = (unsigned)(Rb * K + C) * 2u; }
    const size_t kstep = (size_t)(BK * 2);
    const size_t hA = (size_t)HALF * lda * 2, hB = (size_t)HALF * K * 2;
    const size_t tA = 2 * hA, tB = 2 * hB;
    const unsigned ldsw = (unsigned)wid * 1024u;
    const int aoff = lds_byte(wr * 64 + fr, fq * 8), boff = lds_byte(wc * 32 + fr, fq * 8);
#define PG8_SA(b, h) (((b) * 2 + (h)) * HTB)
#define PG8_SB(b, h) ((4 + (b) * 2 + (h)) * HTB)
#define PG8_STAGE(bufoff, gbase, voff) do { _Pragma("unroll") for (int _i = 0; _i < 2; ++_i) \
        __builtin_amdgcn_global_load_lds((const unsigned*)((const char*)(gbase) + (voff)[_i]), (PG8_LAS unsigned*)(lds + (bufoff) + ldsw + _i * 8192), 16, 0, 0); } while (0)
#define PG8_LDA(dst, b, h) do { _Pragma("unroll") for (int m = 0; m < 4; ++m) _Pragma("unroll") for (int k = 0; k < 2; ++k) dst[m][k] = *(const PG8_LAS bf16x8*)(lds + PG8_SA(b, h) + aoff + m * 2048 + k * 1024); } while (0)
#define PG8_LDB(dst, b, h) do { _Pragma("unroll") for (int n = 0; n < 2; ++n) _Pragma("unroll") for (int k = 0; k < 2; ++k) dst[n][k] = *(const PG8_LAS bf16x8*)(lds + PG8_SB(b, h) + boff + n * 2048 + k * 1024); } while (0)
#define PG8_MMA(ai, bj, At, Bt) do { __builtin_amdgcn_s_setprio(1); _Pragma("unroll") for (int m = 0; m < 4; ++m) _Pragma("unroll") for (int n = 0; n < 2; ++n) _Pragma("unroll") for (int k = 0; k < 2; ++k) \
        acc[ai][bj][m][n] = __builtin_amdgcn_mfma_f32_16x16x32_bf16(Bt[n][k], At[m][k], acc[ai][bj][m][n], 0, 0, 0); __builtin_amdgcn_s_setprio(0); } while (0)
#define PG8_WAIT_V(n) asm volatile("s_waitcnt vmcnt(" #n ")" ::: "memory")
#define PG8_WAIT_L(n) asm volatile("s_waitcnt lgkmcnt(" #n ")" ::: "memory")
#define PG8_BAR __builtin_amdgcn_s_barrier()
#define PG8_SCHED __builtin_amdgcn_sched_barrier(0)
    Unit cur, nxt; int ui = 0;
    if (!S.next(0, cur)) return;
    int pmc = -1;
    f32x4 acc[2][2][4][2];
#pragma unroll
    for (int a = 0; a < 2; ++a)
#pragma unroll
        for (int b = 0; b < 2; ++b)
#pragma unroll
            for (int m = 0; m < 4; ++m)
#pragma unroll
                for (int n = 0; n < 2; ++n) acc[a][b][m][n] = (f32x4){0.f, 0.f, 0.f, 0.f};
    bf16x8 At[4][2], B0[2][2], B1[2][2];
    const char* cA = (const char*)g.A + (size_t)cur.pm * tA; const char* cB = (const char*)g.Bt + (size_t)cur.pn * tB;
    PG8_STAGE(PG8_SB(0, 0), cB, voffB); PG8_STAGE(PG8_SB(0, 1), cB + hB, voffB); PG8_STAGE(PG8_SA(0, 0), cA, voffA); PG8_STAGE(PG8_SA(0, 1), cA + hA, voffA);
    if (wr == 1) PG8_BAR;
    PG8_WAIT_V(2); PG8_BAR;
    PG8_STAGE(PG8_SB(1, 0), cB + kstep, voffB); PG8_STAGE(PG8_SA(1, 0), cA + kstep, voffA); PG8_STAGE(PG8_SB(1, 1), cB + hB + kstep, voffB);
    PG8_WAIT_V(6); PG8_BAR;
    for (;;) {
        const bool has_next = S.next(ui + 1, nxt);
        const char* nA = has_next ? (const char*)g.A + (size_t)nxt.pm * tA : cA; const char* nB = has_next ? (const char*)g.Bt + (size_t)nxt.pn * tB : cB;
        for (int t = 0; t < nt; t += 2) {
            const bool last = (t == nt - 2);
            const char* a1 = cA + (size_t)(t + 1) * kstep;
            const char* a2 = last ? nA : cA + (size_t)(t + 2) * kstep; const char* b2 = last ? nB : cB + (size_t)(t + 2) * kstep;
            const char* a3 = a2 + kstep; const char* b3 = b2 + kstep;
            PG8_LDB(B0, 0, 0); PG8_LDB(B1, 0, 1); PG8_SCHED; PG8_LDA(At, 0, 0); PG8_STAGE(PG8_SA(1, 1), a1 + hA, voffA);
            PG8_WAIT_V(8); PG8_WAIT_L(0); PG8_BAR; PG8_MMA(0, 0, At, B0); PG8_MMA(0, 1, At, B1); PG8_BAR; PG8_SCHED;
            PG8_LDA(At, 0, 1); PG8_STAGE(PG8_SB(0, 0), b2, voffB); PG8_STAGE(PG8_SB(0, 1), b2 + hB, voffB); PG8_STAGE(PG8_SA(0, 0), a2, voffA);
            PG8_WAIT_V(8); PG8_WAIT_L(0); PG8_BAR; PG8_MMA(1, 0, At, B0); PG8_MMA(1, 1, At, B1); PG8_BAR; PG8_SCHED;
            PG8_LDB(B0, 1, 0); PG8_LDB(B1, 1, 1); PG8_SCHED; PG8_LDA(At, 1, 0); PG8_STAGE(PG8_SA(0, 1), a2 + hA, voffA);
            PG8_WAIT_V(8); PG8_WAIT_L(0); PG8_BAR; PG8_MMA(0, 0, At, B0); PG8_MMA(0, 1, At, B1); PG8_BAR; PG8_SCHED;
            PG8_LDA(At, 1, 1); PG8_STAGE(PG8_SB(1, 0), b3, voffB); PG8_STAGE(PG8_SB(1, 1), b3 + hB, voffB); PG8_STAGE(PG8_SA(1, 0), a3, voffA);
            PG8_WAIT_V(8); PG8_WAIT_L(0); PG8_BAR; PG8_MMA(1, 0, At, B0); PG8_MMA(1, 1, At, B1); PG8_BAR; PG8_SCHED;
        }
        if (wr == 0) PG8_BAR;
        if constexpr (Epi::RSTD_TAB) {
            if (E.ss && pmc != cur.pm) { pmc = cur.pm;
                if (tid < BM) *(PG8_LAS float*)(lds + RSTD_TAB_OFF + tid * 4) = row_rstd(E.ss, cur.pm * BM + tid, 1.0f / 2048.0f);
                PG8_WAIT_L(0); PG8_BAR; } }
        E(acc, cur, wr, wc, fr, fq, lds);
        if (!has_next) break;
#pragma unroll
        for (int a = 0; a < 2; ++a)
#pragma unroll
            for (int b = 0; b < 2; ++b)
#pragma unroll
                for (int m = 0; m < 4; ++m)
#pragma unroll
                    for (int n = 0; n < 2; ++n) acc[a][b][m][n] = (f32x4){0.f, 0.f, 0.f, 0.f};
        cur = nxt; cA = nA; cB = nB; ++ui;
        if (wr == 1) PG8_BAR;
    }
    PG8_WAIT_V(0);
    PG8_BAR;
#undef PG8_SA
#undef PG8_SB
#undef PG8_STAGE
#undef PG8_LDA
#undef PG8_LDB
#undef PG8_MMA
#undef PG8_WAIT_V
#undef PG8_WAIT_L
#undef PG8_BAR
#undef PG8_SCHED
}
}

namespace att {
typedef unsigned short bf16_t;
using bf16x8 = __attribute__((ext_vector_type(8))) short;
using s16x4  = __attribute__((ext_vector_type(4))) short;
using f32x16 = __attribute__((ext_vector_type(16))) float;
using u32x4  = __attribute__((ext_vector_type(4))) unsigned;
#define SBAR() __builtin_amdgcn_sched_barrier(0)
#define AGAS __attribute__((address_space(1)))
__device__ __forceinline__ int crow(int r, int hi) { return (r & 3) + 8 * (r >> 2) + 4 * hi; }
__device__ __forceinline__ unsigned cvtpk(float lo, float hi) { unsigned r; asm volatile("v_cvt_pk_bf16_f32 %0, %1, %2" : "=v"(r) : "v"(lo), "v"(hi)); return r; }

__device__ __forceinline__ void partialSM(f32x16& p0, f32x16& p1, float& m_reg, float& mn, float& alpha, float C, float thr_raw) {
  float pmax = p0[0];
#pragma unroll
  for (int r = 1; r < 16; ++r) pmax = fmaxf(pmax, p0[r]);
#pragma unroll
  for (int r = 0; r < 16; ++r) pmax = fmaxf(pmax, p1[r]);
  { auto rr = __builtin_amdgcn_permlane32_swap(__float_as_uint(pmax), __float_as_uint(pmax), false, false);
    pmax = fmaxf(__uint_as_float(rr[0]), __uint_as_float(rr[1])); }
  if (__builtin_expect(__all(pmax - m_reg <= thr_raw), 1)) { mn = m_reg; alpha = 1.f; }
  else { mn = fmaxf(m_reg, pmax); alpha = __builtin_amdgcn_exp2f((m_reg - mn) * C); m_reg = mn; }
  float mnC = -mn * C;
#pragma unroll
  for (int r = 0; r < 16; ++r) p0[r] = fmaf(p0[r], C, mnC);
#pragma unroll
  for (int r = 0; r < 16; ++r) p1[r] = fmaf(p1[r], C, mnC);
#pragma unroll
  for (int r = 0; r < 16; ++r) p0[r] = __builtin_amdgcn_exp2f(p0[r]);
}
__device__ __forceinline__ void finishSM(f32x16& p0, f32x16& p1, float alpha, float& l_reg, bf16x8& pa0, bf16x8& pa1, bf16x8& pa2, bf16x8& pa3) {
#pragma unroll
  for (int r = 0; r < 16; ++r) p1[r] = __builtin_amdgcn_exp2f(p1[r]);
  float ps = 0;
#pragma unroll
  for (int r = 0; r < 16; ++r) ps += p0[r];
#pragma unroll
  for (int r = 0; r < 16; ++r) ps += p1[r];
  { auto rr = __builtin_amdgcn_permlane32_swap(__float_as_uint(ps), __float_as_uint(ps), false, false);
    ps = __uint_as_float(rr[0]) + __uint_as_float(rr[1]); }
  l_reg = l_reg * alpha + ps;
#define PK4(P, BASE, OUT) do { unsigned a0 = cvtpk(P[BASE + 0], P[BASE + 1]), a1 = cvtpk(P[BASE + 2], P[BASE + 3]);   \
    unsigned b0 = cvtpk(P[BASE + 4], P[BASE + 5]), b1 = cvtpk(P[BASE + 6], P[BASE + 7]);                              \
    auto r0 = __builtin_amdgcn_permlane32_swap(a0, b0, false, false); auto r1 = __builtin_amdgcn_permlane32_swap(a1, b1, false, false); \
    u32x4 w = {r0[0], r1[0], r0[1], r1[1]}; OUT = *reinterpret_cast<bf16x8*>(&w); } while (0)
  PK4(p0, 0, pa0); PK4(p0, 8, pa1); PK4(p1, 0, pa2); PK4(p1, 8, pa3);
#undef PK4
}
template <int DQK>
__device__ __forceinline__ void qkt(f32x16& p0, f32x16& p1, const char* Ks, const bf16x8* qr, int r32, int hi) {
  p0 = f32x16{}; p1 = f32x16{};
  constexpr int KST = DQK * 2, SWM = (DQK == 128) ? 15 : 7;
  const int sw = (r32 & SWM) << 4;
#pragma unroll
  for (int d0 = 0; d0 < DQK / 16; ++d0) { const int cb = (d0 * 16 + hi * 8) * 2;
    bf16x8 b0 = *reinterpret_cast<const bf16x8*>(Ks + r32 * KST + (cb ^ sw));
    bf16x8 b1 = *reinterpret_cast<const bf16x8*>(Ks + (32 + r32) * KST + (cb ^ sw));
    p0 = __builtin_amdgcn_mfma_f32_32x32x16_bf16(b0, qr[d0], p0, 0, 0, 0);
    p1 = __builtin_amdgcn_mfma_f32_32x32x16_bf16(b1, qr[d0], p1, 0, 0, 0); }
}
__device__ __forceinline__ int v_st(int k, int c) { const int kk = (k & ~0xC) | ((k & 4) << 1) | ((k & 8) >> 1); return ((kk >> 3) * 4 + (c >> 5)) * 512 + ((kk & 7) * 32 + (c & 31)) * 2; }
__device__ __forceinline__ int v_rd_base(int lane) { return ((lane & 3) << 3) | (((lane >> 2) & 3) << 6) | (((lane >> 4) & 1) << 5) | (((lane >> 5) & 1) << 8); }
constexpr int v_rd_off(int d0, int ks, int half) { return d0 * 512 + ks * 4096 + half * 2048; }
template <int OFF> __device__ __forceinline__ s16x4 tr_read(int vb) {
  s16x4 r; asm volatile("ds_read_b64_tr_b16 %0, %1 offset:%2" : "=&v"(r) : "v"(vb), "i"(OFF) : "memory"); return r;
}
template <int D0> __device__ __forceinline__ void pv_one(f32x16& od, int vb, bf16x8 pa0, bf16x8 pa1, bf16x8 pa2, bf16x8 pa3) {
  const s16x4 l0 = tr_read<v_rd_off(D0, 0, 0)>(vb), h0 = tr_read<v_rd_off(D0, 0, 1)>(vb), l1 = tr_read<v_rd_off(D0, 1, 0)>(vb), h1 = tr_read<v_rd_off(D0, 1, 1)>(vb);
  const s16x4 l2 = tr_read<v_rd_off(D0, 2, 0)>(vb), h2 = tr_read<v_rd_off(D0, 2, 1)>(vb), l3 = tr_read<v_rd_off(D0, 3, 0)>(vb), h3 = tr_read<v_rd_off(D0, 3, 1)>(vb);
  asm volatile("s_waitcnt lgkmcnt(0)" ::: "memory"); SBAR();
#define PK(L, H) (bf16x8){L[0], L[1], L[2], L[3], H[0], H[1], H[2], H[3]}
  od = __builtin_amdgcn_mfma_f32_32x32x16_bf16(pa0, PK(l0, h0), od, 0, 0, 0);
  od = __builtin_amdgcn_mfma_f32_32x32x16_bf16(pa1, PK(l1, h1), od, 0, 0, 0);
  od = __builtin_amdgcn_mfma_f32_32x32x16_bf16(pa2, PK(l2, h2), od, 0, 0, 0);
  od = __builtin_amdgcn_mfma_f32_32x32x16_bf16(pa3, PK(l3, h3), od, 0, 0, 0);
#undef PK
}
__device__ __forceinline__ void pv_d0(f32x16* o, int vb, bf16x8 pa0, bf16x8 pa1, bf16x8 pa2, bf16x8 pa3) {
  pv_one<0>(o[0], vb, pa0, pa1, pa2, pa3); pv_one<1>(o[1], vb, pa0, pa1, pa2, pa3); pv_one<2>(o[2], vb, pa0, pa1, pa2, pa3); pv_one<3>(o[3], vb, pa0, pa1, pa2, pa3);
}
constexpr float MASKV = -3.0e4f;
__device__ __forceinline__ void bandmask(f32x16& p0, f32x16& p1, int kb, int qi, int hi, float slope_raw) {
#pragma unroll
  for (int r = 0; r < 16; ++r) {
    int d0 = kb + crow(r, hi) - qi; d0 = d0 < 0 ? -d0 : d0; int d1 = kb + 32 + crow(r, hi) - qi; d1 = d1 < 0 ? -d1 : d1;
    p0[r] = d0 > 64 ? MASKV : fmaf(-slope_raw, (float)d0, p0[r]);
    p1[r] = d1 > 64 ? MASKV : fmaf(-slope_raw, (float)d1, p1[r]);
  }
}

template <int DQK, int SD, bool BAND>
__device__ __forceinline__ void attn_unit(const bf16_t* __restrict__ Qb, long ldq, const bf16_t* __restrict__ Kh, long ldk, const bf16_t* __restrict__ Vh, long ldv,
                                          bf16_t* Ob, long ldo, int kt0, int NT, float scale, int q0, float slope_raw, float* lse, long ld_lse, char* lds) {
  constexpr int ND = DQK / 16, NKC = DQK / 8, KPT = NKC / 8;
  constexpr int SHM_V = 64 * 128 * 2, SHM_K = 64 * DQK * 2;
  int tid_ = threadIdx.x; asm volatile("" : "+v"(tid_));
  const int tid = tid_, wid = tid >> 6, lane = tid & 63, r32 = lane & 31, hi = lane >> 5;
  char* V_lds = lds; char* K_lds = lds + 2 * SHM_V;
  float* ws = (float*)(lds + 2 * SHM_V + 2 * SHM_K) + wid * 64; float* li_l = ws; float* al_l = ws + 32;
  const float C = scale * 1.4426950408889634f, thr_raw = 8.f / scale;
  float m_reg = BAND ? MASKV : -1e30f, l_reg = 0; f32x16 o[4] = {}; bf16x8 qr[ND];
  const bf16_t* Qw = Qb + (long)(wid * 32 + r32) * ldq + hi * 8;
#pragma unroll
  for (int d0 = 0; d0 < ND; ++d0) qr[d0] = *(const AGAS bf16x8*)(Qw + d0 * 16);
  static_assert(DQK == 128, "pipelined body: DQK = 128");
  const int sr = tid >> 4, sc = (tid & 15) * 8, vst0 = v_st(sr, sc);
  const unsigned vgo0 = (unsigned)(sr * (int)ldv + sc) * 2u, kgo0 = (unsigned)(sr * (int)ldk + sc) * 2u;
  const int klo0 = sr * 256 + ((sc * 2) ^ ((sr & 15) << 4));
  const int vb0 = (int)(uintptr_t)V_lds + v_rd_base(lane);
  const int qi = q0 + wid * 32 + r32;
  bf16x8 vsA0, vsA1, ksA[KPT], vsB0, vsB1, ksB[KPT];
#define KLOADS(KS, k0) do { const char* kb_ = (const char*)Kh + (long)(k0) * ldk * 2; KS[0] = *(const AGAS bf16x8*)(kb_ + kgo0); KS[1] = *(const AGAS bf16x8*)(kb_ + 32 * ldk * 2 + kgo0); } while (0)
#define KWRITES(KS, b) do { *(bf16x8*)(K_lds + (b) * SHM_K + klo0) = KS[0]; *(bf16x8*)(K_lds + (b) * SHM_K + 8192 + klo0) = KS[1]; } while (0)
#define SLOAD_A(k0) do { const char* vb_ = (const char*)Vh + (long)(k0) * ldv * 2; vsA0 = *(const AGAS bf16x8*)(vb_ + vgo0); vsA1 = *(const AGAS bf16x8*)(vb_ + 32 * ldv * 2 + vgo0); KLOADS(ksA, k0); } while (0)
#define SLOAD_B(k0) do { const char* vb_ = (const char*)Vh + (long)(k0) * ldv * 2; vsB0 = *(const AGAS bf16x8*)(vb_ + vgo0); vsB1 = *(const AGAS bf16x8*)(vb_ + 32 * ldv * 2 + vgo0); KLOADS(ksB, k0); } while (0)
#define SWRITE_A(b) do { *(bf16x8*)(V_lds + (b) * SHM_V + vst0) = vsA0; *(bf16x8*)(V_lds + (b) * SHM_V + 8192 + vst0) = vsA1; KWRITES(ksA, b); } while (0)
#define SWRITE_B(b) do { *(bf16x8*)(V_lds + (b) * SHM_V + vst0) = vsB0; *(bf16x8*)(V_lds + (b) * SHM_V + 8192 + vst0) = vsB1; KWRITES(ksB, b); } while (0)
#define SLOAD_E(k0) SLOAD_A(k0)
#define SWRITE_E(b) SWRITE_A(b)
#define SLOAD_O(k0) do { if constexpr (SD == 2) { SLOAD_B(k0); } else { SLOAD_A(k0); } } while (0)
#define SWRITE_O(b) do { if constexpr (SD == 2) { SWRITE_B(b); } else { SWRITE_A(b); } } while (0)
#define SWAIT() do { if constexpr (SD == 2) { if constexpr (KPT == 2) asm volatile("s_waitcnt vmcnt(4)" ::: "memory"); else asm volatile("s_waitcnt vmcnt(5)" ::: "memory"); } else asm volatile("s_waitcnt vmcnt(0)" ::: "memory"); } while (0)
#define RESC(a) do { if (__any((a) < 1.f)) { if (hi == 0) al_l[r32] = (a); asm volatile("s_waitcnt lgkmcnt(0)" ::: "memory"); \
    _Pragma("unroll") for (int d = 0; d < 4; ++d) _Pragma("unroll") for (int r = 0; r < 16; ++r) o[d][r] *= al_l[crow(r, hi)]; } } while (0)
#define BMASK(P0, P1, t) do { if constexpr (BAND) bandmask(P0, P1, (kt0 + (t)) * 64, qi, hi, slope_raw); } while (0)
  f32x16 pA0, pA1, pB0, pB1; float mnA, mnB, alA, alB; bf16x8 pa0, pa1, pa2, pa3;
  const int kbase = kt0 * 64;
  SLOAD_E(kbase); asm volatile("s_waitcnt vmcnt(0)" ::: "memory"); SWRITE_E(0); __syncthreads();
  qkt<DQK>(pA0, pA1, K_lds, qr, r32, hi); BMASK(pA0, pA1, 0); partialSM(pA0, pA1, m_reg, mnA, alA, C, thr_raw);
  SLOAD_O(kbase + 64); if constexpr (SD == 2) { if (2 < NT) SLOAD_E(kbase + 128); }
  SWAIT(); SWRITE_O(1); __syncthreads();
  for (int j = 1; j + 1 < NT; j += 2) {
    SBAR(); qkt<DQK>(pB0, pB1, K_lds + SHM_K, qr, r32, hi); BMASK(pB0, pB1, j);
    finishSM(pA0, pA1, alA, l_reg, pa0, pa1, pa2, pa3); SBAR();
    SLOAD_O(kbase + (j + SD) * 64); SBAR();
    pv_d0(o, vb0, pa0, pa1, pa2, pa3); partialSM(pB0, pB1, m_reg, mnB, alB, C, thr_raw);
    __syncthreads(); SWAIT(); SWRITE_E(0);
    RESC(alB); __syncthreads();
    SBAR(); qkt<DQK>(pA0, pA1, K_lds, qr, r32, hi); BMASK(pA0, pA1, j + 1);
    finishSM(pB0, pB1, alB, l_reg, pa0, pa1, pa2, pa3); SBAR();
    if (SD == 1 || j + 3 < NT) SLOAD_E(kbase + (j + 1 + SD) * 64); SBAR();
    pv_d0(o, vb0 + SHM_V, pa0, pa1, pa2, pa3); partialSM(pA0, pA1, m_reg, mnA, alA, C, thr_raw);
    __syncthreads(); SWAIT(); SWRITE_O(1);
    RESC(alA); __syncthreads();
  }
  SBAR(); qkt<DQK>(pB0, pB1, K_lds + SHM_K, qr, r32, hi); BMASK(pB0, pB1, NT - 1);
  finishSM(pA0, pA1, alA, l_reg, pa0, pa1, pa2, pa3); SBAR();
  pv_d0(o, vb0, pa0, pa1, pa2, pa3); partialSM(pB0, pB1, m_reg, mnB, alB, C, thr_raw);
  __syncthreads(); RESC(alB);
  finishSM(pB0, pB1, alB, l_reg, pa0, pa1, pa2, pa3); SBAR();
  pv_d0(o, vb0 + SHM_V, pa0, pa1, pa2, pa3);
  if (hi == 0) li_l[r32] = l_reg; asm volatile("s_waitcnt lgkmcnt(0)" ::: "memory");
  if constexpr (BAND) { if (hi == 0) *(AGAS float*)(lse + (long)(wid * 32 + r32) * ld_lse) = m_reg * scale + __logf(l_reg); }
  float rli[16];
#pragma unroll
  for (int r = 0; r < 16; ++r) rli[r] = __builtin_amdgcn_rcpf(li_l[crow(r, hi)]);
  bf16_t* Ow = Ob + (long)(wid * 32) * ldo;
  {
    char* stg = lds + 2 * SHM_V + 2 * SHM_K + 2048 + wid * 4608;
#pragma unroll
    for (int h = 0; h < 2; ++h) {
#pragma unroll
      for (int r = 0; r < 16; ++r) { const int orow = crow(r, hi);
#pragma unroll
        for (int dd = 0; dd < 2; ++dd) { const float v = o[2 * h + dd][r] * rli[r]; *(bf16_t*)(stg + orow * 144 + (dd * 32 + r32) * 2) = (bf16_t)(cvtpk(v, v) & 0xffffu); } }
      asm volatile("s_waitcnt lgkmcnt(0)" ::: "memory");
#pragma unroll
      for (int i = 0; i < 4; ++i) { const int row = i * 8 + (lane >> 3), ch = lane & 7; const u32x4 v = *(const u32x4*)(stg + row * 144 + ch * 16);
        *(AGAS u32x4*)(Ow + (long)row * ldo + h * 64 + ch * 8) = v; }
      asm volatile("s_waitcnt lgkmcnt(0)" ::: "memory");
    } }
  __syncthreads();
#undef KLOADS
#undef KWRITES
#undef SLOAD_A
#undef SLOAD_B
#undef SWRITE_A
#undef SWRITE_B
#undef SLOAD_E
#undef SWRITE_E
#undef SLOAD_O
#undef SWRITE_O
#undef SWAIT
#undef RESC
#undef BMASK
}

template <int DQK, bool BAND>
__device__ __forceinline__ void attn_unit_simple(const bf16_t* __restrict__ Qb, long ldq, const bf16_t* __restrict__ Kh, long ldk, const bf16_t* __restrict__ Vh, long ldv,
                                                 bf16_t* Ob, long ldo, int kt0, int NT, float scale, int q0, float slope_raw, float* lse, long ld_lse, char* lds) {
  constexpr int ND = DQK / 16, NKC = DQK / 8, KPT = NKC / 8;
  constexpr int KST = DQK * 2, SWM = (DQK == 128) ? 15 : 7;
  constexpr int SHM_V = 64 * 128 * 2, SHM_K = 64 * KST;
  int tid_ = threadIdx.x; asm volatile("" : "+v"(tid_));
  const int tid = tid_, wid = tid >> 6, lane = tid & 63, r32 = lane & 31, hi = lane >> 5;
  char* V_lds = lds; char* K_lds = lds + 2 * SHM_V;
  float* ws = (float*)(lds + 2 * SHM_V + 2 * SHM_K) + wid * 64; float* li_l = ws; float* al_l = ws + 32;
  const float C = scale * 1.4426950408889634f, thr_raw = 8.f / scale;
  float m_reg = BAND ? MASKV : -1e30f, l_reg = 0; f32x16 o[4] = {}; bf16x8 qr[ND];
  const bf16_t* Qw = Qb + (long)(wid * 32 + r32) * ldq + hi * 8;
#pragma unroll
  for (int d0 = 0; d0 < ND; ++d0) qr[d0] = *(const AGAS bf16x8*)(Qw + d0 * 16);
  const int sr = tid >> 4, sc = (tid & 15) * 8, vst0 = v_st(sr, sc), vst1 = v_st(32 + sr, sc);
  const unsigned vgo0 = (unsigned)(sr * (int)ldv + sc) * 2u, vgo1 = vgo0 + (unsigned)(32 * (int)ldv) * 2u;
  unsigned kgo[KPT]; int klo[KPT];
#pragma unroll
  for (int i = 0; i < KPT; ++i) { const int c = tid + 512 * i, row = c / NKC, cc = c % NKC; kgo[i] = (unsigned)(row * (int)ldk + cc * 8) * 2u; klo[i] = row * KST + ((cc * 16) ^ ((row & SWM) << 4)); }
  const int vb0 = (int)(uintptr_t)V_lds + v_rd_base(lane);
  const int qi = q0 + wid * 32 + r32;
  bf16x8 vsA0, vsA1, ksA[KPT], vsB0, vsB1, ksB[KPT];
#define SLOADX(VS0, VS1, KS, t) do { const char* vb_ = (const char*)Vh + (long)(kt0 + (t)) * 64 * ldv * 2; const char* kb_ = (const char*)Kh + (long)(kt0 + (t)) * 64 * ldk * 2; \
    VS0 = *(const AGAS bf16x8*)(vb_ + vgo0); VS1 = *(const AGAS bf16x8*)(vb_ + vgo1); \
    _Pragma("unroll") for (int i_ = 0; i_ < KPT; ++i_) KS[i_] = *(const AGAS bf16x8*)(kb_ + kgo[i_]); } while (0)
#define SWRITEX(VS0, VS1, KS, b) do { *(bf16x8*)(V_lds + (b) * SHM_V + vst0) = VS0; *(bf16x8*)(V_lds + (b) * SHM_V + vst1) = VS1; \
    _Pragma("unroll") for (int i_ = 0; i_ < KPT; ++i_) *(bf16x8*)(K_lds + (b) * SHM_K + klo[i_]) = KS[i_]; } while (0)
  f32x16 p0, p1; float mn, al; bf16x8 pa0, pa1, pa2, pa3;
#define STEP(j, b) do { \
    bool active = true; \
    if constexpr (BAND) { const int kb = (kt0 + (j)) * 64, qw0 = q0 + wid * 32; active = (kb <= qw0 + 31 + 64) && (kb + 63 >= qw0 - 64); } \
    if (active) { \
      qkt<DQK>(p0, p1, K_lds + (b) * SHM_K, qr, r32, hi); \
      if constexpr (BAND) bandmask(p0, p1, (kt0 + (j)) * 64, qi, hi, slope_raw); \
      partialSM(p0, p1, m_reg, mn, al, C, thr_raw); \
      if (__any(al < 1.f)) { if (hi == 0) al_l[r32] = al; asm volatile("s_waitcnt lgkmcnt(0)" ::: "memory"); \
        _Pragma("unroll") for (int d = 0; d < 4; ++d) _Pragma("unroll") for (int r = 0; r < 16; ++r) o[d][r] *= al_l[crow(r, hi)]; } \
      finishSM(p0, p1, al, l_reg, pa0, pa1, pa2, pa3); SBAR(); \
      pv_d0(o, vb0 + (b) * SHM_V, pa0, pa1, pa2, pa3); \
    } } while (0)
  constexpr bool TWO = (DQK == 128);
  SLOADX(vsA0, vsA1, ksA, 0); SWRITEX(vsA0, vsA1, ksA, 0);
  if constexpr (TWO) {
    if (1 < NT) SLOADX(vsB0, vsB1, ksB, 1);
    for (int j = 0; j < NT; j += 2) {
      __syncthreads();
      if (j + 2 < NT) SLOADX(vsA0, vsA1, ksA, j + 2);
      STEP(j, 0);
      if (j + 1 < NT) SWRITEX(vsB0, vsB1, ksB, 1);
      if (j + 1 >= NT) break;
      __syncthreads();
      if (j + 3 < NT) SLOADX(vsB0, vsB1, ksB, j + 3);
      STEP(j + 1, 1);
      if (j + 2 < NT) SWRITEX(vsA0, vsA1, ksA, 0);
    }
  } else {
    for (int j = 0; j < NT; ++j) {
      const int b = j & 1;
      __syncthreads();
      if (j + 1 < NT) SLOADX(vsA0, vsA1, ksA, j + 1);
      STEP(j, b);
      if (j + 1 < NT) SWRITEX(vsA0, vsA1, ksA, b ^ 1);
    }
  }
  if (hi == 0) li_l[r32] = l_reg; asm volatile("s_waitcnt lgkmcnt(0)" ::: "memory");
  if constexpr (BAND) { if (hi == 0) *(AGAS float*)(lse + (long)(wid * 32 + r32) * ld_lse) = m_reg * scale + __logf(l_reg); }
  float rli[16];
#pragma unroll
  for (int r = 0; r < 16; ++r) rli[r] = __builtin_amdgcn_rcpf(li_l[crow(r, hi)]);
  bf16_t* Ow = Ob + (long)(wid * 32) * ldo;
  if constexpr (true)
  {
    char* stg = lds + 2 * SHM_V + 2 * SHM_K + 2048 + wid * 4608;
#pragma unroll
    for (int h = 0; h < 2; ++h) {
#pragma unroll
      for (int r = 0; r < 16; ++r) { const int orow = crow(r, hi);
#pragma unroll
        for (int dd = 0; dd < 2; ++dd) { const float v = o[2 * h + dd][r] * rli[r]; *(bf16_t*)(stg + orow * 144 + (dd * 32 + r32) * 2) = (bf16_t)(cvtpk(v, v) & 0xffffu); } }
      asm volatile("s_waitcnt lgkmcnt(0)" ::: "memory");
#pragma unroll
      for (int i = 0; i < 4; ++i) { const int row = i * 8 + (lane >> 3), ch = lane & 7; const u32x4 v = *(const u32x4*)(stg + row * 144 + ch * 16);
        *(AGAS u32x4*)(Ow + (long)row * ldo + h * 64 + ch * 8) = v; }
      asm volatile("s_waitcnt lgkmcnt(0)" ::: "memory");
    } }
  else {
#pragma unroll
  for (int r = 0; r < 16; ++r) { const int orow = crow(r, hi);
#pragma unroll
    for (int d0 = 0; d0 < 4; ++d0) { const float v = o[d0][r] * rli[r]; *(AGAS bf16_t*)(Ow + (long)orow * ldo + d0 * 32 + r32) = (bf16_t)(cvtpk(v, v) & 0xffffu); } }
  }
  __syncthreads();
#undef SLOADX
#undef SWRITEX
#undef STEP
}
#undef SBAR
}

#define LAS __attribute__((address_space(3)))
#define GAS __attribute__((address_space(1)))
typedef unsigned short bf16_t;
typedef float f32x4 __attribute__((ext_vector_type(4)));
typedef unsigned u32x4 __attribute__((ext_vector_type(4)));
typedef unsigned u32x2 __attribute__((ext_vector_type(2)));

constexpr int DM = 2048, NB = 8, SEQ = 4096, M = NB * SEQ, DFF = 5632, WIN_N = 6976, ZP = 7168, DEPTH = 2;
constexpr int CQR = 512, CKVR = 256, CQW = 768, CKVW = 1024;
constexpr float EPS = 1e-6f;
constexpr int NWAVES = 8;
constexpr size_t MiB = 1u << 20;
constexpr size_t WS_ROPE_A = 0;
constexpr size_t WS_ROPE_C = 64 * 1024;
constexpr size_t WS_BAR = 1152 * 1024;
constexpr size_t WS_SS = 1216 * 1024;
constexpr size_t WS_WB = 2 * MiB;
constexpr size_t WB_GU1 = 0, WB_D1 = WB_GU1 + (size_t)2 * DFF * DM * 2, WB_IN = WB_D1 + (size_t)DM * DFF * 2, WB_OUT = WB_IN + (size_t)ZP * DM * 2,
                 WB_GU2 = WB_OUT + (size_t)DM * DM * 2, WB_D2 = WB_GU2 + (size_t)2 * DFF * DM * 2, WB_CQ = WB_D2 + (size_t)DM * DFF * 2, WB_CKV = WB_CQ + (size_t)CQW * CQR * 2,
                 WB_END = WB_CKV + (size_t)CKVW * CKVR * 2;
static_assert(WB_END <= 170 * MiB, "weights");
constexpr size_t WS_XN = 172 * MiB;
constexpr size_t WS_LSE = 300 * MiB;
constexpr size_t WS_CQA = 302 * MiB;
constexpr size_t WS_CKVA = 334 * MiB;
constexpr size_t WS_CQ = 350 * MiB;
constexpr size_t WS_CKV = 398 * MiB;
constexpr size_t WS_KC = 462 * MiB;
constexpr size_t WS_Z = 510 * MiB;
constexpr size_t WS_END = WS_Z + (size_t)M * ZP * 2;
static_assert(WS_END <= 1024 * MiB, "ws");
constexpr int LDS_BYTES = 147456;

__device__ __forceinline__ float wave_sum(float v) {
#pragma unroll
  for (int o = 1; o < 64; o <<= 1) v += __shfl_xor(v, o);
  return v;
}
__device__ __forceinline__ float bf2f(unsigned h) { return __uint_as_float(h << 16); }
__device__ __forceinline__ unsigned pk2(float lo, float hi) { return pg8::cvt_pk_bf16(lo, hi); }
__device__ __forceinline__ void unpack8(u32x4 w, float* x) {
  x[0] = __uint_as_float(w.x << 16); x[1] = __uint_as_float(w.x & 0xffff0000u); x[2] = __uint_as_float(w.y << 16); x[3] = __uint_as_float(w.y & 0xffff0000u);
  x[4] = __uint_as_float(w.z << 16); x[5] = __uint_as_float(w.z & 0xffff0000u); x[6] = __uint_as_float(w.w << 16); x[7] = __uint_as_float(w.w & 0xffff0000u);
}
__device__ __forceinline__ u32x4 pack8(const float* x) { u32x4 w; w.x = pk2(x[0], x[1]); w.y = pk2(x[2], x[3]); w.z = pk2(x[4], x[5]); w.w = pk2(x[6], x[7]); return w; }

__device__ __forceinline__ int dest_row(int n0, int mode) {
  if (mode == 0) return n0;
  return n0 < DFF ? 256 * (n0 / 128) + (n0 % 128) : 256 * ((n0 - DFF) / 128) + 128 + ((n0 - DFF) % 128);
}
__device__ __forceinline__ void transpose_item(const float* W, int K, int N, bf16_t* WT, int mode, const float* gain, LAS float* scr, int item, int lane) {
  const int nblk = N / 32, kb = item / nblk, nb = item % nblk, k0 = 64 * kb, n0 = 32 * nb;
  const int dr0 = dest_row(n0, mode);
#pragma unroll 16
  for (int i = 0; i < 32; ++i) { const int kk = 2 * i + (lane >> 5); scr[kk * 33 + (lane & 31)] = *(const GAS float*)(W + (size_t)(k0 + kk) * N + n0 + (lane & 31)); }
  asm volatile("s_waitcnt lgkmcnt(0)" ::: "memory");
  const int c = lane & 7;
  f32x4 ga = (f32x4){1.f, 1.f, 1.f, 1.f}, gb = ga;
  if (gain) { ga = *(const GAS f32x4*)(gain + k0 + 8 * c); gb = *(const GAS f32x4*)(gain + k0 + 8 * c + 4); }
#pragma unroll
  for (int j = 0; j < 4; ++j) { const int n = (lane >> 3) + 8 * j; const LAS float* s = scr + (8 * c) * 33 + n;
    u32x4 o; o.x = pk2(s[0 * 33] * ga.x, s[1 * 33] * ga.y); o.y = pk2(s[2 * 33] * ga.z, s[3 * 33] * ga.w); o.z = pk2(s[4 * 33] * gb.x, s[5 * 33] * gb.y); o.w = pk2(s[6 * 33] * gb.z, s[7 * 33] * gb.w);
    *(GAS u32x4*)(WT + (size_t)(dr0 + n) * K + k0 + 8 * c) = o; }
  asm volatile("s_waitcnt lgkmcnt(0)" ::: "memory");
}

struct Args { const float* in[21]; float* out; unsigned char* ws; };
template <class T> __device__ __forceinline__ T* asglobal(T* p) { return (T*)(__attribute__((address_space(1))) T*)p; }
constexpr int LDS_PTAB = 131072;
struct PT {
  LAS const unsigned long long* t; float* out; unsigned char* ws;
  __device__ __forceinline__ const float* in(int k) const { const unsigned long long v = t[k];
    const unsigned lo = __builtin_amdgcn_readfirstlane((unsigned)v), hi = __builtin_amdgcn_readfirstlane((unsigned)(v >> 32));
    return asglobal((const float*)(((unsigned long long)hi << 32) | lo)); }
};

__device__ __forceinline__ void norm_rows(const float* X, const float* g, bf16_t* out, int gw, int NGW, int lane) {
  asm volatile("" : "+v"(lane));
  f32x4 gv[8];
#pragma unroll
  for (int j = 0; j < 8; ++j) gv[j] = ((const GAS f32x4*)g)[lane + 64 * j];
  for (int m = gw; m < M; m += NGW) {
    const GAS f32x4* xr = (const GAS f32x4*)(X + (size_t)m * DM) + lane;
    f32x4 v[8]; float s = 0.f;
#pragma unroll
    for (int j = 0; j < 8; ++j) { v[j] = xr[64 * j]; s += (v[j].x * v[j].x + v[j].y * v[j].y) + (v[j].z * v[j].z + v[j].w * v[j].w); }
    const float r = rsqrtf(wave_sum(s) * (1.f / DM) + EPS);
    GAS u32x2* o = (GAS u32x2*)(out + (size_t)m * DM) + lane;
#pragma unroll
    for (int j = 0; j < 8; ++j) { u32x2 w; w.x = pk2(v[j].x * r * gv[j].x, v[j].y * r * gv[j].y); w.y = pk2(v[j].z * r * gv[j].z, v[j].w * r * gv[j].w); o[64 * j] = w; }
  }
}

__device__ __forceinline__ void xb_init_rows(const float* X, bf16_t* xb, float* ss, int rb0, int lw, int nlw, int lane)     {
  asm volatile("" : "+v"(lane));
  for (int m = rb0 + lw; m < rb0 + SEQ; m += nlw) {
    const GAS f32x4* xr = (const GAS f32x4*)(X + (size_t)m * DM) + lane;
    f32x4 v[8]; float s = 0.f;
#pragma unroll
    for (int j = 0; j < 8; ++j) { v[j] = xr[64 * j]; s += (v[j].x * v[j].x + v[j].y * v[j].y) + (v[j].z * v[j].z + v[j].w * v[j].w); }
    s = wave_sum(s);
    GAS u32x2* o = (GAS u32x2*)(xb + (size_t)m * DM) + lane;
#pragma unroll
    for (int j = 0; j < 8; ++j) { u32x2 w; w.x = pk2(v[j].x, v[j].y); w.y = pk2(v[j].z, v[j].w); o[64 * j] = w; }
    if (lane == 0) *(GAS unsigned long long*)((unsigned long long*)ss + m) = (unsigned long long)(s * pg8::SS_SCALE);
  }
}
__device__ __forceinline__ void zero_f32(float* p, int n, int gtid, int nthreads) { for (int i = gtid; i < n; i += nthreads) *(GAS float*)(p + i) = 0.f; }

__device__ __forceinline__ void convert_weights(const PT& a, int l, LAS unsigned char* lds, int gw, int NGW, int wave, int lane) {
  asm volatile("" : "+v"(lane));
  LAS float* scr = (LAS float*)(lds + wave * 16384);
  unsigned char* wb = a.ws + WS_WB;
  const int I_GU = (DM / 64) * (2 * DFF / 32), I_D = (DFF / 64) * (DM / 32), I_IN = (DM / 64) * (WIN_N / 32), I_OUT = (DM / 64) * (DM / 32),
            I_CQ = (CQR / 64) * (CQW / 32), I_CKV = (CKVR / 64) * (CKVW / 32);
  const int NIT = 2 * I_GU + 2 * I_D + I_IN + I_OUT + I_CQ + I_CKV;
  for (int it = gw; it < NIT; it += NGW) {
    int r = it;
    if (r < I_GU) { transpose_item(a.in(2) + (size_t)l * DM * 2 * DFF, DM, 2 * DFF, (bf16_t*)(wb + WB_GU1), 1, a.in(1) + l * DM, scr, r, lane); continue; } r -= I_GU;
    if (r < I_GU) { transpose_item(a.in(19) + (size_t)l * DM * 2 * DFF, DM, 2 * DFF, (bf16_t*)(wb + WB_GU2), 1, a.in(18) + l * DM, scr, r, lane); continue; } r -= I_GU;
    if (r < I_D) { transpose_item(a.in(3) + (size_t)l * DFF * DM, DFF, DM, (bf16_t*)(wb + WB_D1), 0, nullptr, scr, r, lane); continue; } r -= I_D;
    if (r < I_D) { transpose_item(a.in(20) + (size_t)l * DFF * DM, DFF, DM, (bf16_t*)(wb + WB_D2), 0, nullptr, scr, r, lane); continue; } r -= I_D;
    if (r < I_IN) { transpose_item(a.in(5) + (size_t)l * DM * WIN_N, DM, WIN_N, (bf16_t*)(wb + WB_IN), 0, a.in(4) + l * DM, scr, r, lane); continue; } r -= I_IN;
    if (r < I_OUT) { transpose_item(a.in(17) + (size_t)l * DM * DM, DM, DM, (bf16_t*)(wb + WB_OUT), 0, nullptr, scr, r, lane); continue; } r -= I_OUT;
    if (r < I_CQ) { transpose_item(a.in(11) + (size_t)l * CQR * CQW, CQR, CQW, (bf16_t*)(wb + WB_CQ), 0, nullptr, scr, r, lane); continue; } r -= I_CQ;
    transpose_item(a.in(13) + (size_t)l * CKVR * CKVW, CKVR, CKVW, (bf16_t*)(wb + WB_CKV), 0, nullptr, scr, r, lane);
  }
  GAS u32x4* pad = (GAS u32x4*)(wb + WB_IN + (size_t)WIN_N * DM * 2);
  for (int i = gw * 64 + lane; i < (ZP - WIN_N) * DM * 2 / 16; i += NGW * 64) pad[i] = (u32x4){0u, 0u, 0u, 0u};
}

__device__ __forceinline__ void rope_tables(unsigned char* ws, int gtid, int nthreads) {
  GAS float* ta = (GAS float*)(ws + WS_ROPE_A); GAS float* tc = (GAS float*)(ws + WS_ROPE_C);
  for (int i = gtid; i < SEQ * 32; i += nthreads) {
    const int pos = i >> 5, f = i & 31;
    const float inv = powf(10000.0f, -(float)f / 32.0f);
    const float ang = (float)pos * inv;
    const float c = cosf(ang), s = sinf(ang);
    tc[i] = c; tc[SEQ * 32 + i] = s;
    if (pos < 64) { ta[i] = c; ta[64 * 32 + i] = s; }
  }
}

__device__ __forceinline__ void ld8f(const float* p, float* g) { const f32x4 g0 = *(const GAS f32x4*)p, g1 = *(const GAS f32x4*)(p + 4);
  g[0] = g0.x; g[1] = g0.y; g[2] = g0.z; g[3] = g0.w; g[4] = g1.x; g[5] = g1.y; g[6] = g1.z; g[7] = g1.w; }
__device__ __forceinline__ void prep_rows(const PT& a, int l, int rb0, int lw, int nlw, int lane)     {
  asm volatile("" : "+v"(lane));
  bf16_t* Z = (bf16_t*)(a.ws + WS_Z); bf16_t* CQA = (bf16_t*)(a.ws + WS_CQA); bf16_t* CKVA = (bf16_t*)(a.ws + WS_CKVA);
  const float* ta = (const float*)(a.ws + WS_ROPE_A);
  const int j = lane & 15, hq = lane >> 4;
  float gaq[8], gak[8], gbq[8], gbk[8], gcq[8];
  ld8f(a.in(6) + l * 128 + 8 * j, gaq); ld8f(a.in(7) + l * 128 + 8 * j, gak); ld8f(a.in(8) + l * 128 + 8 * j, gbq); ld8f(a.in(9) + l * 128 + 8 * j, gbk);
  ld8f(a.in(10) + l * CQR + 8 * lane, gcq);
  const f32x4 gckv = *(const GAS f32x4*)(a.in(12) + l * CKVR + 4 * lane);
  constexpr int RR = 1;
  for (int m0 = rb0 + lw * RR; m0 < rb0 + SEQ; m0 += nlw * RR) {
    u32x4 raw[RR][9], rawq[RR]; u32x2 rawkv[RR]; f32x4 tcs[RR][4];
#pragma unroll
    for (int rr = 0; rr < RR; ++rr) { const int m = m0 + rr; const bf16_t* zr = Z + (size_t)m * ZP; const int t = m % SEQ, prow = t >> 6, pcol = t & 63;
#pragma unroll
      for (int it = 0; it < 9; ++it) { int hh = it * 4 + hq; hh = hh < 34 ? hh : 33; const int col = hh < 10 ? hh * 128 : 1536 + (hh - 10) * 128; raw[rr][it] = *(const GAS u32x4*)(zr + col + 8 * j); }
      rawq[rr] = *(const GAS u32x4*)(zr + 6144 + 8 * lane); rawkv[rr] = *(const GAS u32x2*)(zr + 6656 + 4 * lane);
      const int pos = (j < 8) ? prow : pcol; const int fi = 8 * (j & 3);
      tcs[rr][0] = *(const GAS f32x4*)(ta + pos * 32 + fi); tcs[rr][1] = *(const GAS f32x4*)(ta + pos * 32 + fi + 4);
      tcs[rr][2] = *(const GAS f32x4*)(ta + 2048 + pos * 32 + fi); tcs[rr][3] = *(const GAS f32x4*)(ta + 2048 + pos * 32 + fi + 4); }
#pragma unroll
    for (int rr = 0; rr < RR; ++rr) { const int m = m0 + rr; bf16_t* zr = Z + (size_t)m * ZP;
#pragma unroll
      for (int it = 0; it < 9; ++it) {
        const int hh = it * 4 + hq; const bool act = hh < 34; const bool isA = hh < 10; const int hb = hh - 10;
        const int col = isA ? hh * 128 : 1536 + hb * 128;
        float x[8]; unpack8(raw[rr][it], x);
        float ss = 0.f;
#pragma unroll
        for (int e = 0; e < 8; ++e) ss += x[e] * x[e];
        ss += __shfl_xor(ss, 1); ss += __shfl_xor(ss, 2); ss += __shfl_xor(ss, 4); ss += __shfl_xor(ss, 8);
        const float r = rsqrtf(ss * (1.f / 128.f) + EPS);
        float y[8];
#pragma unroll
        for (int e = 0; e < 8; ++e) { const float g = isA ? (hh < 8 ? gaq[e] : gak[e]) : (hb < 12 ? gbq[e] : gbk[e]); y[e] = x[e] * r * g; }
        if (it < 3) {
          float xp[8];
#pragma unroll
          for (int e = 0; e < 8; ++e) xp[e] = __shfl_xor(y[e], 4);
          if (isA) {
            const float cs[8] = {tcs[rr][0].x, tcs[rr][0].y, tcs[rr][0].z, tcs[rr][0].w, tcs[rr][1].x, tcs[rr][1].y, tcs[rr][1].z, tcs[rr][1].w};
            const float sn[8] = {tcs[rr][2].x, tcs[rr][2].y, tcs[rr][2].z, tcs[rr][2].w, tcs[rr][3].x, tcs[rr][3].y, tcs[rr][3].z, tcs[rr][3].w};
            const bool first = (j & 4) == 0;
#pragma unroll
            for (int e = 0; e < 8; ++e) y[e] = first ? (y[e] * cs[e] - xp[e] * sn[e]) : (xp[e] * sn[e] + y[e] * cs[e]);
          }
        }
        if (act) *(GAS u32x4*)(zr + col + 8 * j) = pack8(y);
      }
      { float x[8]; unpack8(rawq[rr], x); float ss = 0.f;
#pragma unroll
        for (int e = 0; e < 8; ++e) ss += x[e] * x[e];
        const float r = rsqrtf(wave_sum(ss) * (1.f / CQR) + EPS);
        float y[8];
#pragma unroll
        for (int e = 0; e < 8; ++e) y[e] = x[e] * r * gcq[e];
        *(GAS u32x4*)(CQA + (size_t)m * CQR + 8 * lane) = pack8(y); }
      { const u32x2 w = rawkv[rr];
        const float x0 = __uint_as_float(w.x << 16), x1 = __uint_as_float(w.x & 0xffff0000u), x2 = __uint_as_float(w.y << 16), x3 = __uint_as_float(w.y & 0xffff0000u);
        const float r = rsqrtf(wave_sum((x0 * x0 + x1 * x1) + (x2 * x2 + x3 * x3)) * (1.f / CKVR) + EPS);
        u32x2 o; o.x = pk2(x0 * r * gckv.x, x1 * r * gckv.y); o.y = pk2(x2 * r * gckv.z, x3 * r * gckv.w);
        *(GAS u32x2*)(CKVA + (size_t)m * CKVR + 4 * lane) = o; }
    }
  }
}

__device__ __forceinline__ void cpost_rows(const PT& a, int l, int rb0, int lw, int nlw, int lane)     {
  asm volatile("" : "+v"(lane));
  bf16_t* Z = (bf16_t*)(a.ws + WS_Z); bf16_t* CQ = (bf16_t*)(a.ws + WS_CQ); bf16_t* CKV = (bf16_t*)(a.ws + WS_CKV); bf16_t* KC = (bf16_t*)(a.ws + WS_KC);
  const float* tc = (const float*)(a.ws + WS_ROPE_C);
  const bool act = lane < 48; const int e0 = 4 * lane; const bool isrope = lane >= 32 && act, first = lane < 40;
  const int ri = 4 * ((lane - 32) & 7);
  const f32x4 z4 = {0.f, 0.f, 0.f, 0.f};
  const f32x4 gqv = act ? *(const GAS f32x4*)(a.in(14) + l * 192 + e0) : z4, gkv = act ? *(const GAS f32x4*)(a.in(15) + l * 192 + e0) : z4;
  for (int m = rb0 + lw; m < rb0 + SEQ; m += nlw) {
    const int t = m % SEQ;
    const f32x4 csv = *(const GAS f32x4*)(tc + t * 32 + ri), snv = *(const GAS f32x4*)(tc + SEQ * 32 + t * 32 + ri);
    u32x2 rq[4], rk[4]; const u32x2 zz = {0u, 0u};
#pragma unroll
    for (int h = 0; h < 4; ++h) {
      rq[h] = act ? *(const GAS u32x2*)(CQ + (size_t)m * CQW + h * 192 + e0) : zz;
      const bf16_t* ksrc = lane < 32 ? CKV + (size_t)m * CKVW + h * 256 + e0 : Z + (size_t)m * ZP + 6912 + (e0 - 128);
      rk[h] = act ? *(const GAS u32x2*)ksrc : zz; }
#pragma unroll
    for (int h = 0; h < 4; ++h) {
#pragma unroll
      for (int qk = 0; qk < 2; ++qk) {
        const u32x2 w = qk == 0 ? rq[h] : rk[h]; const f32x4 g = qk == 0 ? gqv : gkv;
        const f32x4 x = {__uint_as_float(w.x << 16), __uint_as_float(w.x & 0xffff0000u), __uint_as_float(w.y << 16), __uint_as_float(w.y & 0xffff0000u)};
        const float r = rsqrtf(wave_sum((x.x * x.x + x.y * x.y) + (x.z * x.z + x.w * x.w)) * (1.f / 192.f) + EPS);
        f32x4 y = x * r * g;
        f32x4 yp; yp.x = __shfl_xor(y.x, 8); yp.y = __shfl_xor(y.y, 8); yp.z = __shfl_xor(y.z, 8); yp.w = __shfl_xor(y.w, 8);
        if (isrope) y = first ? (y * csv - yp * snv) : (yp * snv + y * csv);
        u32x2 o; o.x = pk2(y.x, y.y); o.y = pk2(y.z, y.w);
        bf16_t* dst = qk == 0 ? CQ + (size_t)m * CQW + h * 192 + e0 : KC + (size_t)m * CQW + h * 192 + e0;
        if (act) *(GAS u32x2*)dst = o;
      }
    }
  }
}

__device__ __forceinline__ void ynorm_rows(const PT& a, int l, bf16_t* Y, int rb0, int lw, int nlw, int lane)     {
  asm volatile("" : "+v"(lane));
  const bf16_t* Z = (const bf16_t*)(a.ws + WS_Z); const bf16_t* OC = (const bf16_t*)(a.ws + WS_CQA); const GAS float* LSE = (const GAS float*)(a.ws + WS_LSE);
  const float* gn = a.in(16) + l * DM;
  float gA0[8], gA1[8], gB[8], gC[8];
  ld8f(gn + 8 * lane, gA0); ld8f(gn + 512 + 8 * lane, gA1); ld8f(gn + 1024 + 8 * lane, gB); ld8f(gn + 1536 + 8 * lane, gC);
  const int jh = lane >> 4, d = (lane & 15) * 8;
  constexpr int RR = 2;
  for (int m0 = rb0 + lw * RR; m0 < rb0 + SEQ; m0 += nlw * RR) {
    u32x4 ra0[RR], ra1[RR], rb0[RR], rb1[RR], rb2[RR], rc[RR]; float l0[RR], l1[RR], l2[RR];
#pragma unroll
    for (int rr = 0; rr < RR; ++rr) { const int m = m0 + rr; const bf16_t* zr = Z + (size_t)m * ZP;
      ra0[rr] = *(const GAS u32x4*)(zr + 8 * lane); ra1[rr] = *(const GAS u32x4*)(zr + 512 + 8 * lane);
      rb0[rr] = *(const GAS u32x4*)(zr + 1536 + jh * 128 + d); rb1[rr] = *(const GAS u32x4*)(zr + 1536 + (4 + jh) * 128 + d); rb2[rr] = *(const GAS u32x4*)(zr + 1536 + (8 + jh) * 128 + d);
      rc[rr] = *(const GAS u32x4*)(OC + (size_t)m * 512 + jh * 128 + d);
      l0[rr] = LSE[(size_t)m * 12 + jh]; l1[rr] = LSE[(size_t)m * 12 + 4 + jh]; l2[rr] = LSE[(size_t)m * 12 + 8 + jh]; }
#pragma unroll
    for (int rr = 0; rr < RR; ++rr) { const int m = m0 + rr; bf16_t* yr = Y + (size_t)m * DM;
      { float x[16]; unpack8(ra0[rr], x); unpack8(ra1[rr], x + 8); float ss = 0.f;
#pragma unroll
        for (int e = 0; e < 16; ++e) ss += x[e] * x[e];
        const float r = rsqrtf(wave_sum(ss) * (1.f / 1024.f) + EPS);
        float y0[8], y1[8];
#pragma unroll
        for (int e = 0; e < 8; ++e) { y0[e] = x[e] * r * gA0[e]; y1[e] = x[8 + e] * r * gA1[e]; }
        *(GAS u32x4*)(yr + 8 * lane) = pack8(y0); *(GAS u32x4*)(yr + 512 + 8 * lane) = pack8(y1); }
      { const float mx = fmaxf(l0[rr], fmaxf(l1[rr], l2[rr])); const float e0 = __expf(l0[rr] - mx), e1 = __expf(l1[rr] - mx), e2 = __expf(l2[rr] - mx); const float inv = 1.f / (e0 + e1 + e2);
        float x0[8], x1[8], x2[8], ob[8]; unpack8(rb0[rr], x0); unpack8(rb1[rr], x1); unpack8(rb2[rr], x2);
        float ss = 0.f;
#pragma unroll
        for (int e = 0; e < 8; ++e) { ob[e] = (e0 * inv) * x0[e] + (e1 * inv) * x1[e] + (e2 * inv) * x2[e]; ss += ob[e] * ob[e]; }
        const float r = rsqrtf(wave_sum(ss) * (1.f / 512.f) + EPS);
        float y[8];
#pragma unroll
        for (int e = 0; e < 8; ++e) y[e] = ob[e] * r * gB[e];
        *(GAS u32x4*)(yr + 1024 + 8 * lane) = pack8(y); }
      { float x[8]; unpack8(rc[rr], x); float ss = 0.f;
#pragma unroll
        for (int e = 0; e < 8; ++e) ss += x[e] * x[e];
        const float r = rsqrtf(wave_sum(ss) * (1.f / 512.f) + EPS);
        float y[8];
#pragma unroll
        for (int e = 0; e < 8; ++e) y[e] = x[e] * r * gC[e];
        *(GAS u32x4*)(yr + 1536 + 8 * lane) = pack8(y); }
    }
  }
}

__device__ __forceinline__ void attention_phase(const PT& a, char* lds, int bid, int G) {
  bf16_t* Z = (bf16_t*)(a.ws + WS_Z); bf16_t* CQ = (bf16_t*)(a.ws + WS_CQ); const bf16_t* CKV = (const bf16_t*)(a.ws + WS_CKV); const bf16_t* KC = (const bf16_t*)(a.ws + WS_KC);
  float* LSE = (float*)(a.ws + WS_LSE);
  const int xcd = bid & 7, li = bid >> 3, nloc = G >> 3;
  const size_t rb = (size_t)xcd * SEQ;
#ifndef ATM
#define ATM 7
#endif
#ifndef REPA
#define REPA 0
#endif
#ifndef REPC
#define REPC 0
#endif
#ifndef REPB
#define REPB 0
#endif
  bf16_t* OC = (bf16_t*)(a.ws + WS_CQA);
  if constexpr (ATM & 1) for (int u = li; u < 128; u += nloc) { const int h = u >> 4, qb = u & 15, kvh = h >> 2;
    bf16_t* q = Z + (rb + (size_t)qb * 256) * ZP + h * 128;
    att::attn_unit<128, 2, false>(q, ZP, Z + rb * ZP + 1024 + kvh * 128, ZP, Z + rb * ZP + 1280 + kvh * 128, ZP, q, ZP, 0, SEQ / 64, 0.08838834764831845f, 0, 0.f, nullptr, 0, lds); }
  if constexpr (ATM & 2) for (int u = li; u < 64; u += nloc) { const int h = u >> 4, qb = u & 15;
    const bf16_t* q = CQ + (rb + (size_t)qb * 256) * CQW + h * 192;
    att::attn_unit_simple<192, false>(q, CQW, KC + rb * CQW + h * 192, CQW, CKV + rb * CKVW + h * 256 + 128, CKVW, OC + (rb + (size_t)qb * 256) * 512 + h * 128, 512, 0, SEQ / 64, 0.07216878364870323f, 0, 0.f, nullptr, 0, lds); }
  if constexpr (ATM & 4) for (int u = li; u < 192; u += nloc) { const int g = u >> 6, jh = (u >> 4) & 3, w = u & 15;
    const int dil = g == 0 ? 1 : (g == 1 ? 4 : 16), ups = 16 / dil, r = w / ups, qb = w % ups, L = SEQ / dil, hb = g * 4 + jh;
    const int q0 = qb * 256; int lo = q0 / 64 - 1; if (lo < 0) lo = 0; int hi = q0 / 64 + 5; if (hi > L / 64) hi = L / 64;
    if ((hi - lo) & 1) { if (lo > 0) --lo; else ++hi; }
    const float slope = exp2f(-8.0f * (float)(hb + 1) / 12.0f);
    const float slope_raw = slope * (float)dil * 11.313708498984761f;
    const long ld = (long)dil * ZP; const size_t base = (rb + r) * ZP;
    bf16_t* q = Z + base + (size_t)q0 * ld + 1536 + hb * 128;
    att::attn_unit_simple<128, true>(q, ld, Z + base + 3072 + hb * 128, ld, Z + base + 4608 + hb * 128, ld, q, ld, lo, hi - lo, 0.08838834764831845f, q0, slope_raw,
                                 LSE + (rb + r + (size_t)q0 * dil) * 12 + hb, (long)dil * 12, lds); }
}


#define XB_TMO      128
#define XB_XCNT(j)  (256  + 64 * (j))
#define XB_XSUB(j)  (1280 + 64 * (j))
#define XB_XGEN(j)  (2304 + 64 * (j))
#define XB_TOP      3328
#define XB_TOPGEN   3392
#define XB_LSUB(j)  (3456 + 64 * (j))
#define XB_LGEN(j)  (4480 + 64 * (j))
#define XCD_BAR_WORDS 5504
#define XB_SPIN_CAP (1u << 18)
__device__ __forceinline__ unsigned xb_ld(unsigned* p)              { return __hip_atomic_load(p, __ATOMIC_RELAXED, __HIP_MEMORY_SCOPE_AGENT); }
__device__ __forceinline__ unsigned xb_add(unsigned* p, unsigned v) { return __hip_atomic_fetch_add(p, v, __ATOMIC_RELAXED, __HIP_MEMORY_SCOPE_AGENT); }
__device__ __forceinline__ unsigned xb_xcc_id() { return (unsigned)__builtin_amdgcn_s_getreg((3 << 11) | 20) & 0xFu; }
#define XB_SPIN(cond, bar) do { unsigned _sp = 0; while (cond) { __builtin_amdgcn_s_sleep(1); \
    if ((++_sp & 255u) == 0u) { if (xb_ld(&(bar)[XB_TMO])) break; if (_sp > XB_SPIN_CAP) { atomicAdd(&(bar)[XB_TMO], 1u); break; } } } } while (0)
struct XcdBarrier { unsigned* bar; unsigned x; volatile LAS unsigned* st; };
__device__ __forceinline__ XcdBarrier xcd_barrier_post(unsigned* bar, volatile LAS unsigned* st) {
    XcdBarrier b; b.bar = bar; b.x = xb_xcc_id(); b.st = st;
    if (threadIdx.x == 0) st[4] = xb_add(&bar[XB_XCNT(b.x)], 1u);
    return b;
}
__device__ __forceinline__ void xcd_barrier_complete(unsigned* bar, unsigned x, unsigned& nloc, unsigned& nx, unsigned& even8) {
    const unsigned G = gridDim.x * gridDim.y * gridDim.z;
    unsigned sum, cnt, mine, sp = 0u;
    for (;;) {
        sum = 0u; cnt = 0u; mine = 0u;
#pragma unroll
        for (unsigned j = 0; j < 16; ++j) { const unsigned c = xb_ld(&bar[XB_XCNT(j)]); sum += c; cnt += (c > 0u) ? 1u : 0u; mine = (j == x) ? c : mine; }
        if (sum == G) break;
        __builtin_amdgcn_s_sleep(1);
        if ((++sp & 255u) == 0u) { if (xb_ld(&bar[XB_TMO])) break; if (sp > XB_SPIN_CAP) { atomicAdd(&bar[XB_TMO], 1u); break; } }
    }
    nloc = mine > 0u ? mine : 1u; nx = cnt > 0u ? cnt : 1u;
    unsigned eq = (cnt == 8u && sum == G) ? 1u : 0u;
#pragma unroll
    for (unsigned j = 0; j < 8; ++j) { if (xb_ld(&bar[XB_XCNT(j)]) * 8u != G) eq = 0u; }
    even8 = eq;
}
__device__ __forceinline__ void xcd_barrier(const XcdBarrier& b) {
    asm volatile("s_waitcnt vmcnt(0)" ::: "memory");
    __syncthreads();
    if (threadIdx.x == 0) {
        unsigned* bar = b.bar;
        __builtin_amdgcn_s_waitcnt(0);
        unsigned nloc = b.st[0], nx = b.st[1];
        if (nloc == 0u) { unsigned e8; xcd_barrier_complete(bar, b.x, nloc, nx, e8); b.st[0] = nloc; b.st[1] = nx; b.st[2] = e8; b.st[3] = e8 ? (b.x + 8u * b.st[4]) : blockIdx.x; }
        const unsigned old = xb_add(&bar[XB_XSUB(b.x)], 1u);
        const unsigned gen = old / nloc;
        if (old + 1u == (gen + 1u) * nloc) {
            __builtin_amdgcn_fence(__ATOMIC_RELEASE, "agent");
            asm volatile("s_waitcnt vmcnt(0)" ::: "memory");
            const unsigned og = xb_add(&bar[XB_TOP], 1u);
            const unsigned tg = og / nx;
            if (og + 1u == (tg + 1u) * nx) xb_add(&bar[XB_TOPGEN], 1u);
            else XB_SPIN(xb_ld(&bar[XB_TOPGEN]) == tg, bar);
            __builtin_amdgcn_fence(__ATOMIC_ACQUIRE, "agent");
            xb_add(&bar[XB_XGEN(b.x)], 1u);
            asm volatile("s_waitcnt vmcnt(0)" ::: "memory");
        } else {
            XB_SPIN(xb_ld(&bar[XB_XGEN(b.x)]) == gen, bar);
            __builtin_amdgcn_fence(__ATOMIC_ACQUIRE, "agent");
            asm volatile("s_waitcnt vmcnt(0)" ::: "memory");
        }
    }
    __syncthreads();
}

__device__ __forceinline__ void xcd_local_barrier(const XcdBarrier& b) {
    asm volatile("s_waitcnt vmcnt(0)" ::: "memory");
    __syncthreads();
    if (threadIdx.x == 0) {
        unsigned* bar = b.bar;
        __builtin_amdgcn_s_waitcnt(0);
        const unsigned nloc = b.st[0];
        const unsigned old = xb_add(&bar[XB_LSUB(b.x)], 1u);
        const unsigned gen = old / nloc;
        if (old + 1u == (gen + 1u) * nloc) xb_add(&bar[XB_LGEN(b.x)], 1u);
        else XB_SPIN(xb_ld(&bar[XB_LGEN(b.x)]) == gen, bar);
        __builtin_amdgcn_fence(__ATOMIC_ACQUIRE, "agent");
        asm volatile("s_waitcnt vmcnt(0)" ::: "memory");
    }
    __syncthreads();
}

#ifndef PHM
#define PHM 0xFFFF
#endif
#define PH(k) if constexpr ((PHM >> (k)) & 1)
#ifndef WGM_GU
#define WGM_GU 4
#endif
#ifndef WGM_IN
#define WGM_IN 4
#endif
#ifndef REPGU
#define REPGU 1
#endif
#ifndef REPIN
#define REPIN 1
#endif
#ifndef REPNC
#define REPNC 1
#endif
__global__ void __launch_bounds__(NWAVES * 64, 2) fwd_megakernel(Args ka) {
  extern __shared__ __attribute__((aligned(16))) unsigned char lds[];
  cg::grid_group grid = cg::this_grid();
  LAS unsigned char* ldsl = (LAS unsigned char*)lds;
  const int tid = threadIdx.x, lane = tid & 63, wave = __builtin_amdgcn_readfirstlane(tid >> 6);
  int G = gridDim.x, bid = blockIdx.x;
  int gw = bid * NWAVES + wave, NGW = G * NWAVES;
#define FRESH() do { asm volatile("" : "+s"(G), "+s"(bid), "+s"(gw), "+s"(NGW), "+s"(ws), "+s"(wb), "+s"(out), "+s"(XN), "+s"(Z), "+s"(H)); \
    ws = asglobal(ws); wb = asglobal(wb); out = asglobal(out); XN = asglobal(XN); Z = asglobal(Z); H = asglobal(H); } while (0)
  { LAS unsigned long long* pt = (LAS unsigned long long*)(ldsl + LDS_PTAB);
    if (tid == 0) {
#define PTS(k) pt[k] = (unsigned long long)ka.in[k]
      PTS(0); PTS(1); PTS(2); PTS(3); PTS(4); PTS(5); PTS(6); PTS(7); PTS(8); PTS(9); PTS(10); PTS(11); PTS(12); PTS(13); PTS(14); PTS(15); PTS(16); PTS(17); PTS(18); PTS(19); PTS(20);
#undef PTS
      pt[32] = 0ull; pt[33] = 0ull;
    } }
  if (blockIdx.x == 0) for (int i = tid; i < XCD_BAR_WORDS; i += NWAVES * 64) *(GAS unsigned*)((unsigned*)(ka.ws + WS_BAR) + i) = 0u;
  __syncthreads();
  unsigned char* ws = ka.ws; unsigned char* wb = ws + WS_WB;
  PT a; a.t = (LAS const unsigned long long*)(ldsl + LDS_PTAB); a.out = ka.out; a.ws = ka.ws;
  bf16_t* XN = (bf16_t*)(ws + WS_XN); bf16_t* Z = (bf16_t*)(ws + WS_Z); bf16_t* H = Z;
  float* out = a.out;
  PH(0) rope_tables(ws, bid * (NWAVES * 64) + tid, G * NWAVES * 64);
  XcdBarrier xbar; xbar.bar = (unsigned*)(ka.ws + WS_BAR); xbar.x = 0; xbar.st = (volatile LAS unsigned*)(ldsl + LDS_PTAB + 256);
#define GSYNC() do { xcd_barrier(xbar); FRESH(); a.ws = ws; a.out = out; } while (0)
#define LSYNC() do { if (xlocal) xcd_local_barrier(xbar); else xcd_barrier(xbar); FRESH(); a.ws = ws; a.out = out; } while (0)
  bool xlocal = false;
  float* SSa = (float*)(ws + WS_SS);
  PH(2) xb_init_rows(a.in(0), XN, SSa, (bid & 7) * SEQ, (bid >> 3) * NWAVES + wave, (G >> 3) * NWAVES, lane);
#pragma unroll 1
  for (int l = 0; l < DEPTH; ++l) {
    FRESH(); a.ws = ws; a.out = out;
    for (int rep_ = 0; rep_ < REPNC; ++rep_) { PH(1) convert_weights(a, l, ldsl, gw, NGW, wave, lane); }
    zero_f32((float*)(ws + WS_SS) + 2 * M, 4 * M, bid * (NWAVES * 64) + tid, G * NWAVES * 64);
    if (l == 0) { grid.sync(); xbar = xcd_barrier_post((unsigned*)(ka.ws + WS_BAR), (volatile LAS unsigned*)(ldsl + LDS_PTAB + 256)); xcd_barrier(xbar);
      bid = __builtin_amdgcn_readfirstlane((int)xbar.st[3]); gw = bid * NWAVES + wave; xlocal = false  ; FRESH(); a.ws = ws; a.out = out; }
    else GSYNC();
    for (int rep_ = 0; rep_ < REPGU; ++rep_) PH(3) { pg8::Gemm g{XN, (const bf16_t*)(wb + WB_GU1), M, 2 * DFF, DM, DM}; pg8::StaticOrder S; S.init(M, 2 * DFF, G, bid, WGM_GU); pg8::EpiSwiGLU E{H, DFF, (const float*)(ws + WS_SS)};
      pg8::gemm_phase(ldsl, g, S, E); }
    LSYNC();
    PH(4) { pg8::Gemm g{H, (const bf16_t*)(wb + WB_D1), M, DM, DFF, DFF}; pg8::StaticOrder S; S.init(M, DM, G, bid); pg8::EpiResid<1, WS_XN, WS_SS + (size_t)M * 8, false> E{out, ws};
      pg8::gemm_phase(ldsl, g, S, E); }
    LSYNC();
    for (int rep_ = 0; rep_ < REPIN; ++rep_) PH(5) { pg8::Gemm g{XN, (const bf16_t*)(wb + WB_IN), M, ZP, DM, DM}; pg8::StaticOrder S; S.init(M, ZP, G, bid, WGM_IN); pg8::EpiBf16 E{Z, ZP, (const float*)(ws + WS_SS + (size_t)M * 8)};
      pg8::gemm_phase(ldsl, g, S, E); }
    LSYNC();
    PH(6) prep_rows(a, l, (bid & 7) * SEQ, (bid >> 3) * NWAVES + wave, (G >> 3) * NWAVES, lane);
    { unsigned long long* ssa = (unsigned long long*)(ws + WS_SS) + (bid & 7) * SEQ;
      for (int i = (bid >> 3) * (NWAVES * 64) + tid; i < SEQ; i += (G >> 3) * (NWAVES * 64)) __hip_atomic_store(ssa + i, 0ull, __ATOMIC_RELAXED, __HIP_MEMORY_SCOPE_AGENT); }
    LSYNC();
    PH(5) { pg8::Gemm g{(const bf16_t*)(ws + WS_CQA), (const bf16_t*)(wb + WB_CQ), M, CQW, CQR, CQR}; pg8::StaticOrder S; S.init(M, CQW, G, bid); pg8::EpiBf16 E{(bf16_t*)(ws + WS_CQ), CQW, nullptr};
      pg8::gemm_phase(ldsl, g, S, E); }
    PH(5) { pg8::Gemm g{(const bf16_t*)(ws + WS_CKVA), (const bf16_t*)(wb + WB_CKV), M, CKVW, CKVR, CKVR}; pg8::StaticOrder S; S.init(M, CKVW, G, bid); pg8::EpiBf16 E{(bf16_t*)(ws + WS_CKV), CKVW, nullptr};
      pg8::gemm_phase(ldsl, g, S, E); }
    LSYNC();
    PH(7) cpost_rows(a, l, (bid & 7) * SEQ, (bid >> 3) * NWAVES + wave, (G >> 3) * NWAVES, lane);
    LSYNC();
    PH(8) attention_phase(a, (char*)lds, bid, G);
    LSYNC();
    PH(9) ynorm_rows(a, l, (bf16_t*)(ws + WS_CQ), (bid & 7) * SEQ, (bid >> 3) * NWAVES + wave, (G >> 3) * NWAVES, lane);
    LSYNC();
    PH(4) { pg8::Gemm g{(const bf16_t*)(ws + WS_CQ), (const bf16_t*)(wb + WB_OUT), M, DM, DM, DM}; pg8::StaticOrder S; S.init(M, DM, G, bid); pg8::EpiResid<2, WS_XN, WS_SS + (size_t)M * 16, false> E{out, ws};
      pg8::gemm_phase(ldsl, g, S, E); }
    LSYNC();
    for (int rep_ = 0; rep_ < REPGU; ++rep_) PH(3) { pg8::Gemm g{XN, (const bf16_t*)(wb + WB_GU2), M, 2 * DFF, DM, DM}; pg8::StaticOrder S; S.init(M, 2 * DFF, G, bid, WGM_GU); pg8::EpiSwiGLU E{H, DFF, (const float*)(ws + WS_SS + (size_t)M * 16)};
      pg8::gemm_phase(ldsl, g, S, E); }
    LSYNC();
    if (l + 1 < DEPTH) { pg8::Gemm g{H, (const bf16_t*)(wb + WB_D2), M, DM, DFF, DFF}; pg8::StaticOrder S; S.init(M, DM, G, bid); pg8::EpiResid<1, WS_XN, WS_SS, false> E{out, ws};
      pg8::gemm_phase(ldsl, g, S, E); }
    else { pg8::Gemm g{H, (const bf16_t*)(wb + WB_D2), M, DM, DFF, DFF}; pg8::StaticOrder S; S.init(M, DM, G, bid); pg8::EpiResid<1, WS_XN, WS_SS, true> E{out, ws};
      pg8::gemm_phase(ldsl, g, S, E); }
    GSYNC();
  }
}

extern "C" void kernel_launch(void* const* d_in, const int* in_sizes, int n_in, void* d_out, int out_size, void* d_ws, size_t ws_size, hipStream_t stream) {
  static int grid = 0;
  if (grid == 0) {
    if (n_in != 21 || in_sizes[0] != M * DM || out_size != M * DM || ws_size < WS_END) { fprintf(stderr, "kernel_launch: unexpected shapes (n_in %d, ws %zu)\n", n_in, ws_size); grid = -1; return; }
    int dev = 0, cus = 0, per_cu = 0;
    hipGetDevice(&dev); hipDeviceGetAttribute(&cus, hipDeviceAttributeMultiprocessorCount, dev);
    hipFuncSetAttribute((const void*)fwd_megakernel, hipFuncAttributeMaxDynamicSharedMemorySize, LDS_BYTES);
    hipOccupancyMaxActiveBlocksPerMultiprocessor(&per_cu, (const void*)fwd_megakernel, NWAVES * 64, LDS_BYTES);
    if (per_cu < 1) { fprintf(stderr, "kernel_launch: occupancy query says %d blocks per CU\n", per_cu); per_cu = 1; }
    (void)hipGetLastError();
    grid = cus * 1;
    grid -= grid % 8;
  }
  if (grid < 0) return;
  Args a{};
  for (int i = 0; i < 21; ++i) a.in[i] = (const float*)d_in[i];
  a.out = (float*)d_out; a.ws = (unsigned char*)d_ws;
  void* args[] = {&a};
  hipError_t e = hipLaunchCooperativeKernel((const void*)fwd_megakernel, dim3(grid), dim3(NWAVES * 64), args, LDS_BYTES, stream);
  if (e != hipSuccess) fprintf(stderr, "cooperative launch failed: %s (grid %d)\n", hipGetErrorString(e), grid);
}
```

```cpp
#include <hip/hip_runtime.h>
#include <hip/hip_bf16.h>
#include <hip/hip_cooperative_groups.h>
#include <cstdio>
#include <cstdint>
namespace cg = cooperative_groups;

namespace pg8 {
#define PG8_LAS __attribute__((address_space(3)))
#define PG8_GAS __attribute__((address_space(1)))
typedef unsigned short bf16_t;
typedef short bf16x8 __attribute__((ext_vector_type(8)));
typedef float f32x4 __attribute__((ext_vector_type(4)));
typedef unsigned u32x4 __attribute__((ext_vector_type(4)));
constexpr int BM = 256, BK = 64, HALF = 128, HTB = HALF * BK * 2  , STAGE_BYTES = 8 * HTB, NXCD = 8, WGM = 4;

__host__ __device__ __forceinline__ int lds_byte(int r, int c) { const int st = (r >> 4) * 2 + (c >> 5), rr = r & 15, cc = c & 31, ob = rr * 64 + cc * 2; return st * 1024 + (ob ^ (((ob >> 9) & 1) << 5)); }
__host__ __device__ __forceinline__ void stage_rc(int b, int& R, int& C) { const int st = b / 1024, sb = b % 1024, swz = sb ^ (((sb >> 9) & 1) << 5); R = (st >> 1) * 16 + swz / 64; C = (st & 1) * 32 + (swz % 64) / 2; }
__host__ __device__ __forceinline__ int perm32(int rho) { const int n = rho >> 4, i = rho & 15; return 8 * (i >> 2) + 4 * n + (i & 3); }

struct Unit { int pm, pn; };
struct Gemm { const bf16_t* A; const bf16_t* Bt; int M, N, K, lda; };

struct StaticOrder {
    int nM, nN, nwg, G, c, wgm;
    __host__ __device__ void init(int M, int N, int G_, int c_, int wgm_ = 4) { nM = M / BM; nN = N / BM; nwg = nM * nN; G = G_; c = c_; wgm = wgm_; }
    __host__ __device__ bool next(int i, Unit& u) const {
        const long L = (long)i * G + c; if (L >= nwg) return false;
        int wgid = (int)L; { const int q = nwg / NXCD, r = nwg % NXCD, xcd = wgid % NXCD, off = wgid / NXCD; wgid = (xcd < r ? xcd * (q + 1) : r * (q + 1) + (xcd - r) * q) + off; }
        const int nig = wgm * nN, gid = wgid / nig, fm = gid * wgm, gsz = (nM - fm) < wgm ? (nM - fm) : wgm;
        u.pm = fm + ((wgid % nig) % gsz); u.pn = (wgid % nig) / gsz; return true;
    }
};

__device__ __forceinline__ unsigned cvt_pk_bf16(float lo, float hi) { unsigned r; asm volatile("v_cvt_pk_bf16_f32 %0, %1, %2" : "=v"(r) : "v"(lo), "v"(hi)); return r; }

constexpr float SS_SCALE = 4194304.0f, SS_INV = 1.0f / 4194304.0f;
__device__ __forceinline__ float row_rstd(const float* ss, int row, float invn) { const unsigned long long v = *(const PG8_GAS unsigned long long*)((const unsigned long long*)ss + row); return __builtin_amdgcn_rsqf((float)v * SS_INV * invn + 1e-6f); }
constexpr int RSTD_TAB_OFF = 131072 + 1024;
struct EpiBf16 {
    static constexpr bool PERM = true;
    static constexpr bool RSTD_TAB = true;
    bf16_t* O; int ldc; const float* ss;
    __device__ __forceinline__ void operator()(const f32x4 (&acc)[2][2][4][2], const Unit& u, int wr, int wc, int fr, int fq, PG8_LAS unsigned char* lds) const {
        const int row0 = u.pm * BM + wr * 64 + fr; const int col0 = u.pn * BM + wc * 32 + 8 * fq;
        const PG8_LAS float* tab = (const PG8_LAS float*)(lds + RSTD_TAB_OFF) + wr * 64 + fr;
#pragma unroll
        for (int ai = 0; ai < 2; ++ai)
#pragma unroll
            for (int m = 0; m < 4; ++m) { const int row = row0 + ai * HALF + m * 16; bf16_t* rowp = O + (size_t)row * ldc + col0;
                const float r = ss ? tab[ai * HALF + m * 16] : 1.0f;
#pragma unroll
                for (int bj = 0; bj < 2; ++bj) { const f32x4 v0 = acc[ai][bj][m][0] * r, v1 = acc[ai][bj][m][1] * r;
                    u32x4 w; w.x = cvt_pk_bf16(v0[0], v0[1]); w.y = cvt_pk_bf16(v0[2], v0[3]); w.z = cvt_pk_bf16(v1[0], v1[1]); w.w = cvt_pk_bf16(v1[2], v1[3]);
                    *(PG8_GAS u32x4*)(rowp + bj * HALF) = w; } }
    }
};
__device__ __forceinline__ float silu_mul(float g, float u) { return g * u * __builtin_amdgcn_rcpf(1.0f + __builtin_amdgcn_exp2f(-1.4426950408889634f * g)); }
struct EpiSwiGLU {
    static constexpr bool PERM = true;
    static constexpr bool RSTD_TAB = true;
    bf16_t* H; int ldh; const float* ss;
    __device__ __forceinline__ void operator()(const f32x4 (&acc)[2][2][4][2], const Unit& u, int wr, int wc, int fr, int fq, PG8_LAS unsigned char* lds) const {
        const int row0 = u.pm * BM + wr * 64 + fr; const int col0 = u.pn * HALF + wc * 32 + 8 * fq;
        const PG8_LAS float* tab = (const PG8_LAS float*)(lds + RSTD_TAB_OFF) + wr * 64 + fr;
#pragma unroll
        for (int ai = 0; ai < 2; ++ai)
#pragma unroll
            for (int m = 0; m < 4; ++m) { const int row = row0 + ai * HALF + m * 16; bf16_t* rowp = H + (size_t)row * ldh + col0;
                const float r = tab[ai * HALF + m * 16];
                const f32x4 g0 = acc[ai][0][m][0] * r, g1 = acc[ai][0][m][1] * r, u0 = acc[ai][1][m][0] * r, u1 = acc[ai][1][m][1] * r;
                u32x4 w; w.x = cvt_pk_bf16(silu_mul(g0[0], u0[0]), silu_mul(g0[1], u0[1])); w.y = cvt_pk_bf16(silu_mul(g0[2], u0[2]), silu_mul(g0[3], u0[3]));
                w.z = cvt_pk_bf16(silu_mul(g1[0], u1[0]), silu_mul(g1[1], u1[1])); w.w = cvt_pk_bf16(silu_mul(g1[2], u1[2]), silu_mul(g1[3], u1[3]));
                *(PG8_GAS u32x4*)rowp = w; }
    }
};
template <int ALPHA2, size_t ROFF, size_t SSOFF, bool F32OUT>
struct EpiResid {
    static constexpr bool PERM = true;
    static constexpr int ldc = 2048; static constexpr float alpha = 0.5f * ALPHA2;
    static constexpr bool RSTD_TAB = false;
    float* out; unsigned char* ws;
    __device__ __forceinline__ void operator()(const f32x4 (&acc)[2][2][4][2], const Unit& u, int wr, int wc, int fr, int fq, PG8_LAS unsigned char*) const {
        const int row0 = u.pm * BM + wr * 64 + fr; const int col0 = u.pn * BM + wc * 32 + 8 * fq;
        bf16_t* R = (bf16_t*)(ws + ROFF); float* ssq = (float*)(ws + SSOFF);
#pragma unroll
        for (int ai = 0; ai < 2; ++ai) {
            u32x4 pre[4][2];
#pragma unroll
            for (int m = 0; m < 4; ++m) { const size_t off = (size_t)(row0 + ai * HALF + m * 16) * ldc + col0;
#pragma unroll
                for (int bj = 0; bj < 2; ++bj) pre[m][bj] = *(const PG8_GAS u32x4*)(R + off + bj * HALF); }
#pragma unroll
            for (int m = 0; m < 4; ++m) { const int row = row0 + ai * HALF + m * 16; const size_t off = (size_t)row * ldc + col0; float sq = 0.f;
#pragma unroll
                for (int bj = 0; bj < 2; ++bj) { const u32x4 b = pre[m][bj];
                    const f32x4 b0 = {__uint_as_float(b.x << 16), __uint_as_float(b.x & 0xffff0000u), __uint_as_float(b.y << 16), __uint_as_float(b.y & 0xffff0000u)};
                    const f32x4 b1 = {__uint_as_float(b.z << 16), __uint_as_float(b.z & 0xffff0000u), __uint_as_float(b.w << 16), __uint_as_float(b.w & 0xffff0000u)};
                    const f32x4 o0 = b0 + acc[ai][bj][m][0] * alpha, o1 = b1 + acc[ai][bj][m][1] * alpha;
                    if constexpr (F32OUT) { __builtin_nontemporal_store(o0, (PG8_GAS f32x4*)(out + off + bj * HALF)); __builtin_nontemporal_store(o1, (PG8_GAS f32x4*)(out + off + bj * HALF + 4)); }
                    u32x4 w; w.x = cvt_pk_bf16(o0[0], o0[1]); w.y = cvt_pk_bf16(o0[2], o0[3]); w.z = cvt_pk_bf16(o1[0], o1[1]); w.w = cvt_pk_bf16(o1[2], o1[3]);
                    *(PG8_GAS u32x4*)(R + off + bj * HALF) = w;
                    sq += ((o0[0] * o0[0] + o0[1] * o0[1]) + (o0[2] * o0[2] + o0[3] * o0[3])) + ((o1[0] * o1[0] + o1[1] * o1[1]) + (o1[2] * o1[2] + o1[3] * o1[3])); }
                sq += __shfl_xor(sq, 16); sq += __shfl_xor(sq, 32);
                if (fq == 0) __hip_atomic_fetch_add((PG8_GAS unsigned long long*)((unsigned long long*)ssq + row), (unsigned long long)(sq * SS_SCALE), __ATOMIC_RELAXED, __HIP_MEMORY_SCOPE_AGENT); }
        }
    }
};

template <class Epi, class Sched>
__device__ __forceinline__ void gemm_phase(PG8_LAS unsigned char* lds, const Gemm g, const Sched& S, const Epi& E) {
    int tid_ = threadIdx.x; asm volatile("" : "+v"(tid_));
    const int tid = tid_, wid = __builtin_amdgcn_readfirstlane(tid >> 6), lane = tid & 63, wr = wid >> 2, wc = wid & 3, fr = lane & 15, fq = lane >> 4;
    const int K = g.K, nt = K / BK, lda = g.lda;
    unsigned voffA[2], voffB[2];
#pragma unroll
    for (int i = 0; i < 2; ++i) { int R, C; stage_rc(tid * 16 + i * 8192, R, C); const int Rb = Epi::PERM ? ((R & ~31) + perm32(R & 31)) : R;
        voffA[i] = (unsigned)(R * lda + C) * 2u; voffB[i] = (unsigned)(Rb * K + C) * 2u; }
    const size_t kstep = (size_t)(BK * 2);
    const size_t hA = (size_t)HALF * lda * 2, hB = (size_t)HALF * K * 2;
    const size_t tA = 2 * hA, tB = 2 * hB;
    const unsigned ldsw = (unsigned)wid * 1024u;
    const int aoff = lds_byte(wr * 64 + fr, fq * 8), boff = lds_byte(wc * 32 + fr, fq * 8);
#define PG8_SA(b, h) (((b) * 2 + (h)) * HTB)
#define PG8_SB(b, h) ((4 + (b) * 2 + (h)) * HTB)
#define PG8_STAGE(bufoff, gbase, voff) do { _Pragma("unroll") for (int _i = 0; _i < 2; ++_i) \
        __builtin_amdgcn_global_load_lds((const unsigned*)((const char*)(gbase) + (voff)[_i]), (PG8_LAS unsigned*)(lds + (bufoff) + ldsw + _i * 8192), 16, 0, 0); } while (0)
#define PG8_LDA(dst, b, h) do { _Pragma("unroll") for (int m = 0; m < 4; ++m) _Pragma("unroll") for (int k = 0; k < 2; ++k) dst[m][k] = *(const PG8_LAS bf16x8*)(lds + PG8_SA(b, h) + aoff + m * 2048 + k * 1024); } while (0)
#define PG8_LDB(dst, b, h) do { _Pragma("unroll") for (int n = 0; n < 2; ++n) _Pragma("unroll") for (int k = 0; k < 2; ++k) dst[n][k] = *(const PG8_LAS bf16x8*)(lds + PG8_SB(b, h) + boff + n * 2048 + k * 1024); } while (0)
#define PG8_MMA(ai, bj, At, Bt) do { __builtin_amdgcn_s_setprio(1); _Pragma("unroll") for (int m = 0; m < 4; ++m) _Pragma("unroll") for (int n = 0; n < 2; ++n) _Pragma("unroll") for (int k = 0; k < 2; ++k) \
        acc[ai][bj][m][n] = __builtin_amdgcn_mfma_f32_16x16x32_bf16(Bt[n][k], At[m][k], acc[ai][bj][m][n], 0, 0, 0); __builtin_amdgcn_s_setprio(0); } while (0)
#define PG8_WAIT_V(n) asm volatile("s_waitcnt vmcnt(" #n ")" ::: "memory")
#define PG8_WAIT_L(n) asm volatile("s_waitcnt lgkmcnt(" #n ")" ::: "memory")
#define PG8_BAR __builtin_amdgcn_s_barrier()
#define PG8_SCHED __builtin_amdgcn_sched_barrier(0)
    Unit cur, nxt; int ui = 0;
    if (!S.next(0, cur)) return;
    int pmc = -1;
    f32x4 acc[2][2][4][2];
#pragma unroll
    for (int a = 0; a < 2; ++a)
#pragma unroll
        for (int b = 0; b < 2; ++b)
#pragma unroll
            for (int m = 0; m < 4; ++m)
#pragma unroll
                for (int n = 0; n < 2; ++n) acc[a][b][m][n] = (f32x4){0.f, 0.f, 0.f, 0.f};
    bf16x8 At[4][2], B0[2][2], B1[2][2];
    const char* cA = (const char*)g.A + (size_t)cur.pm * tA; const char* cB = (const char*)g.Bt + (size_t)cur.pn * tB;
    PG8_STAGE(PG8_SB(0, 0), cB, voffB); PG8_STAGE(PG8_SB(0, 1), cB + hB, voffB); PG8_STAGE(PG8_SA(0, 0), cA, voffA); PG8_STAGE(PG8_SA(0, 1), cA + hA, voffA);
    if (wr == 1) PG8_BAR;
    PG8_WAIT_V(2); PG8_BAR;
    PG8_STAGE(PG8_SB(1, 0), cB + kstep, voffB); PG8_STAGE(PG8_SA(1, 0), cA + kstep, voffA); PG8_STAGE(PG8_SB(1, 1), cB + hB + kstep, voffB);
    PG8_WAIT_V(6); PG8_BAR;
    for (;;) {
        const bool has_next = S.next(ui + 1, nxt);
        const char* nA = has_next ? (const char*)g.A + (size_t)nxt.pm * tA : cA; const char* nB = has_next ? (const char*)g.Bt + (size_t)nxt.pn * tB : cB;
        for (int t = 0; t < nt; t += 2) {
            const bool last = (t == nt - 2);
            const char* a1 = cA + (size_t)(t + 1) * kstep;
            const char* a2 = last ? nA : cA + (size_t)(t + 2) * kstep; const char* b2 = last ? nB : cB + (size_t)(t + 2) * kstep;
            const char* a3 = a2 + kstep; const char* b3 = b2 + kstep;
            PG8_LDB(B0, 0, 0); PG8_LDB(B1, 0, 1); PG8_SCHED; PG8_LDA(At, 0, 0); PG8_STAGE(PG8_SA(1, 1), a1 + hA, voffA);
            PG8_WAIT_V(8); PG8_WAIT_L(0); PG8_BAR; PG8_MMA(0, 0, At, B0); PG8_MMA(0, 1, At, B1); PG8_BAR; PG8_SCHED;
            PG8_LDA(At, 0, 1); PG8_STAGE(PG8_SB(0, 0), b2, voffB); PG8_STAGE(PG8_SB(0, 1), b2 + hB, voffB); PG8_STAGE(PG8_SA(0, 0), a2, voffA);
            PG8_WAIT_V(8); PG8_WAIT_L(0); PG8_BAR; PG8_MMA(1, 0, At, B0); PG8_MMA(1, 1, At, B1); PG8_BAR; PG8_SCHED;
            PG8_LDB(B0, 1, 0); PG8_LDB(B1, 1, 1); PG8_SCHED; PG8_LDA(At, 1, 0); PG8_STAGE(PG8_SA(0, 1), a2 + hA, voffA);
            PG8_WAIT_V(8); PG8_WAIT_L(0); PG8_BAR; PG8_MMA(0, 0, At, B0); PG8_MMA(0, 1, At, B1); PG8_BAR; PG8_SCHED;
            PG8_LDA(At, 1, 1); PG8_STAGE(PG8_SB(1, 0), b3, voffB); PG8_STAGE(PG8_SB(1, 1), b3 + hB, voffB); PG8_STAGE(PG8_SA(1, 0), a3, voffA);
            PG8_WAIT_V(8); PG8_WAIT_L(0); PG8_BAR; PG8_MMA(1, 0, At, B0); PG8_MMA(1, 1, At, B1); PG8_BAR; PG8_SCHED;
        }
        if (wr == 0) PG8_BAR;
        if constexpr (Epi::RSTD_TAB) {
            if (E.ss && pmc != cur.pm) { pmc = cur.pm;
                if (tid < BM) *(PG8_LAS float*)(lds + RSTD_TAB_OFF + tid * 4) = row_rstd(E.ss, cur.pm * BM + tid, 1.0f / 2048.0f);
                PG8_WAIT_L(0); PG8_BAR; } }
        E(acc, cur, wr, wc, fr, fq, lds);
        if (!has_next) break;
#pragma unroll
        for (int a = 0; a < 2; ++a)
#pragma unroll
            for (int b = 0; b < 2; ++b)
#pragma unroll
                for (int m = 0; m < 4; ++m)
#pragma unroll
                    for (int n = 0; n < 2; ++n) acc[a][b][m][n] = (f32x4){0.f, 0.f, 0.f, 0.f};
        cur = nxt; cA = nA; cB = nB; ++ui;
        if (wr == 1) PG8_BAR;
    }
    PG8_WAIT_V(0);
    PG8_BAR;
#undef PG8_SA
#undef PG8_SB
#undef PG8_STAGE
#undef PG8_LDA
#undef PG8_LDB
#undef PG8_MMA
#undef PG8_WAIT_V
#undef PG8_WAIT_L
#undef PG8_BAR
#undef PG8_SCHED
}
}

namespace att {
typedef unsigned short bf16_t;
using bf16x8 = __attribute__((ext_vector_type(8))) short;
using s16x4  = __attribute__((ext_vector_type(4))) short;
using f32x16 = __attribute__((ext_vector_type(16))) float;
using u32x4  = __attribute__((ext_vector_type(4))) unsigned;
#define SBAR() __builtin_amdgcn_sched_barrier(0)
#define AGAS __attribute__((address_space(1)))
__device__ __forceinline__ int crow(int r, int hi) { return (r & 3) + 8 * (r >> 2) + 4 * hi; }
__device__ __forceinline__ unsigned cvtpk(float lo, float hi) { unsigned r; asm volatile("v_cvt_pk_bf16_f32 %0, %1, %2" : "=v"(r) : "v"(lo), "v"(hi)); return r; }

__device__ __forceinline__ void partialSM(f32x16& p0, f32x16& p1, float& m_reg, float& mn, float& alpha, float C, float thr_raw) {
  float pmax = p0[0];
#pragma unroll
  for (int r = 1; r < 16; ++r) pmax = fmaxf(pmax, p0[r]);
#pragma unroll
  for (int r = 0; r < 16; ++r) pmax = fmaxf(pmax, p1[r]);
  { auto rr = __builtin_amdgcn_permlane32_swap(__float_as_uint(pmax), __float_as_uint(pmax), false, false);
    pmax = fmaxf(__uint_as_float(rr[0]), __uint_as_float(rr[1])); }
  if (__builtin_expect(__all(pmax - m_reg <= thr_raw), 1)) { mn = m_reg; alpha = 1.f; }
  else { mn = fmaxf(m_reg, pmax); alpha = __builtin_amdgcn_exp2f((m_reg - mn) * C); m_reg = mn; }
  float mnC = -mn * C;
#pragma unroll
  for (int r = 0; r < 16; ++r) p0[r] = fmaf(p0[r], C, mnC);
#pragma unroll
  for (int r = 0; r < 16; ++r) p1[r] = fmaf(p1[r], C, mnC);
#pragma unroll
  for (int r = 0; r < 16; ++r) p0[r] = __builtin_amdgcn_exp2f(p0[r]);
}
__device__ __forceinline__ void finishSM(f32x16& p0, f32x16& p1, float alpha, float& l_reg, bf16x8& pa0, bf16x8& pa1, bf16x8& pa2, bf16x8& pa3) {
#pragma unroll
  for (int r = 0; r < 16; ++r) p1[r] = __builtin_amdgcn_exp2f(p1[r]);
  float ps = 0;
#pragma unroll
  for (int r = 0; r < 16; ++r) ps += p0[r];
#pragma unroll
  for (int r = 0; r < 16; ++r) ps += p1[r];
  { auto rr = __builtin_amdgcn_permlane32_swap(__float_as_uint(ps), __float_as_uint(ps), false, false);
    ps = __uint_as_float(rr[0]) + __uint_as_float(rr[1]); }
  l_reg = l_reg * alpha + ps;
#define PK4(P, BASE, OUT) do { unsigned a0 = cvtpk(P[BASE + 0], P[BASE + 1]), a1 = cvtpk(P[BASE + 2], P[BASE + 3]);   \
    unsigned b0 = cvtpk(P[BASE + 4], P[BASE + 5]), b1 = cvtpk(P[BASE + 6], P[BASE + 7]);                              \
    auto r0 = __builtin_amdgcn_permlane32_swap(a0, b0, false, false); auto r1 = __builtin_amdgcn_permlane32_swap(a1, b1, false, false); \
    u32x4 w = {r0[0], r1[0], r0[1], r1[1]}; OUT = *reinterpret_cast<bf16x8*>(&w); } while (0)
  PK4(p0, 0, pa0); PK4(p0, 8, pa1); PK4(p1, 0, pa2); PK4(p1, 8, pa3);
#undef PK4
}
template <int DQK>
__device__ __forceinline__ void qkt(f32x16& p0, f32x16& p1, const char* Ks, const bf16x8* qr, int r32, int hi) {
  p0 = f32x16{}; p1 = f32x16{};
  constexpr int KST = DQK * 2, SWM = (DQK == 128) ? 15 : 7;
  const int sw = (r32 & SWM) << 4;
#pragma unroll
  for (int d0 = 0; d0 < DQK / 16; ++d0) { const int cb = (d0 * 16 + hi * 8) * 2;
    bf16x8 b0 = *reinterpret_cast<const bf16x8*>(Ks + r32 * KST + (cb ^ sw));
    bf16x8 b1 = *reinterpret_cast<const bf16x8*>(Ks + (32 + r32) * KST + (cb ^ sw));
    p0 = __builtin_amdgcn_mfma_f32_32x32x16_bf16(b0, qr[d0], p0, 0, 0, 0);
    p1 = __builtin_amdgcn_mfma_f32_32x32x16_bf16(b1, qr[d0], p1, 0, 0, 0); }
}
__device__ __forceinline__ int v_st(int k, int c) { const int kk = (k & ~0xC) | ((k & 4) << 1) | ((k & 8) >> 1); return ((kk >> 3) * 4 + (c >> 5)) * 512 + ((kk & 7) * 32 + (c & 31)) * 2; }
__device__ __forceinline__ int v_rd_base(int lane) { return ((lane & 3) << 3) | (((lane >> 2) & 3) << 6) | (((lane >> 4) & 1) << 5) | (((lane >> 5) & 1) << 8); }
constexpr int v_rd_off(int d0, int ks, int half) { return d0 * 512 + ks * 4096 + half * 2048; }
template <int OFF> __device__ __forceinline__ s16x4 tr_read(int vb) {
  s16x4 r; asm volatile("ds_read_b64_tr_b16 %0, %1 offset:%2" : "=&v"(r) : "v"(vb), "i"(OFF) : "memory"); return r;
}
template <int D0> __device__ __forceinline__ void pv_one(f32x16& od, int vb, bf16x8 pa0, bf16x8 pa1, bf16x8 pa2, bf16x8 pa3) {
  const s16x4 l0 = tr_read<v_rd_off(D0, 0, 0)>(vb), h0 = tr_read<v_rd_off(D0, 0, 1)>(vb), l1 = tr_read<v_rd_off(D0, 1, 0)>(vb), h1 = tr_read<v_rd_off(D0, 1, 1)>(vb);
  const s16x4 l2 = tr_read<v_rd_off(D0, 2, 0)>(vb), h2 = tr_read<v_rd_off(D0, 2, 1)>(vb), l3 = tr_read<v_rd_off(D0, 3, 0)>(vb), h3 = tr_read<v_rd_off(D0, 3, 1)>(vb);
  asm volatile("s_waitcnt lgkmcnt(0)" ::: "memory"); SBAR();
#define PK(L, H) (bf16x8){L[0], L[1], L[2], L[3], H[0], H[1], H[2], H[3]}
  od = __builtin_amdgcn_mfma_f32_32x32x16_bf16(pa0, PK(l0, h0), od, 0, 0, 0);
  od = __builtin_amdgcn_mfma_f32_32x32x16_bf16(pa1, PK(l1, h1), od, 0, 0, 0);
  od = __builtin_amdgcn_mfma_f32_32x32x16_bf16(pa2, PK(l2, h2), od, 0, 0, 0);
  od = __builtin_amdgcn_mfma_f32_32x32x16_bf16(pa3, PK(l3, h3), od, 0, 0, 0);
#undef PK
}
__device__ __forceinline__ void pv_d0(f32x16* o, int vb, bf16x8 pa0, bf16x8 pa1, bf16x8 pa2, bf16x8 pa3) {
  pv_one<0>(o[0], vb, pa0, pa1, pa2, pa3); pv_one<1>(o[1], vb, pa0, pa1, pa2, pa3); pv_one<2>(o[2], vb, pa0, pa1, pa2, pa3); pv_one<3>(o[3], vb, pa0, pa1, pa2, pa3);
}
constexpr float MASKV = -3.0e4f;
__device__ __forceinline__ void bandmask(f32x16& p0, f32x16& p1, int kb, int qi, int hi, float slope_raw) {
#pragma unroll
  for (int r = 0; r < 16; ++r) {
    int d0 = kb + crow(r, hi) - qi; d0 = d0 < 0 ? -d0 : d0; int d1 = kb + 32 + crow(r, hi) - qi; d1 = d1 < 0 ? -d1 : d1;
    p0[r] = d0 > 64 ? MASKV : fmaf(-slope_raw, (float)d0, p0[r]);
    p1[r] = d1 > 64 ? MASKV : fmaf(-slope_raw, (float)d1, p1[r]);
  }
}

template <int DQK, int SD, bool BAND>
__device__ __forceinline__ void attn_unit(const bf16_t* __restrict__ Qb, long ldq, const bf16_t* __restrict__ Kh, long ldk, const bf16_t* __restrict__ Vh, long ldv,
                                          bf16_t* Ob, long ldo, int kt0, int NT, float scale, int q0, float slope_raw, float* lse, long ld_lse, char* lds) {
  constexpr int ND = DQK / 16, NKC = DQK / 8, KPT = NKC / 8;
  constexpr int SHM_V = 64 * 128 * 2, SHM_K = 64 * DQK * 2;
  int tid_ = threadIdx.x; asm volatile("" : "+v"(tid_));
  const int tid = tid_, wid = tid >> 6, lane = tid & 63, r32 = lane & 31, hi = lane >> 5;
  char* V_lds = lds; char* K_lds = lds + 2 * SHM_V;
  float* ws = (float*)(lds + 2 * SHM_V + 2 * SHM_K) + wid * 64; float* li_l = ws; float* al_l = ws + 32;
  const float C = scale * 1.4426950408889634f, thr_raw = 8.f / scale;
  float m_reg = BAND ? MASKV : -1e30f, l_reg = 0; f32x16 o[4] = {}; bf16x8 qr[ND];
  const bf16_t* Qw = Qb + (long)(wid * 32 + r32) * ldq + hi * 8;
#pragma unroll
  for (int d0 = 0; d0 < ND; ++d0) qr[d0] = *(const AGAS bf16x8*)(Qw + d0 * 16);
  static_assert(DQK == 128, "pipelined body: DQK = 128");
  const int sr = tid >> 4, sc = (tid & 15) * 8, vst0 = v_st(sr, sc);
  const unsigned vgo0 = (unsigned)(sr * (int)ldv + sc) * 2u, kgo0 = (unsigned)(sr * (int)ldk + sc) * 2u;
  const int klo0 = sr * 256 + ((sc * 2) ^ ((sr & 15) << 4));
  const int vb0 = (int)(uintptr_t)V_lds + v_rd_base(lane);
  const int qi = q0 + wid * 32 + r32;
  bf16x8 vsA0, vsA1, ksA[KPT], vsB0, vsB1, ksB[KPT];
#define KLOADS(KS, k0) do { const char* kb_ = (const char*)Kh + (long)(k0) * ldk * 2; KS[0] = *(const AGAS bf16x8*)(kb_ + kgo0); KS[1] = *(const AGAS bf16x8*)(kb_ + 32 * ldk * 2 + kgo0); } while (0)
#define KWRITES(KS, b) do { *(bf16x8*)(K_lds + (b) * SHM_K + klo0) = KS[0]; *(bf16x8*)(K_lds + (b) * SHM_K + 8192 + klo0) = KS[1]; } while (0)
#define SLOAD_A(k0) do { const char* vb_ = (const char*)Vh + (long)(k0) * ldv * 2; vsA0 = *(const AGAS bf16x8*)(vb_ + vgo0); vsA1 = *(const AGAS bf16x8*)(vb_ + 32 * ldv * 2 + vgo0); KLOADS(ksA, k0); } while (0)
#define SLOAD_B(k0) do { const char* vb_ = (const char*)Vh + (long)(k0) * ldv * 2; vsB0 = *(const AGAS bf16x8*)(vb_ + vgo0); vsB1 = *(const AGAS bf16x8*)(vb_ + 32 * ldv * 2 + vgo0); KLOADS(ksB, k0); } while (0)
#define SWRITE_A(b) do { *(bf16x8*)(V_lds + (b) * SHM_V + vst0) = vsA0; *(bf16x8*)(V_lds + (b) * SHM_V + 8192 + vst0) = vsA1; KWRITES(ksA, b); } while (0)
#define SWRITE_B(b) do { *(bf16x8*)(V_lds + (b) * SHM_V + vst0) = vsB0; *(bf16x8*)(V_lds + (b) * SHM_V + 8192 + vst0) = vsB1; KWRITES(ksB, b); } while (0)
#define SLOAD_E(k0) SLOAD_A(k0)
#define SWRITE_E(b) SWRITE_A(b)
#define SLOAD_O(k0) do { if constexpr (SD == 2) { SLOAD_B(k0); } else { SLOAD_A(k0); } } while (0)
#define SWRITE_O(b) do { if constexpr (SD == 2) { SWRITE_B(b); } else { SWRITE_A(b); } } while (0)
#define SWAIT() do { if constexpr (SD == 2) { if constexpr (KPT == 2) asm volatile("s_waitcnt vmcnt(4)" ::: "memory"); else asm volatile("s_waitcnt vmcnt(5)" ::: "memory"); } else asm volatile("s_waitcnt vmcnt(0)" ::: "memory"); } while (0)
#define RESC(a) do { if (__any((a) < 1.f)) { if (hi == 0) al_l[r32] = (a); asm volatile("s_waitcnt lgkmcnt(0)" ::: "memory"); \
    _Pragma("unroll") for (int d = 0; d < 4; ++d) _Pragma("unroll") for (int r = 0; r < 16; ++r) o[d][r] *= al_l[crow(r, hi)]; } } while (0)
#define BMASK(P0, P1, t) do { if constexpr (BAND) bandmask(P0, P1, (kt0 + (t)) * 64, qi, hi, slope_raw); } while (0)
  f32x16 pA0, pA1, pB0, pB1; float mnA, mnB, alA, alB; bf16x8 pa0, pa1, pa2, pa3;
  const int kbase = kt0 * 64;
  SLOAD_E(kbase); asm volatile("s_waitcnt vmcnt(0)" ::: "memory"); SWRITE_E(0); __syncthreads();
  qkt<DQK>(pA0, pA1, K_lds, qr, r32, hi); BMASK(pA0, pA1, 0); partialSM(pA0, pA1, m_reg, mnA, alA, C, thr_raw);
  SLOAD_O(kbase + 64); if constexpr (SD == 2) { if (2 < NT) SLOAD_E(kbase + 128); }
  SWAIT(); SWRITE_O(1); __syncthreads();
  for (int j = 1; j + 1 < NT; j += 2) {
    SBAR(); qkt<DQK>(pB0, pB1, K_lds + SHM_K, qr, r32, hi); BMASK(pB0, pB1, j);
    finishSM(pA0, pA1, alA, l_reg, pa0, pa1, pa2, pa3); SBAR();
    SLOAD_O(kbase + (j + SD) * 64); SBAR();
    pv_d0(o, vb0, pa0, pa1, pa2, pa3); partialSM(pB0, pB1, m_reg, mnB, alB, C, thr_raw);
    __syncthreads(); SWAIT(); SWRITE_E(0);
    RESC(alB); __syncthreads();
    SBAR(); qkt<DQK>(pA0, pA1, K_lds, qr, r32, hi); BMASK(pA0, pA1, j + 1);
    finishSM(pB0, pB1, alB, l_reg, pa0, pa1, pa2, pa3); SBAR();
    if (SD == 1 || j + 3 < NT) SLOAD_E(kbase + (j + 1 + SD) * 64); SBAR();
    pv_d0(o, vb0 + SHM_V, pa0, pa1, pa2, pa3); partialSM(pA0, pA1, m_reg, mnA, alA, C, thr_raw);
    __syncthreads(); SWAIT(); SWRITE_O(1);
    RESC(alA); __syncthreads();
  }
  SBAR(); qkt<DQK>(pB0, pB1, K_lds + SHM_K, qr, r32, hi); BMASK(pB0, pB1, NT - 1);
  finishSM(pA0, pA1, alA, l_reg, pa0, pa1, pa2, pa3); SBAR();
  pv_d0(o, vb0, pa0, pa1, pa2, pa3); partialSM(pB0, pB1, m_reg, mnB, alB, C, thr_raw);
  __syncthreads(); RESC(alB);
  finishSM(pB0, pB1, alB, l_reg, pa0, pa1, pa2, pa3); SBAR();
  pv_d0(o, vb0 + SHM_V, pa0, pa1, pa2, pa3);
  if (hi == 0) li_l[r32] = l_reg; asm volatile("s_waitcnt lgkmcnt(0)" ::: "memory");
  if constexpr (BAND) { if (hi == 0) *(AGAS float*)(lse + (long)(wid * 32 + r32) * ld_lse) = m_reg * scale + __logf(l_reg); }
  float rli[16];
#pragma unroll
  for (int r = 0; r < 16; ++r) rli[r] = __builtin_amdgcn_rcpf(li_l[crow(r, hi)]);
  bf16_t* Ow = Ob + (long)(wid * 32) * ldo;
  {
    char* stg = lds + 2 * SHM_V + 2 * SHM_K + 2048 + wid * 4608;
#pragma unroll
    for (int h = 0; h < 2; ++h) {
#pragma unroll
      for (int r = 0; r < 16; ++r) { const int orow = crow(r, hi);
#pragma unroll
        for (int dd = 0; dd < 2; ++dd) { const float v = o[2 * h + dd][r] * rli[r]; *(bf16_t*)(stg + orow * 144 + (dd * 32 + r32) * 2) = (bf16_t)(cvtpk(v, v) & 0xffffu); } }
      asm volatile("s_waitcnt lgkmcnt(0)" ::: "memory");
#pragma unroll
      for (int i = 0; i < 4; ++i) { const int row = i * 8 + (lane >> 3), ch = lane & 7; const u32x4 v = *(const u32x4*)(stg + row * 144 + ch * 16);
        *(AGAS u32x4*)(Ow + (long)row * ldo + h * 64 + ch * 8) = v; }
      asm volatile("s_waitcnt lgkmcnt(0)" ::: "memory");
    } }
  __syncthreads();
#undef KLOADS
#undef KWRITES
#undef SLOAD_A
#undef SLOAD_B
#undef SWRITE_A
#undef SWRITE_B
#undef SLOAD_E
#undef SWRITE_E
#undef SLOAD_O
#undef SWRITE_O
#undef SWAIT
#undef RESC
#undef BMASK
}

template <int DQK, bool BAND>
__device__ __forceinline__ void attn_unit_simple(const bf16_t* __restrict__ Qb, long ldq, const bf16_t* __restrict__ Kh, long ldk, const bf16_t* __restrict__ Vh, long ldv,
                                                 bf16_t* Ob, long ldo, int kt0, int NT, float scale, int q0, float slope_raw, float* lse, long ld_lse, char* lds) {
  constexpr int ND = DQK / 16, NKC = DQK / 8, KPT = NKC / 8;
  constexpr int KST = DQK * 2, SWM = (DQK == 128) ? 15 : 7;
  constexpr int SHM_V = 64 * 128 * 2, SHM_K = 64 * KST;
  int tid_ = threadIdx.x; asm volatile("" : "+v"(tid_));
  const int tid = tid_, wid = tid >> 6, lane = tid & 63, r32 = lane & 31, hi = lane >> 5;
  char* V_lds = lds; char* K_lds = lds + 2 * SHM_V;
  float* ws = (float*)(lds + 2 * SHM_V + 2 * SHM_K) + wid * 64; float* li_l = ws; float* al_l = ws + 32;
  const float C = scale * 1.4426950408889634f, thr_raw = 8.f / scale;
  float m_reg = BAND ? MASKV : -1e30f, l_reg = 0; f32x16 o[4] = {}; bf16x8 qr[ND];
  const bf16_t* Qw = Qb + (long)(wid * 32 + r32) * ldq + hi * 8;
#pragma unroll
  for (int d0 = 0; d0 < ND; ++d0) qr[d0] = *(const AGAS bf16x8*)(Qw + d0 * 16);
  const int sr = tid >> 4, sc = (tid & 15) * 8, vst0 = v_st(sr, sc), vst1 = v_st(32 + sr, sc);
  const unsigned vgo0 = (unsigned)(sr * (int)ldv + sc) * 2u, vgo1 = vgo0 + (unsigned)(32 * (int)ldv) * 2u;
  unsigned kgo[KPT]; int klo[KPT];
#pragma unroll
  for (int i = 0; i < KPT; ++i) { const int c = tid + 512 * i, row = c / NKC, cc = c % NKC; kgo[i] = (unsigned)(row * (int)ldk + cc * 8) * 2u; klo[i] = row * KST + ((cc * 16) ^ ((row & SWM) << 4)); }
  const int vb0 = (int)(uintptr_t)V_lds + v_rd_base(lane);
  const int qi = q0 + wid * 32 + r32;
  bf16x8 vsA0, vsA1, ksA[KPT], vsB0, vsB1, ksB[KPT];
#define SLOADX(VS0, VS1, KS, t) do { const char* vb_ = (const char*)Vh + (long)(kt0 + (t)) * 64 * ldv * 2; const char* kb_ = (const char*)Kh + (long)(kt0 + (t)) * 64 * ldk * 2; \
    VS0 = *(const AGAS bf16x8*)(vb_ + vgo0); VS1 = *(const AGAS bf16x8*)(vb_ + vgo1); \
    _Pragma("unroll") for (int i_ = 0; i_ < KPT; ++i_) KS[i_] = *(const AGAS bf16x8*)(kb_ + kgo[i_]); } while (0)
#define SWRITEX(VS0, VS1, KS, b) do { *(bf16x8*)(V_lds + (b) * SHM_V + vst0) = VS0; *(bf16x8*)(V_lds + (b) * SHM_V + vst1) = VS1; \
    _Pragma("unroll") for (int i_ = 0; i_ < KPT; ++i_) *(bf16x8*)(K_lds + (b) * SHM_K + klo[i_]) = KS[i_]; } while (0)
  f32x16 p0, p1; float mn, al; bf16x8 pa0, pa1, pa2, pa3;
#define STEP(j, b) do { \
    bool active = true; \
    if constexpr (BAND) { const int kb = (kt0 + (j)) * 64, qw0 = q0 + wid * 32; active = (kb <= qw0 + 31 + 64) && (kb + 63 >= qw0 - 64); } \
    if (active) { \
      qkt<DQK>(p0, p1, K_lds + (b) * SHM_K, qr, r32, hi); \
      if constexpr (BAND) bandmask(p0, p1, (kt0 + (j)) * 64, qi, hi, slope_raw); \
      partialSM(p0, p1, m_reg, mn, al, C, thr_raw); \
      if (__any(al < 1.f)) { if (hi == 0) al_l[r32] = al; asm volatile("s_waitcnt lgkmcnt(0)" ::: "memory"); \
        _Pragma("unroll") for (int d = 0; d < 4; ++d) _Pragma("unroll") for (int r = 0; r < 16; ++r) o[d][r] *= al_l[crow(r, hi)]; } \
      finishSM(p0, p1, al, l_reg, pa0, pa1, pa2, pa3); SBAR(); \
      pv_d0(o, vb0 + (b) * SHM_V, pa0, pa1, pa2, pa3); \
    } } while (0)
  constexpr bool TWO = (DQK == 128);
  SLOADX(vsA0, vsA1, ksA, 0); SWRITEX(vsA0, vsA1, ksA, 0);
  if constexpr (TWO) {
    if (1 < NT) SLOADX(vsB0, vsB1, ksB, 1);
    for (int j = 0; j < NT; j += 2) {
      __syncthreads();
      if (j + 2 < NT) SLOADX(vsA0, vsA1, ksA, j + 2);
      STEP(j, 0);
      if (j + 1 < NT) SWRITEX(vsB0, vsB1, ksB, 1);
      if (j + 1 >= NT) break;
      __syncthreads();
      if (j + 3 < NT) SLOADX(vsB0, vsB1, ksB, j + 3);
      STEP(j + 1, 1);
      if (j + 2 < NT) SWRITEX(vsA0, vsA1, ksA, 0);
    }
  } else {
    for (int j = 0; j < NT; ++j) {
      const int b = j & 1;
      __syncthreads();
      if (j + 1 < NT) SLOADX(vsA0, vsA1, ksA, j + 1);
      STEP(j, b);
      if (j + 1 < NT) SWRITEX(vsA0, vsA1, ksA, b ^ 1);
    }
  }
  if (hi == 0) li_l[r32] = l_reg; asm volatile("s_waitcnt lgkmcnt(0)" ::: "memory");
  if constexpr (BAND) { if (hi == 0) *(AGAS float*)(lse + (long)(wid * 32 + r32) * ld_lse) = m_reg * scale + __logf(l_reg); }
  float rli[16];
#pragma unroll
  for (int r = 0; r < 16; ++r) rli[r] = __builtin_amdgcn_rcpf(li_l[crow(r, hi)]);
  bf16_t* Ow = Ob + (long)(wid * 32) * ldo;
  if constexpr (true)
  {
    char* stg = lds + 2 * SHM_V + 2 * SHM_K + 2048 + wid * 4608;
#pragma unroll
    for (int h = 0; h < 2; ++h) {
#pragma unroll
      for (int r = 0; r < 16; ++r) { const int orow = crow(r, hi);
#pragma unroll
        for (int dd = 0; dd < 2; ++dd) { const float v = o[2 * h + dd][r] * rli[r]; *(bf16_t*)(stg + orow * 144 + (dd * 32 + r32) * 2) = (bf16_t)(cvtpk(v, v) & 0xffffu); } }
      asm volatile("s_waitcnt lgkmcnt(0)" ::: "memory");
#pragma unroll
      for (int i = 0; i < 4; ++i) { const int row = i * 8 + (lane >> 3), ch = lane & 7; const u32x4 v = *(const u32x4*)(stg + row * 144 + ch * 16);
        *(AGAS u32x4*)(Ow + (long)row * ldo + h * 64 + ch * 8) = v; }
      asm volatile("s_waitcnt lgkmcnt(0)" ::: "memory");
    } }
  else {
#pragma unroll
  for (int r = 0; r < 16; ++r) { const int orow = crow(r, hi);
#pragma unroll
    for (int d0 = 0; d0 < 4; ++d0) { const float v = o[d0][r] * rli[r]; *(AGAS bf16_t*)(Ow + (long)orow * ldo + d0 * 32 + r32) = (bf16_t)(cvtpk(v, v) & 0xffffu); } }
  }
  __syncthreads();
#undef SLOADX
#undef SWRITEX
#undef STEP
}
#undef SBAR
}

#define LAS __attribute__((address_space(3)))
#define GAS __attribute__((address_space(1)))
typedef unsigned short bf16_t;
typedef float f32x4 __attribute__((ext_vector_type(4)));
typedef unsigned u32x4 __attribute__((ext_vector_type(4)));
typedef unsigned u32x2 __attribute__((ext_vector_type(2)));

constexpr int DM = 2048, NB = 8, SEQ = 4096, M = NB * SEQ, DFF = 5632, WIN_N = 6976, ZP = 7168, DEPTH = 2;
constexpr int CQR = 512, CKVR = 256, CQW = 768, CKVW = 1024;
constexpr float EPS = 1e-6f;
constexpr int NWAVES = 8;
constexpr size_t MiB = 1u << 20;
constexpr size_t WS_ROPE_A = 0;
constexpr size_t WS_ROPE_C = 64 * 1024;
constexpr size_t WS_BAR = 1152 * 1024;
constexpr size_t WS_SS = 1216 * 1024;
constexpr size_t WS_WB = 2 * MiB;
constexpr size_t WB_GU1 = 0, WB_D1 = WB_GU1 + (size_t)2 * DFF * DM * 2, WB_IN = WB_D1 + (size_t)DM * DFF * 2, WB_OUT = WB_IN + (size_t)ZP * DM * 2,
                 WB_GU2 = WB_OUT + (size_t)DM * DM * 2, WB_D2 = WB_GU2 + (size_t)2 * DFF * DM * 2, WB_CQ = WB_D2 + (size_t)DM * DFF * 2, WB_CKV = WB_CQ + (size_t)CQW * CQR * 2,
                 WB_END = WB_CKV + (size_t)CKVW * CKVR * 2;
static_assert(WB_END <= 170 * MiB, "weights");
constexpr size_t WS_XN = 172 * MiB;
constexpr size_t WS_LSE = 300 * MiB;
constexpr size_t WS_CQA = 302 * MiB;
constexpr size_t WS_CKVA = 334 * MiB;
constexpr size_t WS_CQ = 350 * MiB;
constexpr size_t WS_CKV = 398 * MiB;
constexpr size_t WS_KC = 462 * MiB;
constexpr size_t WS_Z = 510 * MiB;
constexpr size_t WS_END = WS_Z + (size_t)M * ZP * 2;
static_assert(WS_END <= 1024 * MiB, "ws");
constexpr int LDS_BYTES = 147456;

__device__ __forceinline__ float wave_sum(float v) {
#pragma unroll
  for (int o = 1; o < 64; o <<= 1) v += __shfl_xor(v, o);
  return v;
}
__device__ __forceinline__ float bf2f(unsigned h) { return __uint_as_float(h << 16); }
__device__ __forceinline__ unsigned pk2(float lo, float hi) { return pg8::cvt_pk_bf16(lo, hi); }
__device__ __forceinline__ void unpack8(u32x4 w, float* x) {
  x[0] = __uint_as_float(w.x << 16); x[1] = __uint_as_float(w.x & 0xffff0000u); x[2] = __uint_as_float(w.y << 16); x[3] = __uint_as_float(w.y & 0xffff0000u);
  x[4] = __uint_as_float(w.z << 16); x[5] = __uint_as_float(w.z & 0xffff0000u); x[6] = __uint_as_float(w.w << 16); x[7] = __uint_as_float(w.w & 0xffff0000u);
}
__device__ __forceinline__ u32x4 pack8(const float* x) { u32x4 w; w.x = pk2(x[0], x[1]); w.y = pk2(x[2], x[3]); w.z = pk2(x[4], x[5]); w.w = pk2(x[6], x[7]); return w; }

__device__ __forceinline__ int dest_row(int n0, int mode) {
  if (mode == 0) return n0;
  return n0 < DFF ? 256 * (n0 / 128) + (n0 % 128) : 256 * ((n0 - DFF) / 128) + 128 + ((n0 - DFF) % 128);
}
__device__ __forceinline__ void transpose_item(const float* W, int K, int N, bf16_t* WT, int mode, const float* gain, LAS float* scr, int item, int lane) {
  const int nblk = N / 32, kb = item / nblk, nb = item % nblk, k0 = 64 * kb, n0 = 32 * nb;
  const int dr0 = dest_row(n0, mode);
#pragma unroll 16
  for (int i = 0; i < 32; ++i) { const int kk = 2 * i + (lane >> 5); scr[kk * 33 + (lane & 31)] = *(const GAS float*)(W + (size_t)(k0 + kk) * N + n0 + (lane & 31)); }
  asm volatile("s_waitcnt lgkmcnt(0)" ::: "memory");
  const int c = lane & 7;
  f32x4 ga = (f32x4){1.f, 1.f, 1.f, 1.f}, gb = ga;
  if (gain) { ga = *(const GAS f32x4*)(gain + k0 + 8 * c); gb = *(const GAS f32x4*)(gain + k0 + 8 * c + 4); }
#pragma unroll
  for (int j = 0; j < 4; ++j) { const int n = (lane >> 3) + 8 * j; const LAS float* s = scr + (8 * c) * 33 + n;
    u32x4 o; o.x = pk2(s[0 * 33] * ga.x, s[1 * 33] * ga.y); o.y = pk2(s[2 * 33] * ga.z, s[3 * 33] * ga.w); o.z = pk2(s[4 * 33] * gb.x, s[5 * 33] * gb.y); o.w = pk2(s[6 * 33] * gb.z, s[7 * 33] * gb.w);
    *(GAS u32x4*)(WT + (size_t)(dr0 + n) * K + k0 + 8 * c) = o; }
  asm volatile("s_waitcnt lgkmcnt(0)" ::: "memory");
}

struct Args { const float* in[21]; float* out; unsigned char* ws; };
template <class T> __device__ __forceinline__ T* asglobal(T* p) { return (T*)(__attribute__((address_space(1))) T*)p; }
constexpr int LDS_PTAB = 131072;
struct PT {
  LAS const unsigned long long* t; float* out; unsigned char* ws;
  __device__ __forceinline__ const float* in(int k) const { const unsigned long long v = t[k];
    const unsigned lo = __builtin_amdgcn_readfirstlane((unsigned)v), hi = __builtin_amdgcn_readfirstlane((unsigned)(v >> 32));
    return asglobal((const float*)(((unsigned long long)hi << 32) | lo)); }
};

__device__ __forceinline__ void norm_rows(const float* X, const float* g, bf16_t* out, int gw, int NGW, int lane) {
  asm volatile("" : "+v"(lane));
  f32x4 gv[8];
#pragma unroll
  for (int j = 0; j < 8; ++j) gv[j] = ((const GAS f32x4*)g)[lane + 64 * j];
  for (int m = gw; m < M; m += NGW) {
    const GAS f32x4* xr = (const GAS f32x4*)(X + (size_t)m * DM) + lane;
    f32x4 v[8]; float s = 0.f;
#pragma unroll
    for (int j = 0; j < 8; ++j) { v[j] = xr[64 * j]; s += (v[j].x * v[j].x + v[j].y * v[j].y) + (v[j].z * v[j].z + v[j].w * v[j].w); }
    const float r = rsqrtf(wave_sum(s) * (1.f / DM) + EPS);
    GAS u32x2* o = (GAS u32x2*)(out + (size_t)m * DM) + lane;
#pragma unroll
    for (int j = 0; j < 8; ++j) { u32x2 w; w.x = pk2(v[j].x * r * gv[j].x, v[j].y * r * gv[j].y); w.y = pk2(v[j].z * r * gv[j].z, v[j].w * r * gv[j].w); o[64 * j] = w; }
  }
}

__device__ __forceinline__ void xb_init_rows(const float* X, bf16_t* xb, float* ss, int rb0, int lw, int nlw, int lane)     {
  asm volatile("" : "+v"(lane));
  for (int m = rb0 + lw; m < rb0 + SEQ; m += nlw) {
    const GAS f32x4* xr = (const GAS f32x4*)(X + (size_t)m * DM) + lane;
    f32x4 v[8]; float s = 0.f;
#pragma unroll
    for (int j = 0; j < 8; ++j) { v[j] = xr[64 * j]; s += (v[j].x * v[j].x + v[j].y * v[j].y) + (v[j].z * v[j].z + v[j].w * v[j].w); }
    s = wave_sum(s);
    GAS u32x2* o = (GAS u32x2*)(xb + (size_t)m * DM) + lane;
#pragma unroll
    for (int j = 0; j < 8; ++j) { u32x2 w; w.x = pk2(v[j].x, v[j].y); w.y = pk2(v[j].z, v[j].w); o[64 * j] = w; }
    if (lane == 0) *(GAS unsigned long long*)((unsigned long long*)ss + m) = (unsigned long long)(s * pg8::SS_SCALE);
  }
}
__device__ __forceinline__ void zero_f32(float* p, int n, int gtid, int nthreads) { for (int i = gtid; i < n; i += nthreads) *(GAS float*)(p + i) = 0.f; }

__device__ __forceinline__ void convert_weights(const PT& a, int l, LAS unsigned char* lds, int gw, int NGW, int wave, int lane) {
  asm volatile("" : "+v"(lane));
  LAS float* scr = (LAS float*)(lds + wave * 16384);
  unsigned char* wb = a.ws + WS_WB;
  const int I_GU = (DM / 64) * (2 * DFF / 32), I_D = (DFF / 64) * (DM / 32), I_IN = (DM / 64) * (WIN_N / 32), I_OUT = (DM / 64) * (DM / 32),
            I_CQ = (CQR / 64) * (CQW / 32), I_CKV = (CKVR / 64) * (CKVW / 32);
  const int NIT = 2 * I_GU + 2 * I_D + I_IN + I_OUT + I_CQ + I_CKV;
  for (int it = gw; it < NIT; it += NGW) {
    int r = it;
    if (r < I_GU) { transpose_item(a.in(2) + (size_t)l * DM * 2 * DFF, DM, 2 * DFF, (bf16_t*)(wb + WB_GU1), 1, a.in(1) + l * DM, scr, r, lane); continue; } r -= I_GU;
    if (r < I_GU) { transpose_item(a.in(19) + (size_t)l * DM * 2 * DFF, DM, 2 * DFF, (bf16_t*)(wb + WB_GU2), 1, a.in(18) + l * DM, scr, r, lane); continue; } r -= I_GU;
    if (r < I_D) { transpose_item(a.in(3) + (size_t)l * DFF * DM, DFF, DM, (bf16_t*)(wb + WB_D1), 0, nullptr, scr, r, lane); continue; } r -= I_D;
    if (r < I_D) { transpose_item(a.in(20) + (size_t)l * DFF * DM, DFF, DM, (bf16_t*)(wb + WB_D2), 0, nullptr, scr, r, lane); continue; } r -= I_D;
    if (r < I_IN) { transpose_item(a.in(5) + (size_t)l * DM * WIN_N, DM, WIN_N, (bf16_t*)(wb + WB_IN), 0, a.in(4) + l * DM, scr, r, lane); continue; } r -= I_IN;
    if (r < I_OUT) { transpose_item(a.in(17) + (size_t)l * DM * DM, DM, DM, (bf16_t*)(wb + WB_OUT), 0, nullptr, scr, r, lane); continue; } r -= I_OUT;
    if (r < I_CQ) { transpose_item(a.in(11) + (size_t)l * CQR * CQW, CQR, CQW, (bf16_t*)(wb + WB_CQ), 0, nullptr, scr, r, lane); continue; } r -= I_CQ;
    transpose_item(a.in(13) + (size_t)l * CKVR * CKVW, CKVR, CKVW, (bf16_t*)(wb + WB_CKV), 0, nullptr, scr, r, lane);
  }
  GAS u32x4* pad = (GAS u32x4*)(wb + WB_IN + (size_t)WIN_N * DM * 2);
  for (int i = gw * 64 + lane; i < (ZP - WIN_N) * DM * 2 / 16; i += NGW * 64) pad[i] = (u32x4){0u, 0u, 0u, 0u};
}

__device__ __forceinline__ void rope_tables(unsigned char* ws, int gtid, int nthreads) {
  GAS float* ta = (GAS float*)(ws + WS_ROPE_A); GAS float* tc = (GAS float*)(ws + WS_ROPE_C);
  for (int i = gtid; i < SEQ * 32; i += nthreads) {
    const int pos = i >> 5, f = i & 31;
    const float inv = powf(10000.0f, -(float)f / 32.0f);
    const float ang = (float)pos * inv;
    const float c = cosf(ang), s = sinf(ang);
    tc[i] = c; tc[SEQ * 32 + i] = s;
    if (pos < 64) { ta[i] = c; ta[64 * 32 + i] = s; }
  }
}

__device__ __forceinline__ void ld8f(const float* p, float* g) { const f32x4 g0 = *(const GAS f32x4*)p, g1 = *(const GAS f32x4*)(p + 4);
  g[0] = g0.x; g[1] = g0.y; g[2] = g0.z; g[3] = g0.w; g[4] = g1.x; g[5] = g1.y; g[6] = g1.z; g[7] = g1.w; }
__device__ __forceinline__ void prep_rows(const PT& a, int l, int rb0, int lw, int nlw, int lane)     {
  asm volatile("" : "+v"(lane));
  bf16_t* Z = (bf16_t*)(a.ws + WS_Z); bf16_t* CQA = (bf16_t*)(a.ws + WS_CQA); bf16_t* CKVA = (bf16_t*)(a.ws + WS_CKVA);
  const float* ta = (const float*)(a.ws + WS_ROPE_A);
  const int j = lane & 15, hq = lane >> 4;
  float gaq[8], gak[8], gbq[8], gbk[8], gcq[8];
  ld8f(a.in(6) + l * 128 + 8 * j, gaq); ld8f(a.in(7) + l * 128 + 8 * j, gak); ld8f(a.in(8) + l * 128 + 8 * j, gbq); ld8f(a.in(9) + l * 128 + 8 * j, gbk);
  ld8f(a.in(10) + l * CQR + 8 * lane, gcq);
  const f32x4 gckv = *(const GAS f32x4*)(a.in(12) + l * CKVR + 4 * lane);
  constexpr int RR = 1;
  for (int m0 = rb0 + lw * RR; m0 < rb0 + SEQ; m0 += nlw * RR) {
    u32x4 raw[RR][9], rawq[RR]; u32x2 rawkv[RR]; f32x4 tcs[RR][4];
#pragma unroll
    for (int rr = 0; rr < RR; ++rr) { const int m = m0 + rr; const bf16_t* zr = Z + (size_t)m * ZP; const int t = m % SEQ, prow = t >> 6, pcol = t & 63;
#pragma unroll
      for (int it = 0; it < 9; ++it) { int hh = it * 4 + hq; hh = hh < 34 ? hh : 33; const int col = hh < 10 ? hh * 128 : 1536 + (hh - 10) * 128; raw[rr][it] = *(const GAS u32x4*)(zr + col + 8 * j); }
      rawq[rr] = *(const GAS u32x4*)(zr + 6144 + 8 * lane); rawkv[rr] = *(const GAS u32x2*)(zr + 6656 + 4 * lane);
      const int pos = (j < 8) ? prow : pcol; const int fi = 8 * (j & 3);
      tcs[rr][0] = *(const GAS f32x4*)(ta + pos * 32 + fi); tcs[rr][1] = *(const GAS f32x4*)(ta + pos * 32 + fi + 4);
      tcs[rr][2] = *(const GAS f32x4*)(ta + 2048 + pos * 32 + fi); tcs[rr][3] = *(const GAS f32x4*)(ta + 2048 + pos * 32 + fi + 4); }
#pragma unroll
    for (int rr = 0; rr < RR; ++rr) { const int m = m0 + rr; bf16_t* zr = Z + (size_t)m * ZP;
#pragma unroll
      for (int it = 0; it < 9; ++it) {
        const int hh = it * 4 + hq; const bool act = hh < 34; const bool isA = hh < 10; const int hb = hh - 10;
        const int col = isA ? hh * 128 : 1536 + hb * 128;
        float x[8]; unpack8(raw[rr][it], x);
        float ss = 0.f;
#pragma unroll
        for (int e = 0; e < 8; ++e) ss += x[e] * x[e];
        ss += __shfl_xor(ss, 1); ss += __shfl_xor(ss, 2); ss += __shfl_xor(ss, 4); ss += __shfl_xor(ss, 8);
        const float r = rsqrtf(ss * (1.f / 128.f) + EPS);
        float y[8];
#pragma unroll
        for (int e = 0; e < 8; ++e) { const float g = isA ? (hh < 8 ? gaq[e] : gak[e]) : (hb < 12 ? gbq[e] : gbk[e]); y[e] = x[e] * r * g; }
        if (it < 3) {
          float xp[8];
#pragma unroll
          for (int e = 0; e < 8; ++e) xp[e] = __shfl_xor(y[e], 4);
          if (isA) {
            const float cs[8] = {tcs[rr][0].x, tcs[rr][0].y, tcs[rr][0].z, tcs[rr][0].w, tcs[rr][1].x, tcs[rr][1].y, tcs[rr][1].z, tcs[rr][1].w};
            const float sn[8] = {tcs[rr][2].x, tcs[rr][2].y, tcs[rr][2].z, tcs[rr][2].w, tcs[rr][3].x, tcs[rr][3].y, tcs[rr][3].z, tcs[rr][3].w};
            const bool first = (j & 4) == 0;
#pragma unroll
            for (int e = 0; e < 8; ++e) y[e] = first ? (y[e] * cs[e] - xp[e] * sn[e]) : (xp[e] * sn[e] + y[e] * cs[e]);
          }
        }
        if (act) *(GAS u32x4*)(zr + col + 8 * j) = pack8(y);
      }
      { float x[8]; unpack8(rawq[rr], x); float ss = 0.f;
#pragma unroll
        for (int e = 0; e < 8; ++e) ss += x[e] * x[e];
        const float r = rsqrtf(wave_sum(ss) * (1.f / CQR) + EPS);
        float y[8];
#pragma unroll
        for (int e = 0; e < 8; ++e) y[e] = x[e] * r * gcq[e];
        *(GAS u32x4*)(CQA + (size_t)m * CQR + 8 * lane) = pack8(y); }
      { const u32x2 w = rawkv[rr];
        const float x0 = __uint_as_float(w.x << 16), x1 = __uint_as_float(w.x & 0xffff0000u), x2 = __uint_as_float(w.y << 16), x3 = __uint_as_float(w.y & 0xffff0000u);
        const float r = rsqrtf(wave_sum((x0 * x0 + x1 * x1) + (x2 * x2 + x3 * x3)) * (1.f / CKVR) + EPS);
        u32x2 o; o.x = pk2(x0 * r * gckv.x, x1 * r * gckv.y); o.y = pk2(x2 * r * gckv.z, x3 * r * gckv.w);
        *(GAS u32x2*)(CKVA + (size_t)m * CKVR + 4 * lane) = o; }
    }
  }
}

__device__ __forceinline__ void cpost_rows(const PT& a, int l, int rb0, int lw, int nlw, int lane)     {
  asm volatile("" : "+v"(lane));
  bf16_t* Z = (bf16_t*)(a.ws + WS_Z); bf16_t* CQ = (bf16_t*)(a.ws + WS_CQ); bf16_t* CKV = (bf16_t*)(a.ws + WS_CKV); bf16_t* KC = (bf16_t*)(a.ws + WS_KC);
  const float* tc = (const float*)(a.ws + WS_ROPE_C);
  const bool act = lane < 48; const int e0 = 4 * lane; const bool isrope = lane >= 32 && act, first = lane < 40;
  const int ri = 4 * ((lane - 32) & 7);
  const f32x4 z4 = {0.f, 0.f, 0.f, 0.f};
  const f32x4 gqv = act ? *(const GAS f32x4*)(a.in(14) + l * 192 + e0) : z4, gkv = act ? *(const GAS f32x4*)(a.in(15) + l * 192 + e0) : z4;
  constexpr int RR = 4;
  for (int m0 = rb0 + lw * RR; m0 < rb0 + SEQ; m0 += nlw * RR) {
    u32x2 rq[RR][4], rk[RR][4]; f32x4 csv[RR], snv[RR]; const u32x2 zz = {0u, 0u};
#pragma unroll
    for (int rr = 0; rr < RR; ++rr) { const int m = m0 + rr, t = m % SEQ;
      csv[rr] = *(const GAS f32x4*)(tc + t * 32 + ri); snv[rr] = *(const GAS f32x4*)(tc + SEQ * 32 + t * 32 + ri);
#pragma unroll
      for (int h = 0; h < 4; ++h) {
        rq[rr][h] = act ? *(const GAS u32x2*)(CQ + (size_t)m * CQW + h * 192 + e0) : zz;
        const bf16_t* ksrc = lane < 32 ? CKV + (size_t)m * CKVW + h * 256 + e0 : Z + (size_t)m * ZP + 6912 + (e0 - 128);
        rk[rr][h] = act ? *(const GAS u32x2*)ksrc : zz; } }
#pragma unroll
    for (int rr = 0; rr < RR; ++rr) { const int m = m0 + rr;
#pragma unroll
      for (int h = 0; h < 4; ++h) {
#pragma unroll
        for (int qk = 0; qk < 2; ++qk) {
          const u32x2 w = qk == 0 ? rq[rr][h] : rk[rr][h]; const f32x4 g = qk == 0 ? gqv : gkv;
          const f32x4 x = {__uint_as_float(w.x << 16), __uint_as_float(w.x & 0xffff0000u), __uint_as_float(w.y << 16), __uint_as_float(w.y & 0xffff0000u)};
          const float r = rsqrtf(wave_sum((x.x * x.x + x.y * x.y) + (x.z * x.z + x.w * x.w)) * (1.f / 192.f) + EPS);
          f32x4 y = x * r * g;
          f32x4 yp; yp.x = __shfl_xor(y.x, 8); yp.y = __shfl_xor(y.y, 8); yp.z = __shfl_xor(y.z, 8); yp.w = __shfl_xor(y.w, 8);
          if (isrope) y = first ? (y * csv[rr] - yp * snv[rr]) : (yp * snv[rr] + y * csv[rr]);
          u32x2 o; o.x = pk2(y.x, y.y); o.y = pk2(y.z, y.w);
          bf16_t* dst = qk == 0 ? CQ + (size_t)m * CQW + h * 192 + e0 : KC + (size_t)m * CQW + h * 192 + e0;
          if (act) *(GAS u32x2*)dst = o;
        }
      }
    }
  }
}

__device__ __forceinline__ void ynorm_rows(const PT& a, int l, bf16_t* Y, int rb0, int lw, int nlw, int lane)     {
  asm volatile("" : "+v"(lane));
  const bf16_t* Z = (const bf16_t*)(a.ws + WS_Z); const bf16_t* OC = (const bf16_t*)(a.ws + WS_CQA); const GAS float* LSE = (const GAS float*)(a.ws + WS_LSE);
  const float* gn = a.in(16) + l * DM;
  float gA0[8], gA1[8], gB[8], gC[8];
  ld8f(gn + 8 * lane, gA0); ld8f(gn + 512 + 8 * lane, gA1); ld8f(gn + 1024 + 8 * lane, gB); ld8f(gn + 1536 + 8 * lane, gC);
  const int jh = lane >> 4, d = (lane & 15) * 8;
  constexpr int RR = 2;
  for (int m0 = rb0 + lw * RR; m0 < rb0 + SEQ; m0 += nlw * RR) {
    u32x4 ra0[RR], ra1[RR], rb0[RR], rb1[RR], rb2[RR], rc[RR]; float l0[RR], l1[RR], l2[RR];
#pragma unroll
    for (int rr = 0; rr < RR; ++rr) { const int m = m0 + rr; const bf16_t* zr = Z + (size_t)m * ZP;
      ra0[rr] = *(const GAS u32x4*)(zr + 8 * lane); ra1[rr] = *(const GAS u32x4*)(zr + 512 + 8 * lane);
      rb0[rr] = *(const GAS u32x4*)(zr + 1536 + jh * 128 + d); rb1[rr] = *(const GAS u32x4*)(zr + 1536 + (4 + jh) * 128 + d); rb2[rr] = *(const GAS u32x4*)(zr + 1536 + (8 + jh) * 128 + d);
      rc[rr] = *(const GAS u32x4*)(OC + (size_t)m * 512 + jh * 128 + d);
      l0[rr] = LSE[(size_t)m * 12 + jh]; l1[rr] = LSE[(size_t)m * 12 + 4 + jh]; l2[rr] = LSE[(size_t)m * 12 + 8 + jh]; }
#pragma unroll
    for (int rr = 0; rr < RR; ++rr) { const int m = m0 + rr; bf16_t* yr = Y + (size_t)m * DM;
      { float x[16]; unpack8(ra0[rr], x); unpack8(ra1[rr], x + 8); float ss = 0.f;
#pragma unroll
        for (int e = 0; e < 16; ++e) ss += x[e] * x[e];
        const float r = rsqrtf(wave_sum(ss) * (1.f / 1024.f) + EPS);
        float y0[8], y1[8];
#pragma unroll
        for (int e = 0; e < 8; ++e) { y0[e] = x[e] * r * gA0[e]; y1[e] = x[8 + e] * r * gA1[e]; }
        *(GAS u32x4*)(yr + 8 * lane) = pack8(y0); *(GAS u32x4*)(yr + 512 + 8 * lane) = pack8(y1); }
      { const float mx = fmaxf(l0[rr], fmaxf(l1[rr], l2[rr])); const float e0 = __expf(l0[rr] - mx), e1 = __expf(l1[rr] - mx), e2 = __expf(l2[rr] - mx); const float inv = 1.f / (e0 + e1 + e2);
        float x0[8], x1[8], x2[8], ob[8]; unpack8(rb0[rr], x0); unpack8(rb1[rr], x1); unpack8(rb2[rr], x2);
        float ss = 0.f;
#pragma unroll
        for (int e = 0; e < 8; ++e) { ob[e] = (e0 * inv) * x0[e] + (e1 * inv) * x1[e] + (e2 * inv) * x2[e]; ss += ob[e] * ob[e]; }
        const float r = rsqrtf(wave_sum(ss) * (1.f / 512.f) + EPS);
        float y[8];
#pragma unroll
        for (int e = 0; e < 8; ++e) y[e] = ob[e] * r * gB[e];
        *(GAS u32x4*)(yr + 1024 + 8 * lane) = pack8(y); }
      { float x[8]; unpack8(rc[rr], x); float ss = 0.f;
#pragma unroll
        for (int e = 0; e < 8; ++e) ss += x[e] * x[e];
        const float r = rsqrtf(wave_sum(ss) * (1.f / 512.f) + EPS);
        float y[8];
#pragma unroll
        for (int e = 0; e < 8; ++e) y[e] = x[e] * r * gC[e];
        *(GAS u32x4*)(yr + 1536 + 8 * lane) = pack8(y); }
    }
  }
}

__device__ __forceinline__ void attention_phase(const PT& a, char* lds, int bid, int G) {
  bf16_t* Z = (bf16_t*)(a.ws + WS_Z); bf16_t* CQ = (bf16_t*)(a.ws + WS_CQ); const bf16_t* CKV = (const bf16_t*)(a.ws + WS_CKV); const bf16_t* KC = (const bf16_t*)(a.ws + WS_KC);
  float* LSE = (float*)(a.ws + WS_LSE);
  const int xcd = bid & 7, li = bid >> 3, nloc = G >> 3;
  const size_t rb = (size_t)xcd * SEQ;
#ifndef ATM
#define ATM 7
#endif
#ifndef REPA
#define REPA 0
#endif
#ifndef REPC
#define REPC 0
#endif
#ifndef REPB
#define REPB 0
#endif
  bf16_t* OC = (bf16_t*)(a.ws + WS_CQA);
  if constexpr (ATM & 1) for (int u = li; u < 128; u += nloc) { const int h = u >> 4, qb = u & 15, kvh = h >> 2;
    bf16_t* q = Z + (rb + (size_t)qb * 256) * ZP + h * 128;
    att::attn_unit<128, 2, false>(q, ZP, Z + rb * ZP + 1024 + kvh * 128, ZP, Z + rb * ZP + 1280 + kvh * 128, ZP, q, ZP, 0, SEQ / 64, 0.08838834764831845f, 0, 0.f, nullptr, 0, lds); }
  if constexpr (ATM & 2) for (int u = li; u < 64; u += nloc) { const int h = u >> 4, qb = u & 15;
    const bf16_t* q = CQ + (rb + (size_t)qb * 256) * CQW + h * 192;
    att::attn_unit_simple<192, false>(q, CQW, KC + rb * CQW + h * 192, CQW, CKV + rb * CKVW + h * 256 + 128, CKVW, OC + (rb + (size_t)qb * 256) * 512 + h * 128, 512, 0, SEQ / 64, 0.07216878364870323f, 0, 0.f, nullptr, 0, lds); }
  if constexpr (ATM & 4) for (int u = li; u < 192; u += nloc) { const int g = u >> 6, jh = (u >> 4) & 3, w = u & 15;
    const int dil = g == 0 ? 1 : (g == 1 ? 4 : 16), ups = 16 / dil, r = w / ups, qb = w % ups, L = SEQ / dil, hb = g * 4 + jh;
    const int q0 = qb * 256; int lo = q0 / 64 - 1; if (lo < 0) lo = 0; int hi = q0 / 64 + 5; if (hi > L / 64) hi = L / 64;
    if ((hi - lo) & 1) { if (lo > 0) --lo; else ++hi; }
    const float slope = exp2f(-8.0f * (float)(hb + 1) / 12.0f);
    const float slope_raw = slope * (float)dil * 11.313708498984761f;
    const long ld = (long)dil * ZP; const size_t base = (rb + r) * ZP;
    bf16_t* q = Z + base + (size_t)q0 * ld + 1536 + hb * 128;
    att::attn_unit_simple<128, true>(q, ld, Z + base + 3072 + hb * 128, ld, Z + base + 4608 + hb * 128, ld, q, ld, lo, hi - lo, 0.08838834764831845f, q0, slope_raw,
                                 LSE + (rb + r + (size_t)q0 * dil) * 12 + hb, (long)dil * 12, lds); }
}


#define XB_TMO      128
#define XB_XCNT(j)  (256  + 64 * (j))
#define XB_XSUB(j)  (1280 + 64 * (j))
#define XB_XGEN(j)  (2304 + 64 * (j))
#define XB_TOP      3328
#define XB_TOPGEN   3392
#define XB_LSUB(j)  (3456 + 64 * (j))
#define XB_LGEN(j)  (4480 + 64 * (j))
#define XCD_BAR_WORDS 5504
#define XB_SPIN_CAP (1u << 18)
__device__ __forceinline__ unsigned xb_ld(unsigned* p)              { return __hip_atomic_load(p, __ATOMIC_RELAXED, __HIP_MEMORY_SCOPE_AGENT); }
__device__ __forceinline__ unsigned xb_add(unsigned* p, unsigned v) { return __hip_atomic_fetch_add(p, v, __ATOMIC_RELAXED, __HIP_MEMORY_SCOPE_AGENT); }
__device__ __forceinline__ unsigned xb_xcc_id() { return (unsigned)__builtin_amdgcn_s_getreg((3 << 11) | 20) & 0xFu; }
#define XB_SPIN(cond, bar) do { unsigned _sp = 0; while (cond) { __builtin_amdgcn_s_sleep(1); \
    if ((++_sp & 255u) == 0u) { if (xb_ld(&(bar)[XB_TMO])) break; if (_sp > XB_SPIN_CAP) { atomicAdd(&(bar)[XB_TMO], 1u); break; } } } } while (0)
struct XcdBarrier { unsigned* bar; unsigned x; volatile LAS unsigned* st; };
__device__ __forceinline__ XcdBarrier xcd_barrier_post(unsigned* bar, volatile LAS unsigned* st) {
    XcdBarrier b; b.bar = bar; b.x = xb_xcc_id(); b.st = st;
    if (threadIdx.x == 0) st[4] = xb_add(&bar[XB_XCNT(b.x)], 1u);
    return b;
}
__device__ __forceinline__ void xcd_barrier_complete(unsigned* bar, unsigned x, unsigned& nloc, unsigned& nx, unsigned& even8) {
    const unsigned G = gridDim.x * gridDim.y * gridDim.z;
    unsigned sum, cnt, mine, sp = 0u;
    for (;;) {
        sum = 0u; cnt = 0u; mine = 0u;
#pragma unroll
        for (unsigned j = 0; j < 16; ++j) { const unsigned c = xb_ld(&bar[XB_XCNT(j)]); sum += c; cnt += (c > 0u) ? 1u : 0u; mine = (j == x) ? c : mine; }
        if (sum == G) break;
        __builtin_amdgcn_s_sleep(1);
        if ((++sp & 255u) == 0u) { if (xb_ld(&bar[XB_TMO])) break; if (sp > XB_SPIN_CAP) { atomicAdd(&bar[XB_TMO], 1u); break; } }
    }
    nloc = mine > 0u ? mine : 1u; nx = cnt > 0u ? cnt : 1u;
    unsigned eq = (cnt == 8u && sum == G) ? 1u : 0u;
#pragma unroll
    for (unsigned j = 0; j < 8; ++j) { if (xb_ld(&bar[XB_XCNT(j)]) * 8u != G) eq = 0u; }
    even8 = eq;
}
__device__ __forceinline__ void xcd_barrier(const XcdBarrier& b) {
    asm volatile("s_waitcnt vmcnt(0)" ::: "memory");
    __syncthreads();
    if (threadIdx.x == 0) {
        unsigned* bar = b.bar;
        __builtin_amdgcn_s_waitcnt(0);
        unsigned nloc = b.st[0], nx = b.st[1];
        if (nloc == 0u) { unsigned e8; xcd_barrier_complete(bar, b.x, nloc, nx, e8); b.st[0] = nloc; b.st[1] = nx; b.st[2] = e8; b.st[3] = e8 ? (b.x + 8u * b.st[4]) : blockIdx.x; }
        const unsigned old = xb_add(&bar[XB_XSUB(b.x)], 1u);
        const unsigned gen = old / nloc;
        if (old + 1u == (gen + 1u) * nloc) {
            __builtin_amdgcn_fence(__ATOMIC_RELEASE, "agent");
            asm volatile("s_waitcnt vmcnt(0)" ::: "memory");
            const unsigned og = xb_add(&bar[XB_TOP], 1u);
            const unsigned tg = og / nx;
            if (og + 1u == (tg + 1u) * nx) xb_add(&bar[XB_TOPGEN], 1u);
            else XB_SPIN(xb_ld(&bar[XB_TOPGEN]) == tg, bar);
            __builtin_amdgcn_fence(__ATOMIC_ACQUIRE, "agent");
            xb_add(&bar[XB_XGEN(b.x)], 1u);
            asm volatile("s_waitcnt vmcnt(0)" ::: "memory");
        } else {
            XB_SPIN(xb_ld(&bar[XB_XGEN(b.x)]) == gen, bar);
            __builtin_amdgcn_fence(__ATOMIC_ACQUIRE, "agent");
            asm volatile("s_waitcnt vmcnt(0)" ::: "memory");
        }
    }
    __syncthreads();
}

__device__ __forceinline__ void xcd_local_barrier(const XcdBarrier& b) {
    asm volatile("s_waitcnt vmcnt(0)" ::: "memory");
    __syncthreads();
    if (threadIdx.x == 0) {
        unsigned* bar = b.bar;
        __builtin_amdgcn_s_waitcnt(0);
        const unsigned nloc = b.st[0];
        const unsigned old = xb_add(&bar[XB_LSUB(b.x)], 1u);
        const unsigned gen = old / nloc;
        if (old + 1u == (gen + 1u) * nloc) xb_add(&bar[XB_LGEN(b.x)], 1u);
        else XB_SPIN(xb_ld(&bar[XB_LGEN(b.x)]) == gen, bar);
        __builtin_amdgcn_fence(__ATOMIC_ACQUIRE, "agent");
        asm volatile("s_waitcnt vmcnt(0)" ::: "memory");
    }
    __syncthreads();
}

#ifndef PHM
#define PHM 0xFFFF
#endif
#define PH(k) if constexpr ((PHM >> (k)) & 1)
#ifndef WGM_GU
#define WGM_GU 4
#endif
#ifndef WGM_IN
#define WGM_IN 4
#endif
#ifndef REPGU
#define REPGU 1
#endif
#ifndef REPIN
#define REPIN 1
#endif
#ifndef REPNC
#define REPNC 1
#endif
__global__ void __launch_bounds__(NWAVES * 64, 2) fwd_megakernel(Args ka) {
  extern __shared__ __attribute__((aligned(16))) unsigned char lds[];
  cg::grid_group grid = cg::this_grid();
  LAS unsigned char* ldsl = (LAS unsigned char*)lds;
  const int tid = threadIdx.x, lane = tid & 63, wave = __builtin_amdgcn_readfirstlane(tid >> 6);
  int G = gridDim.x, bid = blockIdx.x;
  int gw = bid * NWAVES + wave, NGW = G * NWAVES;
#define FRESH() do { asm volatile("" : "+s"(G), "+s"(bid), "+s"(gw), "+s"(NGW), "+s"(ws), "+s"(wb), "+s"(out), "+s"(XN), "+s"(Z), "+s"(H)); \
    ws = asglobal(ws); wb = asglobal(wb); out = asglobal(out); XN = asglobal(XN); Z = asglobal(Z); H = asglobal(H); } while (0)
  { LAS unsigned long long* pt = (LAS unsigned long long*)(ldsl + LDS_PTAB);
    if (tid == 0) {
#define PTS(k) pt[k] = (unsigned long long)ka.in[k]
      PTS(0); PTS(1); PTS(2); PTS(3); PTS(4); PTS(5); PTS(6); PTS(7); PTS(8); PTS(9); PTS(10); PTS(11); PTS(12); PTS(13); PTS(14); PTS(15); PTS(16); PTS(17); PTS(18); PTS(19); PTS(20);
#undef PTS
      pt[32] = 0ull; pt[33] = 0ull;
    } }
  if (blockIdx.x == 0) for (int i = tid; i < XCD_BAR_WORDS; i += NWAVES * 64) *(GAS unsigned*)((unsigned*)(ka.ws + WS_BAR) + i) = 0u;
  __syncthreads();
  unsigned char* ws = ka.ws; unsigned char* wb = ws + WS_WB;
  PT a; a.t = (LAS const unsigned long long*)(ldsl + LDS_PTAB); a.out = ka.out; a.ws = ka.ws;
  bf16_t* XN = (bf16_t*)(ws + WS_XN); bf16_t* Z = (bf16_t*)(ws + WS_Z); bf16_t* H = Z;
  float* out = a.out;
  PH(0) rope_tables(ws, bid * (NWAVES * 64) + tid, G * NWAVES * 64);
  XcdBarrier xbar; xbar.bar = (unsigned*)(ka.ws + WS_BAR); xbar.x = 0; xbar.st = (volatile LAS unsigned*)(ldsl + LDS_PTAB + 256);
#define GSYNC() do { xcd_barrier(xbar); FRESH(); a.ws = ws; a.out = out; } while (0)
#define LSYNC() do { if (xlocal) xcd_local_barrier(xbar); else xcd_barrier(xbar); FRESH(); a.ws = ws; a.out = out; } while (0)
  bool xlocal = false;
  float* SSa = (float*)(ws + WS_SS);
  PH(2) xb_init_rows(a.in(0), XN, SSa, (bid & 7) * SEQ, (bid >> 3) * NWAVES + wave, (G >> 3) * NWAVES, lane);
#pragma unroll 1
  for (int l = 0; l < DEPTH; ++l) {
    FRESH(); a.ws = ws; a.out = out;
    for (int rep_ = 0; rep_ < REPNC; ++rep_) { PH(1) convert_weights(a, l, ldsl, gw, NGW, wave, lane); }
    zero_f32((float*)(ws + WS_SS) + 2 * M, 4 * M, bid * (NWAVES * 64) + tid, G * NWAVES * 64);
    if (l == 0) { grid.sync(); xbar = xcd_barrier_post((unsigned*)(ka.ws + WS_BAR), (volatile LAS unsigned*)(ldsl + LDS_PTAB + 256)); xcd_barrier(xbar);
      bid = __builtin_amdgcn_readfirstlane((int)xbar.st[3]); gw = bid * NWAVES + wave; xlocal = false  ; FRESH(); a.ws = ws; a.out = out; }
    else GSYNC();
    for (int rep_ = 0; rep_ < REPGU; ++rep_) PH(3) { pg8::Gemm g{XN, (const bf16_t*)(wb + WB_GU1), M, 2 * DFF, DM, DM}; pg8::StaticOrder S; S.init(M, 2 * DFF, G, bid, WGM_GU); pg8::EpiSwiGLU E{H, DFF, (const float*)(ws + WS_SS)};
      pg8::gemm_phase(ldsl, g, S, E); }
    LSYNC();
    PH(4) { pg8::Gemm g{H, (const bf16_t*)(wb + WB_D1), M, DM, DFF, DFF}; pg8::StaticOrder S; S.init(M, DM, G, bid); pg8::EpiResid<1, WS_XN, WS_SS + (size_t)M * 8, false> E{out, ws};
      pg8::gemm_phase(ldsl, g, S, E); }
    LSYNC();
    for (int rep_ = 0; rep_ < REPIN; ++rep_) PH(5) { pg8::Gemm g{XN, (const bf16_t*)(wb + WB_IN), M, ZP, DM, DM}; pg8::StaticOrder S; S.init(M, ZP, G, bid, WGM_IN); pg8::EpiBf16 E{Z, ZP, (const float*)(ws + WS_SS + (size_t)M * 8)};
      pg8::gemm_phase(ldsl, g, S, E); }
    LSYNC();
    PH(6) prep_rows(a, l, (bid & 7) * SEQ, (bid >> 3) * NWAVES + wave, (G >> 3) * NWAVES, lane);
    { unsigned long long* ssa = (unsigned long long*)(ws + WS_SS) + (bid & 7) * SEQ;
      for (int i = (bid >> 3) * (NWAVES * 64) + tid; i < SEQ; i += (G >> 3) * (NWAVES * 64)) __hip_atomic_store(ssa + i, 0ull, __ATOMIC_RELAXED, __HIP_MEMORY_SCOPE_AGENT); }
    LSYNC();
    PH(5) { pg8::Gemm g{(const bf16_t*)(ws + WS_CQA), (const bf16_t*)(wb + WB_CQ), M, CQW, CQR, CQR}; pg8::StaticOrder S; S.init(M, CQW, G, bid); pg8::EpiBf16 E{(bf16_t*)(ws + WS_CQ), CQW, nullptr};
      pg8::gemm_phase(ldsl, g, S, E); }
    PH(5) { pg8::Gemm g{(const bf16_t*)(ws + WS_CKVA), (const bf16_t*)(wb + WB_CKV), M, CKVW, CKVR, CKVR}; pg8::StaticOrder S; S.init(M, CKVW, G, bid); pg8::EpiBf16 E{(bf16_t*)(ws + WS_CKV), CKVW, nullptr};
      pg8::gemm_phase(ldsl, g, S, E); }
    LSYNC();
    PH(7) cpost_rows(a, l, (bid & 7) * SEQ, (bid >> 3) * NWAVES + wave, (G >> 3) * NWAVES, lane);
    LSYNC();
    PH(8) attention_phase(a, (char*)lds, bid, G);
    LSYNC();
    PH(9) ynorm_rows(a, l, (bf16_t*)(ws + WS_CQ), (bid & 7) * SEQ, (bid >> 3) * NWAVES + wave, (G >> 3) * NWAVES, lane);
    LSYNC();
    PH(4) { pg8::Gemm g{(const bf16_t*)(ws + WS_CQ), (const bf16_t*)(wb + WB_OUT), M, DM, DM, DM}; pg8::StaticOrder S; S.init(M, DM, G, bid); pg8::EpiResid<2, WS_XN, WS_SS + (size_t)M * 16, false> E{out, ws};
      pg8::gemm_phase(ldsl, g, S, E); }
    LSYNC();
    for (int rep_ = 0; rep_ < REPGU; ++rep_) PH(3) { pg8::Gemm g{XN, (const bf16_t*)(wb + WB_GU2), M, 2 * DFF, DM, DM}; pg8::StaticOrder S; S.init(M, 2 * DFF, G, bid, WGM_GU); pg8::EpiSwiGLU E{H, DFF, (const float*)(ws + WS_SS + (size_t)M * 16)};
      pg8::gemm_phase(ldsl, g, S, E); }
    LSYNC();
    if (l + 1 < DEPTH) { pg8::Gemm g{H, (const bf16_t*)(wb + WB_D2), M, DM, DFF, DFF}; pg8::StaticOrder S; S.init(M, DM, G, bid); pg8::EpiResid<1, WS_XN, WS_SS, false> E{out, ws};
      pg8::gemm_phase(ldsl, g, S, E); }
    else { pg8::Gemm g{H, (const bf16_t*)(wb + WB_D2), M, DM, DFF, DFF}; pg8::StaticOrder S; S.init(M, DM, G, bid); pg8::EpiResid<1, WS_XN, WS_SS, true> E{out, ws};
      pg8::gemm_phase(ldsl, g, S, E); }
    GSYNC();
  }
}

extern "C" void kernel_launch(void* const* d_in, const int* in_sizes, int n_in, void* d_out, int out_size, void* d_ws, size_t ws_size, hipStream_t stream) {
  static int grid = 0;
  if (grid == 0) {
    if (n_in != 21 || in_sizes[0] != M * DM || out_size != M * DM || ws_size < WS_END) { fprintf(stderr, "kernel_launch: unexpected shapes (n_in %d, ws %zu)\n", n_in, ws_size); grid = -1; return; }
    int dev = 0, cus = 0, per_cu = 0;
    hipGetDevice(&dev); hipDeviceGetAttribute(&cus, hipDeviceAttributeMultiprocessorCount, dev);
    hipFuncSetAttribute((const void*)fwd_megakernel, hipFuncAttributeMaxDynamicSharedMemorySize, LDS_BYTES);
    hipOccupancyMaxActiveBlocksPerMultiprocessor(&per_cu, (const void*)fwd_megakernel, NWAVES * 64, LDS_BYTES);
    if (per_cu < 1) { fprintf(stderr, "kernel_launch: occupancy query says %d blocks per CU\n", per_cu); per_cu = 1; }
    (void)hipGetLastError();
    grid = cus * 1;
    grid -= grid % 8;
  }
  if (grid < 0) return;
  Args a{};
  for (int i = 0; i < 21; ++i) a.in[i] = (const float*)d_in[i];
  a.out = (float*)d_out; a.ws = (unsigned char*)d_ws;
  void* args[] = {&a};
  hipError_t e = hipLaunchCooperativeKernel((const void*)fwd_megakernel, dim3(grid), dim3(NWAVES * 64), args, LDS_BYTES, stream);
  if (e != hipSuccess) fprintf(stderr, "cooperative launch failed: %s (grid %d)\n", hipGetErrorString(e), grid);
}
```

```cpp
#include <hip/hip_runtime.h>
#include <hip/hip_bf16.h>
#include <hip/hip_cooperative_groups.h>
#include <cstdio>
#include <cstdint>
namespace cg = cooperative_groups;

namespace pg8 {
#define PG8_LAS __attribute__((address_space(3)))
#define PG8_GAS __attribute__((address_space(1)))
typedef unsigned short bf16_t;
typedef short bf16x8 __attribute__((ext_vector_type(8)));
typedef float f32x4 __attribute__((ext_vector_type(4)));
typedef unsigned u32x4 __attribute__((ext_vector_type(4)));
constexpr int BM = 256, BK = 64, HALF = 128, HTB = HALF * BK * 2  , STAGE_BYTES = 8 * HTB, NXCD = 8, WGM = 4;

__host__ __device__ __forceinline__ int lds_byte(int r, int c) { const int st = (r >> 4) * 2 + (c >> 5), rr = r & 15, cc = c & 31, ob = rr * 64 + cc * 2; return st * 1024 + (ob ^ (((ob >> 9) & 1) << 5)); }
__host__ __device__ __forceinline__ void stage_rc(int b, int& R, int& C) { const int st = b / 1024, sb = b % 1024, swz = sb ^ (((sb >> 9) & 1) << 5); R = (st >> 1) * 16 + swz / 64; C = (st & 1) * 32 + (swz % 64) / 2; }
__host__ __device__ __forceinline__ int perm32(int rho) { const int n = rho >> 4, i = rho & 15; return 8 * (i >> 2) + 4 * n + (i & 3); }

struct Unit { int pm, pn; };
struct Gemm { const bf16_t* A; const bf16_t* Bt; int M, N, K, lda; };

struct StaticOrder {
    int nM, nN, nwg, G, c, wgm;
    __host__ __device__ void init(int M, int N, int G_, int c_, int wgm_ = 4) { nM = M / BM; nN = N / BM; nwg = nM * nN; G = G_; c = c_; wgm = wgm_; }
    __host__ __device__ bool next(int i, Unit& u) const {
        const long L = (long)i * G + c; if (L >= nwg) return false;
        int wgid = (int)L; { const int q = nwg / NXCD, r = nwg % NXCD, xcd = wgid % NXCD, off = wgid / NXCD; wgid = (xcd < r ? xcd * (q + 1) : r * (q + 1) + (xcd - r) * q) + off; }
        const int nig = wgm * nN, gid = wgid / nig, fm = gid * wgm, gsz = (nM - fm) < wgm ? (nM - fm) : wgm;
        u.pm = fm + ((wgid % nig) % gsz); u.pn = (wgid % nig) / gsz; return true;
    }
};

__device__ __forceinline__ unsigned cvt_pk_bf16(float lo, float hi) { unsigned r; asm volatile("v_cvt_pk_bf16_f32 %0, %1, %2" : "=v"(r) : "v"(lo), "v"(hi)); return r; }

constexpr float SS_SCALE = 4194304.0f, SS_INV = 1.0f / 4194304.0f;
__device__ __forceinline__ float row_rstd(const float* ss, int row, float invn) { const unsigned long long v = *(const PG8_GAS unsigned long long*)((const unsigned long long*)ss + row); return __builtin_amdgcn_rsqf((float)v * SS_INV * invn + 1e-6f); }
constexpr int RSTD_TAB_OFF = 131072 + 1024;
struct EpiBf16 {
    static constexpr bool PERM = true;
    static constexpr bool RSTD_TAB = true;
    bf16_t* O; int ldc; const float* ss;
    __device__ __forceinline__ void operator()(const f32x4 (&acc)[2][2][4][2], const Unit& u, int wr, int wc, int fr, int fq, PG8_LAS unsigned char* lds) const {
        const int row0 = u.pm * BM + wr * 64 + fr; const int col0 = u.pn * BM + wc * 32 + 8 * fq;
        const PG8_LAS float* tab = (const PG8_LAS float*)(lds + RSTD_TAB_OFF) + wr * 64 + fr;
#pragma unroll
        for (int ai = 0; ai < 2; ++ai)
#pragma unroll
            for (int m = 0; m < 4; ++m) { const int row = row0 + ai * HALF + m * 16; bf16_t* rowp = O + (size_t)row * ldc + col0;
                const float r = ss ? tab[ai * HALF + m * 16] : 1.0f;
#pragma unroll
                for (int bj = 0; bj < 2; ++bj) { const f32x4 v0 = acc[ai][bj][m][0] * r, v1 = acc[ai][bj][m][1] * r;
                    u32x4 w; w.x = cvt_pk_bf16(v0[0], v0[1]); w.y = cvt_pk_bf16(v0[2], v0[3]); w.z = cvt_pk_bf16(v1[0], v1[1]); w.w = cvt_pk_bf16(v1[2], v1[3]);
                    *(PG8_GAS u32x4*)(rowp + bj * HALF) = w; } }
    }
};
__device__ __forceinline__ float silu_mul(float g, float u) { return g * u * __builtin_amdgcn_rcpf(1.0f + __builtin_amdgcn_exp2f(-1.4426950408889634f * g)); }
struct EpiSwiGLU {
    static constexpr bool PERM = true;
    static constexpr bool RSTD_TAB = true;
    bf16_t* H; int ldh; const float* ss;
    __device__ __forceinline__ void operator()(const f32x4 (&acc)[2][2][4][2], const Unit& u, int wr, int wc, int fr, int fq, PG8_LAS unsigned char* lds) const {
        const int row0 = u.pm * BM + wr * 64 + fr; const int col0 = u.pn * HALF + wc * 32 + 8 * fq;
        const PG8_LAS float* tab = (const PG8_LAS float*)(lds + RSTD_TAB_OFF) + wr * 64 + fr;
#pragma unroll
        for (int ai = 0; ai < 2; ++ai)
#pragma unroll
            for (int m = 0; m < 4; ++m) { const int row = row0 + ai * HALF + m * 16; bf16_t* rowp = H + (size_t)row * ldh + col0;
                const float r = tab[ai * HALF + m * 16];
                const f32x4 g0 = acc[ai][0][m][0] * r, g1 = acc[ai][0][m][1] * r, u0 = acc[ai][1][m][0] * r, u1 = acc[ai][1][m][1] * r;
                u32x4 w; w.x = cvt_pk_bf16(silu_mul(g0[0], u0[0]), silu_mul(g0[1], u0[1])); w.y = cvt_pk_bf16(silu_mul(g0[2], u0[2]), silu_mul(g0[3], u0[3]));
                w.z = cvt_pk_bf16(silu_mul(g1[0], u1[0]), silu_mul(g1[1], u1[1])); w.w = cvt_pk_bf16(silu_mul(g1[2], u1[2]), silu_mul(g1[3], u1[3]));
                *(PG8_GAS u32x4*)rowp = w; }
    }
};
template <int ALPHA2, size_t ROFF, size_t SSOFF, bool F32OUT>
struct EpiResid {
    static constexpr bool PERM = true;
    static constexpr int ldc = 2048; static constexpr float alpha = 0.5f * ALPHA2;
    static constexpr bool RSTD_TAB = false;
    float* out; unsigned char* ws;
    __device__ __forceinline__ void operator()(const f32x4 (&acc)[2][2][4][2], const Unit& u, int wr, int wc, int fr, int fq, PG8_LAS unsigned char*) const {
        const int row0 = u.pm * BM + wr * 64 + fr; const int col0 = u.pn * BM + wc * 32 + 8 * fq;
        bf16_t* R = (bf16_t*)(ws + ROFF); float* ssq = (float*)(ws + SSOFF);
#pragma unroll
        for (int ai = 0; ai < 2; ++ai) {
            u32x4 pre[4][2];
#pragma unroll
            for (int m = 0; m < 4; ++m) { const size_t off = (size_t)(row0 + ai * HALF + m * 16) * ldc + col0;
#pragma unroll
                for (int bj = 0; bj < 2; ++bj) pre[m][bj] = *(const PG8_GAS u32x4*)(R + off + bj * HALF); }
#pragma unroll
            for (int m = 0; m < 4; ++m) { const int row = row0 + ai * HALF + m * 16; const size_t off = (size_t)row * ldc + col0; float sq = 0.f;
#pragma unroll
                for (int bj = 0; bj < 2; ++bj) { const u32x4 b = pre[m][bj];
                    const f32x4 b0 = {__uint_as_float(b.x << 16), __uint_as_float(b.x & 0xffff0000u), __uint_as_float(b.y << 16), __uint_as_float(b.y & 0xffff0000u)};
                    const f32x4 b1 = {__uint_as_float(b.z << 16), __uint_as_float(b.z & 0xffff0000u), __uint_as_float(b.w << 16), __uint_as_float(b.w & 0xffff0000u)};
                    const f32x4 o0 = b0 + acc[ai][bj][m][0] * alpha, o1 = b1 + acc[ai][bj][m][1] * alpha;
                    if constexpr (F32OUT) { __builtin_nontemporal_store(o0, (PG8_GAS f32x4*)(out + off + bj * HALF)); __builtin_nontemporal_store(o1, (PG8_GAS f32x4*)(out + off + bj * HALF + 4)); }
                    u32x4 w; w.x = cvt_pk_bf16(o0[0], o0[1]); w.y = cvt_pk_bf16(o0[2], o0[3]); w.z = cvt_pk_bf16(o1[0], o1[1]); w.w = cvt_pk_bf16(o1[2], o1[3]);
                    *(PG8_GAS u32x4*)(R + off + bj * HALF) = w;
                    sq += ((o0[0] * o0[0] + o0[1] * o0[1]) + (o0[2] * o0[2] + o0[3] * o0[3])) + ((o1[0] * o1[0] + o1[1] * o1[1]) + (o1[2] * o1[2] + o1[3] * o1[3])); }
                sq += __shfl_xor(sq, 16); sq += __shfl_xor(sq, 32);
                if (fq == 0) __hip_atomic_fetch_add((PG8_GAS unsigned long long*)((unsigned long long*)ssq + row), (unsigned long long)(sq * SS_SCALE), __ATOMIC_RELAXED, __HIP_MEMORY_SCOPE_AGENT); }
        }
    }
};

template <class Epi, class Sched>
__device__ __forceinline__ void gemm_phase(PG8_LAS unsigned char* lds, const Gemm g, const Sched& S, const Epi& E) {
    int tid_ = threadIdx.x; asm volatile("" : "+v"(tid_));
    const int tid = tid_, wid = __builtin_amdgcn_readfirstlane(tid >> 6), lane = tid & 63, wr = wid >> 2, wc = wid & 3, fr = lane & 15, fq = lane >> 4;
    const int K = g.K, nt = K / BK, lda = g.lda;
    unsigned voffA[2], voffB[2];
#pragma unroll
    for (int i = 0; i < 2; ++i) { int R, C; stage_rc(tid * 16 + i * 8192, R, C); const int Rb = Epi::PERM ? ((R & ~31) + perm32(R & 31)) : R;
        voffA[i] = (unsigned)(R * lda + C) * 2u; voffB[i] = (unsigned)(Rb * K + C) * 2u; }
    const size_t kstep = (size_t)(BK * 2);
    const size_t hA = (size_t)HALF * lda * 2, hB = (size_t)HALF * K * 2;
    const size_t tA = 2 * hA, tB = 2 * hB;
    const unsigned ldsw = (unsigned)wid * 1024u;
    const int aoff = lds_byte(wr * 64 + fr, fq * 8), boff = lds_byte(wc * 32 + fr, fq * 8);
#define PG8_SA(b, h) (((b) * 2 + (h)) * HTB)
#define PG8_SB(b, h) ((4 + (b) * 2 + (h)) * HTB)
#define PG8_STAGE(bufoff, gbase, voff) do { _Pragma("unroll") for (int _i = 0; _i < 2; ++_i) \
        __builtin_amdgcn_global_load_lds((const unsigned*)((const char*)(gbase) + (voff)[_i]), (PG8_LAS unsigned*)(lds + (bufoff) + ldsw + _i * 8192), 16, 0, 0); } while (0)
#define PG8_LDA(dst, b, h) do { _Pragma("unroll") for (int m = 0; m < 4; ++m) _Pragma("unroll") for (int k = 0; k < 2; ++k) dst[m][k] = *(const PG8_LAS bf16x8*)(lds + PG8_SA(b, h) + aoff + m * 2048 + k * 1024); } while (0)
#define PG8_LDB(dst, b, h) do { _Pragma("unroll") for (int n = 0; n < 2; ++n) _Pragma("unroll") for (int k = 0; k < 2; ++k) dst[n][k] = *(const PG8_LAS bf16x8*)(lds + PG8_SB(b, h) + boff + n * 2048 + k * 1024); } while (0)
#define PG8_MMA(ai, bj, At, Bt) do { __builtin_amdgcn_s_setprio(1); _Pragma("unroll") for (int m = 0; m < 4; ++m) _Pragma("unroll") for (int n = 0; n < 2; ++n) _Pragma("unroll") for (int k = 0; k < 2; ++k) \
        acc[ai][bj][m][n] = __builtin_amdgcn_mfma_f32_16x16x32_bf16(Bt[n][k], At[m][k], acc[ai][bj][m][n], 0, 0, 0); __builtin_amdgcn_s_setprio(0); } while (0)
#define PG8_WAIT_V(n) asm volatile("s_waitcnt vmcnt(" #n ")" ::: "memory")
#define PG8_WAIT_L(n) asm volatile("s_waitcnt lgkmcnt(" #n ")" ::: "memory")
#define PG8_BAR __builtin_amdgcn_s_barrier()
#define PG8_SCHED __builtin_amdgcn_sched_barrier(0)
    Unit cur, nxt; int ui = 0;
    if (!S.next(0, cur)) return;
    int pmc = -1;
    f32x4 acc[2][2][4][2];
#pragma unroll
    for (int a = 0; a < 2; ++a)
#pragma unroll
        for (int b = 0; b < 2; ++b)
#pragma unroll
            for (int m = 0; m < 4; ++m)
#pragma unroll
                for (int n = 0; n < 2; ++n) acc[a][b][m][n] = (f32x4){0.f, 0.f, 0.f, 0.f};
    bf16x8 At[4][2], B0[2][2], B1[2][2];
    const char* cA = (const char*)g.A + (size_t)cur.pm * tA; const char* cB = (const char*)g.Bt + (size_t)cur.pn * tB;
    PG8_STAGE(PG8_SB(0, 0), cB, voffB); PG8_STAGE(PG8_SB(0, 1), cB + hB, voffB); PG8_STAGE(PG8_SA(0, 0), cA, voffA); PG8_STAGE(PG8_SA(0, 1), cA + hA, voffA);
    if (wr == 1) PG8_BAR;
    PG8_WAIT_V(2); PG8_BAR;
    PG8_STAGE(PG8_SB(1, 0), cB + kstep, voffB); PG8_STAGE(PG8_SA(1, 0), cA + kstep, voffA); PG8_STAGE(PG8_SB(1, 1), cB + hB + kstep, voffB);
    PG8_WAIT_V(6); PG8_BAR;
    for (;;) {
        const bool has_next = S.next(ui + 1, nxt);
        const char* nA = has_next ? (const char*)g.A + (size_t)nxt.pm * tA : cA; const char* nB = has_next ? (const char*)g.Bt + (size_t)nxt.pn * tB : cB;
        for (int t = 0; t < nt; t += 2) {
            const bool last = (t == nt - 2);
            const char* a1 = cA + (size_t)(t + 1) * kstep;
            const char* a2 = last ? nA : cA + (size_t)(t + 2) * kstep; const char* b2 = last ? nB : cB + (size_t)(t + 2) * kstep;
            const char* a3 = a2 + kstep; const char* b3 = b2 + kstep;
            PG8_LDB(B0, 0, 0); PG8_LDB(B1, 0, 1); PG8_SCHED; PG8_LDA(At, 0, 0); PG8_STAGE(PG8_SA(1, 1), a1 + hA, voffA);
            PG8_WAIT_V(8); PG8_WAIT_L(0); PG8_BAR; PG8_MMA(0, 0, At, B0); PG8_MMA(0, 1, At, B1); PG8_BAR; PG8_SCHED;
            PG8_LDA(At, 0, 1); PG8_STAGE(PG8_SB(0, 0), b2, voffB); PG8_STAGE(PG8_SB(0, 1), b2 + hB, voffB); PG8_STAGE(PG8_SA(0, 0), a2, voffA);
            PG8_WAIT_V(8); PG8_WAIT_L(0); PG8_BAR; PG8_MMA(1, 0, At, B0); PG8_MMA(1, 1, At, B1); PG8_BAR; PG8_SCHED;
            PG8_LDB(B0, 1, 0); PG8_LDB(B1, 1, 1); PG8_SCHED; PG8_LDA(At, 1, 0); PG8_STAGE(PG8_SA(0, 1), a2 + hA, voffA);
            PG8_WAIT_V(8); PG8_WAIT_L(0); PG8_BAR; PG8_MMA(0, 0, At, B0); PG8_MMA(0, 1, At, B1); PG8_BAR; PG8_SCHED;
            PG8_LDA(At, 1, 1); PG8_STAGE(PG8_SB(1, 0), b3, voffB); PG8_STAGE(PG8_SB(1, 1), b3 + hB, voffB); PG8_STAGE(PG8_SA(1, 0), a3, voffA);
            PG8_WAIT_V(8); PG8_WAIT_L(0); PG8_BAR; PG8_MMA(1, 0, At, B0); PG8_MMA(1, 1, At, B1); PG8_BAR; PG8_SCHED;
        }
        if (wr == 0) PG8_BAR;
        if constexpr (Epi::RSTD_TAB) {
            if (E.ss && pmc != cur.pm) { pmc = cur.pm;
                if (tid < BM) *(PG8_LAS float*)(lds + RSTD_TAB_OFF + tid * 4) = row_rstd(E.ss, cur.pm * BM + tid, 1.0f / 2048.0f);
                PG8_WAIT_L(0); PG8_BAR; } }
        E(acc, cur, wr, wc, fr, fq, lds);
        if (!has_next) break;
#pragma unroll
        for (int a = 0; a < 2; ++a)
#pragma unroll
            for (int b = 0; b < 2; ++b)
#pragma unroll
                for (int m = 0; m < 4; ++m)
#pragma unroll
                    for (int n = 0; n < 2; ++n) acc[a][b][m][n] = (f32x4){0.f, 0.f, 0.f, 0.f};
        cur = nxt; cA = nA; cB = nB; ++ui;
        if (wr == 1) PG8_BAR;
    }
    PG8_WAIT_V(0);
    PG8_BAR;
#undef PG8_SA
#undef PG8_SB
#undef PG8_STAGE
#undef PG8_LDA
#undef PG8_LDB
#undef PG8_MMA
#undef PG8_WAIT_V
#undef PG8_WAIT_L
#undef PG8_BAR
#undef PG8_SCHED
}
}

namespace att {
typedef unsigned short bf16_t;
using bf16x8 = __attribute__((ext_vector_type(8))) short;
using s16x4  = __attribute__((ext_vector_type(4))) short;
using f32x16 = __attribute__((ext_vector_type(16))) float;
using u32x4  = __attribute__((ext_vector_type(4))) unsigned;
#define SBAR() __builtin_amdgcn_sched_barrier(0)
#define AGAS __attribute__((address_space(1)))
__device__ __forceinline__ int crow(int r, int hi) { return (r & 3) + 8 * (r >> 2) + 4 * hi; }
__device__ __forceinline__ unsigned cvtpk(float lo, float hi) { unsigned r; asm volatile("v_cvt_pk_bf16_f32 %0, %1, %2" : "=v"(r) : "v"(lo), "v"(hi)); return r; }

__device__ __forceinline__ void partialSM(f32x16& p0, f32x16& p1, float& m_reg, float& mn, float& alpha, float C, float thr_raw) {
  float pmax = p0[0];
#pragma unroll
  for (int r = 1; r < 16; ++r) pmax = fmaxf(pmax, p0[r]);
#pragma unroll
  for (int r = 0; r < 16; ++r) pmax = fmaxf(pmax, p1[r]);
  { auto rr = __builtin_amdgcn_permlane32_swap(__float_as_uint(pmax), __float_as_uint(pmax), false, false);
    pmax = fmaxf(__uint_as_float(rr[0]), __uint_as_float(rr[1])); }
  if (__builtin_expect(__all(pmax - m_reg <= thr_raw), 1)) { mn = m_reg; alpha = 1.f; }
  else { mn = fmaxf(m_reg, pmax); alpha = __builtin_amdgcn_exp2f((m_reg - mn) * C); m_reg = mn; }
  float mnC = -mn * C;
#pragma unroll
  for (int r = 0; r < 16; ++r) p0[r] = fmaf(p0[r], C, mnC);
#pragma unroll
  for (int r = 0; r < 16; ++r) p1[r] = fmaf(p1[r], C, mnC);
#pragma unroll
  for (int r = 0; r < 16; ++r) p0[r] = __builtin_amdgcn_exp2f(p0[r]);
}
__device__ __forceinline__ void finishSM(f32x16& p0, f32x16& p1, float alpha, float& l_reg, bf16x8& pa0, bf16x8& pa1, bf16x8& pa2, bf16x8& pa3) {
#pragma unroll
  for (int r = 0; r < 16; ++r) p1[r] = __builtin_amdgcn_exp2f(p1[r]);
  float ps = 0;
#pragma unroll
  for (int r = 0; r < 16; ++r) ps += p0[r];
#pragma unroll
  for (int r = 0; r < 16; ++r) ps += p1[r];
  { auto rr = __builtin_amdgcn_permlane32_swap(__float_as_uint(ps), __float_as_uint(ps), false, false);
    ps = __uint_as_float(rr[0]) + __uint_as_float(rr[1]); }
  l_reg = l_reg * alpha + ps;
#define PK4(P, BASE, OUT) do { unsigned a0 = cvtpk(P[BASE + 0], P[BASE + 1]), a1 = cvtpk(P[BASE + 2], P[BASE + 3]);   \
    unsigned b0 = cvtpk(P[BASE + 4], P[BASE + 5]), b1 = cvtpk(P[BASE + 6], P[BASE + 7]);                              \
    auto r0 = __builtin_amdgcn_permlane32_swap(a0, b0, false, false); auto r1 = __builtin_amdgcn_permlane32_swap(a1, b1, false, false); \
    u32x4 w = {r0[0], r1[0], r0[1], r1[1]}; OUT = *reinterpret_cast<bf16x8*>(&w); } while (0)
  PK4(p0, 0, pa0); PK4(p0, 8, pa1); PK4(p1, 0, pa2); PK4(p1, 8, pa3);
#undef PK4
}
template <int DQK>
__device__ __forceinline__ void qkt(f32x16& p0, f32x16& p1, const char* Ks, const bf16x8* qr, int r32, int hi) {
  p0 = f32x16{}; p1 = f32x16{};
  constexpr int KST = DQK * 2, SWM = (DQK == 128) ? 15 : 7;
  const int sw = (r32 & SWM) << 4;
#pragma unroll
  for (int d0 = 0; d0 < DQK / 16; ++d0) { const int cb = (d0 * 16 + hi * 8) * 2;
    bf16x8 b0 = *reinterpret_cast<const bf16x8*>(Ks + r32 * KST + (cb ^ sw));
    bf16x8 b1 = *reinterpret_cast<const bf16x8*>(Ks + (32 + r32) * KST + (cb ^ sw));
    p0 = __builtin_amdgcn_mfma_f32_32x32x16_bf16(b0, qr[d0], p0, 0, 0, 0);
    p1 = __builtin_amdgcn_mfma_f32_32x32x16_bf16(b1, qr[d0], p1, 0, 0, 0); }
}
__device__ __forceinline__ int v_st(int k, int c) { const int kk = (k & ~0xC) | ((k & 4) << 1) | ((k & 8) >> 1); return ((kk >> 3) * 4 + (c >> 5)) * 512 + ((kk & 7) * 32 + (c & 31)) * 2; }
__device__ __forceinline__ int v_rd_base(int lane) { return ((lane & 3) << 3) | (((lane >> 2) & 3) << 6) | (((lane >> 4) & 1) << 5) | (((lane >> 5) & 1) << 8); }
constexpr int v_rd_off(int d0, int ks, int half) { return d0 * 512 + ks * 4096 + half * 2048; }
template <int OFF> __device__ __forceinline__ s16x4 tr_read(int vb) {
  s16x4 r; asm volatile("ds_read_b64_tr_b16 %0, %1 offset:%2" : "=&v"(r) : "v"(vb), "i"(OFF) : "memory"); return r;
}
template <int D0> __device__ __forceinline__ void pv_one(f32x16& od, int vb, bf16x8 pa0, bf16x8 pa1, bf16x8 pa2, bf16x8 pa3) {
  const s16x4 l0 = tr_read<v_rd_off(D0, 0, 0)>(vb), h0 = tr_read<v_rd_off(D0, 0, 1)>(vb), l1 = tr_read<v_rd_off(D0, 1, 0)>(vb), h1 = tr_read<v_rd_off(D0, 1, 1)>(vb);
  const s16x4 l2 = tr_read<v_rd_off(D0, 2, 0)>(vb), h2 = tr_read<v_rd_off(D0, 2, 1)>(vb), l3 = tr_read<v_rd_off(D0, 3, 0)>(vb), h3 = tr_read<v_rd_off(D0, 3, 1)>(vb);
  asm volatile("s_waitcnt lgkmcnt(0)" ::: "memory"); SBAR();
#define PK(L, H) (bf16x8){L[0], L[1], L[2], L[3], H[0], H[1], H[2], H[3]}
  od = __builtin_amdgcn_mfma_f32_32x32x16_bf16(pa0, PK(l0, h0), od, 0, 0, 0);
  od = __builtin_amdgcn_mfma_f32_32x32x16_bf16(pa1, PK(l1, h1), od, 0, 0, 0);
  od = __builtin_amdgcn_mfma_f32_32x32x16_bf16(pa2, PK(l2, h2), od, 0, 0, 0);
  od = __builtin_amdgcn_mfma_f32_32x32x16_bf16(pa3, PK(l3, h3), od, 0, 0, 0);
#undef PK
}
__device__ __forceinline__ void pv_d0(f32x16* o, int vb, bf16x8 pa0, bf16x8 pa1, bf16x8 pa2, bf16x8 pa3) {
  pv_one<0>(o[0], vb, pa0, pa1, pa2, pa3); pv_one<1>(o[1], vb, pa0, pa1, pa2, pa3); pv_one<2>(o[2], vb, pa0, pa1, pa2, pa3); pv_one<3>(o[3], vb, pa0, pa1, pa2, pa3);
}
constexpr float MASKV = -3.0e4f;
__device__ __forceinline__ void bandmask(f32x16& p0, f32x16& p1, int kb, int qi, int hi, float slope_raw) {
#pragma unroll
  for (int r = 0; r < 16; ++r) {
    int d0 = kb + crow(r, hi) - qi; d0 = d0 < 0 ? -d0 : d0; int d1 = kb + 32 + crow(r, hi) - qi; d1 = d1 < 0 ? -d1 : d1;
    p0[r] = d0 > 64 ? MASKV : fmaf(-slope_raw, (float)d0, p0[r]);
    p1[r] = d1 > 64 ? MASKV : fmaf(-slope_raw, (float)d1, p1[r]);
  }
}

template <int DQK, int SD, bool BAND>
__device__ __forceinline__ void attn_unit(const bf16_t* __restrict__ Qb, long ldq, const bf16_t* __restrict__ Kh, long ldk, const bf16_t* __restrict__ Vh, long ldv,
                                          bf16_t* Ob, long ldo, int kt0, int NT, float scale, int q0, float slope_raw, float* lse, long ld_lse, char* lds) {
  constexpr int ND = DQK / 16, NKC = DQK / 8, KPT = NKC / 8;
  constexpr int SHM_V = 64 * 128 * 2, SHM_K = 64 * DQK * 2;
  int tid_ = threadIdx.x; asm volatile("" : "+v"(tid_));
  const int tid = tid_, wid = tid >> 6, lane = tid & 63, r32 = lane & 31, hi = lane >> 5;
  char* V_lds = lds; char* K_lds = lds + 2 * SHM_V;
  float* ws = (float*)(lds + 2 * SHM_V + 2 * SHM_K) + wid * 64; float* li_l = ws; float* al_l = ws + 32;
  const float C = scale * 1.4426950408889634f, thr_raw = 8.f / scale;
  float m_reg = BAND ? MASKV : -1e30f, l_reg = 0; f32x16 o[4] = {}; bf16x8 qr[ND];
  const bf16_t* Qw = Qb + (long)(wid * 32 + r32) * ldq + hi * 8;
#pragma unroll
  for (int d0 = 0; d0 < ND; ++d0) qr[d0] = *(const AGAS bf16x8*)(Qw + d0 * 16);
  static_assert(DQK == 128, "pipelined body: DQK = 128");
  const int sr = tid >> 4, sc = (tid & 15) * 8, vst0 = v_st(sr, sc);
  const unsigned vgo0 = (unsigned)(sr * (int)ldv + sc) * 2u, kgo0 = (unsigned)(sr * (int)ldk + sc) * 2u;
  const int klo0 = sr * 256 + ((sc * 2) ^ ((sr & 15) << 4));
  const int vb0 = (int)(uintptr_t)V_lds + v_rd_base(lane);
  const int qi = q0 + wid * 32 + r32;
  bf16x8 vsA0, vsA1, ksA[KPT], vsB0, vsB1, ksB[KPT];
#define KLOADS(KS, k0) do { const char* kb_ = (const char*)Kh + (long)(k0) * ldk * 2; KS[0] = *(const AGAS bf16x8*)(kb_ + kgo0); KS[1] = *(const AGAS bf16x8*)(kb_ + 32 * ldk * 2 + kgo0); } while (0)
#define KWRITES(KS, b) do { *(bf16x8*)(K_lds + (b) * SHM_K + klo0) = KS[0]; *(bf16x8*)(K_lds + (b) * SHM_K + 8192 + klo0) = KS[1]; } while (0)
#define SLOAD_A(k0) do { const char* vb_ = (const char*)Vh + (long)(k0) * ldv * 2; vsA0 = *(const AGAS bf16x8*)(vb_ + vgo0); vsA1 = *(const AGAS bf16x8*)(vb_ + 32 * ldv * 2 + vgo0); KLOADS(ksA, k0); } while (0)
#define SLOAD_B(k0) do { const char* vb_ = (const char*)Vh + (long)(k0) * ldv * 2; vsB0 = *(const AGAS bf16x8*)(vb_ + vgo0); vsB1 = *(const AGAS bf16x8*)(vb_ + 32 * ldv * 2 + vgo0); KLOADS(ksB, k0); } while (0)
#define SWRITE_A(b) do { *(bf16x8*)(V_lds + (b) * SHM_V + vst0) = vsA0; *(bf16x8*)(V_lds + (b) * SHM_V + 8192 + vst0) = vsA1; KWRITES(ksA, b); } while (0)
#define SWRITE_B(b) do { *(bf16x8*)(V_lds + (b) * SHM_V + vst0) = vsB0; *(bf16x8*)(V_lds + (b) * SHM_V + 8192 + vst0) = vsB1; KWRITES(ksB, b); } while (0)
#define SLOAD_E(k0) SLOAD_A(k0)
#define SWRITE_E(b) SWRITE_A(b)
#define SLOAD_O(k0) do { if constexpr (SD == 2) { SLOAD_B(k0); } else { SLOAD_A(k0); } } while (0)
#define SWRITE_O(b) do { if constexpr (SD == 2) { SWRITE_B(b); } else { SWRITE_A(b); } } while (0)
#define SWAIT() do { if constexpr (SD == 2) { if constexpr (KPT == 2) asm volatile("s_waitcnt vmcnt(4)" ::: "memory"); else asm volatile("s_waitcnt vmcnt(5)" ::: "memory"); } else asm volatile("s_waitcnt vmcnt(0)" ::: "memory"); } while (0)
#define RESC(a) do { if (__any((a) < 1.f)) { if (hi == 0) al_l[r32] = (a); asm volatile("s_waitcnt lgkmcnt(0)" ::: "memory"); \
    _Pragma("unroll") for (int d = 0; d < 4; ++d) _Pragma("unroll") for (int r = 0; r < 16; ++r) o[d][r] *= al_l[crow(r, hi)]; } } while (0)
#define BMASK(P0, P1, t) do { if constexpr (BAND) bandmask(P0, P1, (kt0 + (t)) * 64, qi, hi, slope_raw); } while (0)
  f32x16 pA0, pA1, pB0, pB1; float mnA, mnB, alA, alB; bf16x8 pa0, pa1, pa2, pa3;
  const int kbase = kt0 * 64;
  SLOAD_E(kbase); asm volatile("s_waitcnt vmcnt(0)" ::: "memory"); SWRITE_E(0); __syncthreads();
  qkt<DQK>(pA0, pA1, K_lds, qr, r32, hi); BMASK(pA0, pA1, 0); partialSM(pA0, pA1, m_reg, mnA, alA, C, thr_raw);
  SLOAD_O(kbase + 64); if constexpr (SD == 2) { if (2 < NT) SLOAD_E(kbase + 128); }
  SWAIT(); SWRITE_O(1); __syncthreads();
  for (int j = 1; j + 1 < NT; j += 2) {
    SBAR(); qkt<DQK>(pB0, pB1, K_lds + SHM_K, qr, r32, hi); BMASK(pB0, pB1, j);
    finishSM(pA0, pA1, alA, l_reg, pa0, pa1, pa2, pa3); SBAR();
    SLOAD_O(kbase + (j + SD) * 64); SBAR();
    pv_d0(o, vb0, pa0, pa1, pa2, pa3); partialSM(pB0, pB1, m_reg, mnB, alB, C, thr_raw);
    __syncthreads(); SWAIT(); SWRITE_E(0);
    RESC(alB); __syncthreads();
    SBAR(); qkt<DQK>(pA0, pA1, K_lds, qr, r32, hi); BMASK(pA0, pA1, j + 1);
    finishSM(pB0, pB1, alB, l_reg, pa0, pa1, pa2, pa3); SBAR();
    if (SD == 1 || j + 3 < NT) SLOAD_E(kbase + (j + 1 + SD) * 64); SBAR();
    pv_d0(o, vb0 + SHM_V, pa0, pa1, pa2, pa3); partialSM(pA0, pA1, m_reg, mnA, alA, C, thr_raw);
    __syncthreads(); SWAIT(); SWRITE_O(1);
    RESC(alA); __syncthreads();
  }
  SBAR(); qkt<DQK>(pB0, pB1, K_lds + SHM_K, qr, r32, hi); BMASK(pB0, pB1, NT - 1);
  finishSM(pA0, pA1, alA, l_reg, pa0, pa1, pa2, pa3); SBAR();
  pv_d0(o, vb0, pa0, pa1, pa2, pa3); partialSM(pB0, pB1, m_reg, mnB, alB, C, thr_raw);
  __syncthreads(); RESC(alB);
  finishSM(pB0, pB1, alB, l_reg, pa0, pa1, pa2, pa3); SBAR();
  pv_d0(o, vb0 + SHM_V, pa0, pa1, pa2, pa3);
  if (hi == 0) li_l[r32] = l_reg; asm volatile("s_waitcnt lgkmcnt(0)" ::: "memory");
  if constexpr (BAND) { if (hi == 0) *(AGAS float*)(lse + (long)(wid * 32 + r32) * ld_lse) = m_reg * scale + __logf(l_reg); }
  float rli[16];
#pragma unroll
  for (int r = 0; r < 16; ++r) rli[r] = __builtin_amdgcn_rcpf(li_l[crow(r, hi)]);
  bf16_t* Ow = Ob + (long)(wid * 32) * ldo;
  {
    char* stg = lds + 2 * SHM_V + 2 * SHM_K + 2048 + wid * 4608;
#pragma unroll
    for (int h = 0; h < 2; ++h) {
#pragma unroll
      for (int r = 0; r < 16; ++r) { const int orow = crow(r, hi);
#pragma unroll
        for (int dd = 0; dd < 2; ++dd) { const float v = o[2 * h + dd][r] * rli[r]; *(bf16_t*)(stg + orow * 144 + (dd * 32 + r32) * 2) = (bf16_t)(cvtpk(v, v) & 0xffffu); } }
      asm volatile("s_waitcnt lgkmcnt(0)" ::: "memory");
#pragma unroll
      for (int i = 0; i < 4; ++i) { const int row = i * 8 + (lane >> 3), ch = lane & 7; const u32x4 v = *(const u32x4*)(stg + row * 144 + ch * 16);
        *(AGAS u32x4*)(Ow + (long)row * ldo + h * 64 + ch * 8) = v; }
      asm volatile("s_waitcnt lgkmcnt(0)" ::: "memory");
    } }
  __syncthreads();
#undef KLOADS
#undef KWRITES
#undef SLOAD_A
#undef SLOAD_B
#undef SWRITE_A
#undef SWRITE_B
#undef SLOAD_E
#undef SWRITE_E
#undef SLOAD_O
#undef SWRITE_O
#undef SWAIT
#undef RESC
#undef BMASK
}

template <int DQK, bool BAND>
__device__ __forceinline__ void attn_unit_simple(const bf16_t* __restrict__ Qb, long ldq, const bf16_t* __restrict__ Kh, long ldk, const bf16_t* __restrict__ Vh, long ldv,
                                                 bf16_t* Ob, long ldo, int kt0, int NT, float scale, int q0, float slope_raw, float* lse, long ld_lse, char* lds) {
  constexpr int ND = DQK / 16, NKC = DQK / 8, KPT = NKC / 8;
  constexpr int KST = DQK * 2, SWM = (DQK == 128) ? 15 : 7;
  constexpr int SHM_V = 64 * 128 * 2, SHM_K = 64 * KST;
  int tid_ = threadIdx.x; asm volatile("" : "+v"(tid_));
  const int tid = tid_, wid = tid >> 6, lane = tid & 63, r32 = lane & 31, hi = lane >> 5;
  char* V_lds = lds; char* K_lds = lds + 2 * SHM_V;
  float* ws = (float*)(lds + 2 * SHM_V + 2 * SHM_K) + wid * 64; float* li_l = ws; float* al_l = ws + 32;
  const float C = scale * 1.4426950408889634f, thr_raw = 8.f / scale;
  float m_reg = BAND ? MASKV : -1e30f, l_reg = 0; f32x16 o[4] = {}; bf16x8 qr[ND];
  const bf16_t* Qw = Qb + (long)(wid * 32 + r32) * ldq + hi * 8;
#pragma unroll
  for (int d0 = 0; d0 < ND; ++d0) qr[d0] = *(const AGAS bf16x8*)(Qw + d0 * 16);
  const int sr = tid >> 4, sc = (tid & 15) * 8, vst0 = v_st(sr, sc), vst1 = v_st(32 + sr, sc);
  const unsigned vgo0 = (unsigned)(sr * (int)ldv + sc) * 2u, vgo1 = vgo0 + (unsigned)(32 * (int)ldv) * 2u;
  unsigned kgo[KPT]; int klo[KPT];
#pragma unroll
  for (int i = 0; i < KPT; ++i) { const int c = tid + 512 * i, row = c / NKC, cc = c % NKC; kgo[i] = (unsigned)(row * (int)ldk + cc * 8) * 2u; klo[i] = row * KST + ((cc * 16) ^ ((row & SWM) << 4)); }
  const int vb0 = (int)(uintptr_t)V_lds + v_rd_base(lane);
  const int qi = q0 + wid * 32 + r32;
  bf16x8 vsA0, vsA1, ksA[KPT], vsB0, vsB1, ksB[KPT];
#define SLOADX(VS0, VS1, KS, t) do { const char* vb_ = (const char*)Vh + (long)(kt0 + (t)) * 64 * ldv * 2; const char* kb_ = (const char*)Kh + (long)(kt0 + (t)) * 64 * ldk * 2; \
    VS0 = *(const AGAS bf16x8*)(vb_ + vgo0); VS1 = *(const AGAS bf16x8*)(vb_ + vgo1); \
    _Pragma("unroll") for (int i_ = 0; i_ < KPT; ++i_) KS[i_] = *(const AGAS bf16x8*)(kb_ + kgo[i_]); } while (0)
#define SWRITEX(VS0, VS1, KS, b) do { *(bf16x8*)(V_lds + (b) * SHM_V + vst0) = VS0; *(bf16x8*)(V_lds + (b) * SHM_V + vst1) = VS1; \
    _Pragma("unroll") for (int i_ = 0; i_ < KPT; ++i_) *(bf16x8*)(K_lds + (b) * SHM_K + klo[i_]) = KS[i_]; } while (0)
  f32x16 p0, p1; float mn, al; bf16x8 pa0, pa1, pa2, pa3;
#define STEP(j, b) do { \
    bool active = true; \
    if constexpr (BAND) { const int kb = (kt0 + (j)) * 64, qw0 = q0 + wid * 32; active = (kb <= qw0 + 31 + 64) && (kb + 63 >= qw0 - 64); } \
    if (active) { \
      qkt<DQK>(p0, p1, K_lds + (b) * SHM_K, qr, r32, hi); \
      if constexpr (BAND) bandmask(p0, p1, (kt0 + (j)) * 64, qi, hi, slope_raw); \
      partialSM(p0, p1, m_reg, mn, al, C, thr_raw); \
      if (__any(al < 1.f)) { if (hi == 0) al_l[r32] = al; asm volatile("s_waitcnt lgkmcnt(0)" ::: "memory"); \
        _Pragma("unroll") for (int d = 0; d < 4; ++d) _Pragma("unroll") for (int r = 0; r < 16; ++r) o[d][r] *= al_l[crow(r, hi)]; } \
      finishSM(p0, p1, al, l_reg, pa0, pa1, pa2, pa3); SBAR(); \
      pv_d0(o, vb0 + (b) * SHM_V, pa0, pa1, pa2, pa3); \
    } } while (0)
  constexpr bool TWO = (DQK == 128);
  SLOADX(vsA0, vsA1, ksA, 0); SWRITEX(vsA0, vsA1, ksA, 0);
  if constexpr (TWO) {
    if (1 < NT) SLOADX(vsB0, vsB1, ksB, 1);
    for (int j = 0; j < NT; j += 2) {
      __syncthreads();
      if (j + 2 < NT) SLOADX(vsA0, vsA1, ksA, j + 2);
      STEP(j, 0);
      if (j + 1 < NT) SWRITEX(vsB0, vsB1, ksB, 1);
      if (j + 1 >= NT) break;
      __syncthreads();
      if (j + 3 < NT) SLOADX(vsB0, vsB1, ksB, j + 3);
      STEP(j + 1, 1);
      if (j + 2 < NT) SWRITEX(vsA0, vsA1, ksA, 0);
    }
  } else {
    for (int j = 0; j < NT; ++j) {
      const int b = j & 1;
      __syncthreads();
      if (j + 1 < NT) SLOADX(vsA0, vsA1, ksA, j + 1);
      STEP(j, b);
      if (j + 1 < NT) SWRITEX(vsA0, vsA1, ksA, b ^ 1);
    }
  }
  if (hi == 0) li_l[r32] = l_reg; asm volatile("s_waitcnt lgkmcnt(0)" ::: "memory");
  if constexpr (BAND) { if (hi == 0) *(AGAS float*)(lse + (long)(wid * 32 + r32) * ld_lse) = m_reg * scale + __logf(l_reg); }
  float rli[16];
#pragma unroll
  for (int r = 0; r < 16; ++r) rli[r] = __builtin_amdgcn_rcpf(li_l[crow(r, hi)]);
  bf16_t* Ow = Ob + (long)(wid * 32) * ldo;
  if constexpr (true)
  {
    char* stg = lds + 2 * SHM_V + 2 * SHM_K + 2048 + wid * 4608;
#pragma unroll
    for (int h = 0; h < 2; ++h) {
#pragma unroll
      for (int r = 0; r < 16; ++r) { const int orow = crow(r, hi);
#pragma unroll
        for (int dd = 0; dd < 2; ++dd) { const float v = o[2 * h + dd][r] * rli[r]; *(bf16_t*)(stg + orow * 144 + (dd * 32 + r32) * 2) = (bf16_t)(cvtpk(v, v) & 0xffffu); } }
      asm volatile("s_waitcnt lgkmcnt(0)" ::: "memory");
#pragma unroll
      for (int i = 0; i < 4; ++i) { const int row = i * 8 + (lane >> 3), ch = lane & 7; const u32x4 v = *(const u32x4*)(stg + row * 144 + ch * 16);
        *(AGAS u32x4*)(Ow + (long)row * ldo + h * 64 + ch * 8) = v; }
      asm volatile("s_waitcnt lgkmcnt(0)" ::: "memory");
    } }
  else {
#pragma unroll
  for (int r = 0; r < 16; ++r) { const int orow = crow(r, hi);
#pragma unroll
    for (int d0 = 0; d0 < 4; ++d0) { const float v = o[d0][r] * rli[r]; *(AGAS bf16_t*)(Ow + (long)orow * ldo + d0 * 32 + r32) = (bf16_t)(cvtpk(v, v) & 0xffffu); } }
  }
  __syncthreads();
#undef SLOADX
#undef SWRITEX
#undef STEP
}
#undef SBAR
}

#define LAS __attribute__((address_space(3)))
#define GAS __attribute__((address_space(1)))
typedef unsigned short bf16_t;
typedef float f32x4 __attribute__((ext_vector_type(4)));
typedef unsigned u32x4 __attribute__((ext_vector_type(4)));
typedef unsigned u32x2 __attribute__((ext_vector_type(2)));

constexpr int DM = 2048, NB = 8, SEQ = 4096, M = NB * SEQ, DFF = 5632, WIN_N = 6976, ZP = 7168, DEPTH = 2;
constexpr int CQR = 512, CKVR = 256, CQW = 768, CKVW = 1024;
constexpr float EPS = 1e-6f;
constexpr int NWAVES = 8;
constexpr size_t MiB = 1u << 20;
constexpr size_t WS_ROPE_A = 0;
constexpr size_t WS_ROPE_C = 64 * 1024;
constexpr size_t WS_BAR = 1152 * 1024;
constexpr size_t WS_SS = 1216 * 1024;
constexpr size_t WS_WB = 2 * MiB;
constexpr size_t WB_GU1 = 0, WB_D1 = WB_GU1 + (size_t)2 * DFF * DM * 2, WB_IN = WB_D1 + (size_t)DM * DFF * 2, WB_OUT = WB_IN + (size_t)ZP * DM * 2,
                 WB_GU2 = WB_OUT + (size_t)DM * DM * 2, WB_D2 = WB_GU2 + (size_t)2 * DFF * DM * 2, WB_CQ = WB_D2 + (size_t)DM * DFF * 2, WB_CKV = WB_CQ + (size_t)CQW * CQR * 2,
                 WB_END = WB_CKV + (size_t)CKVW * CKVR * 2;
static_assert(WB_END <= 170 * MiB, "weights");
constexpr size_t WS_XN = 172 * MiB;
constexpr size_t WS_LSE = 300 * MiB;
constexpr size_t WS_CQA = 302 * MiB;
constexpr size_t WS_CKVA = 334 * MiB;
constexpr size_t WS_CQ = 350 * MiB;
constexpr size_t WS_CKV = 398 * MiB;
constexpr size_t WS_KC = 462 * MiB;
constexpr size_t WS_Z = 510 * MiB;
constexpr size_t WS_END = WS_Z + (size_t)M * ZP * 2;
static_assert(WS_END <= 1024 * MiB, "ws");
constexpr int LDS_BYTES = 147456;

__device__ __forceinline__ float wave_sum(float v) {
#pragma unroll
  for (int o = 1; o < 64; o <<= 1) v += __shfl_xor(v, o);
  return v;
}
__device__ __forceinline__ float bf2f(unsigned h) { return __uint_as_float(h << 16); }
__device__ __forceinline__ unsigned pk2(float lo, float hi) { return pg8::cvt_pk_bf16(lo, hi); }
__device__ __forceinline__ void unpack8(u32x4 w, float* x) {
  x[0] = __uint_as_float(w.x << 16); x[1] = __uint_as_float(w.x & 0xffff0000u); x[2] = __uint_as_float(w.y << 16); x[3] = __uint_as_float(w.y & 0xffff0000u);
  x[4] = __uint_as_float(w.z << 16); x[5] = __uint_as_float(w.z & 0xffff0000u); x[6] = __uint_as_float(w.w << 16); x[7] = __uint_as_float(w.w & 0xffff0000u);
}
__device__ __forceinline__ u32x4 pack8(const float* x) { u32x4 w; w.x = pk2(x[0], x[1]); w.y = pk2(x[2], x[3]); w.z = pk2(x[4], x[5]); w.w = pk2(x[6], x[7]); return w; }

__device__ __forceinline__ int dest_row(int n0, int mode) {
  if (mode == 0) return n0;
  return n0 < DFF ? 256 * (n0 / 128) + (n0 % 128) : 256 * ((n0 - DFF) / 128) + 128 + ((n0 - DFF) % 128);
}
__device__ __forceinline__ void transpose_item(const float* W, int K, int N, bf16_t* WT, int mode, const float* gain, LAS float* scr, int item, int lane) {
  const int nblk = N / 32, kb = item / nblk, nb = item % nblk, k0 = 64 * kb, n0 = 32 * nb;
  const int dr0 = dest_row(n0, mode);
#pragma unroll 16
  for (int i = 0; i < 32; ++i) { const int kk = 2 * i + (lane >> 5); scr[kk * 33 + (lane & 31)] = __builtin_nontemporal_load((const GAS float*)(W + (size_t)(k0 + kk) * N + n0 + (lane & 31))); }
  asm volatile("s_waitcnt lgkmcnt(0)" ::: "memory");
  const int c = lane & 7;
  f32x4 ga = (f32x4){1.f, 1.f, 1.f, 1.f}, gb = ga;
  if (gain) { ga = *(const GAS f32x4*)(gain + k0 + 8 * c); gb = *(const GAS f32x4*)(gain + k0 + 8 * c + 4); }
#pragma unroll
  for (int j = 0; j < 4; ++j) { const int n = (lane >> 3) + 8 * j; const LAS float* s = scr + (8 * c) * 33 + n;
    u32x4 o; o.x = pk2(s[0 * 33] * ga.x, s[1 * 33] * ga.y); o.y = pk2(s[2 * 33] * ga.z, s[3 * 33] * ga.w); o.z = pk2(s[4 * 33] * gb.x, s[5 * 33] * gb.y); o.w = pk2(s[6 * 33] * gb.z, s[7 * 33] * gb.w);
    *(GAS u32x4*)(WT + (size_t)(dr0 + n) * K + k0 + 8 * c) = o; }
  asm volatile("s_waitcnt lgkmcnt(0)" ::: "memory");
}

struct Args { const float* in[21]; float* out; unsigned char* ws; };
template <class T> __device__ __forceinline__ T* asglobal(T* p) { return (T*)(__attribute__((address_space(1))) T*)p; }
constexpr int LDS_PTAB = 131072;
struct PT {
  LAS const unsigned long long* t; float* out; unsigned char* ws;
  __device__ __forceinline__ const float* in(int k) const { const unsigned long long v = t[k];
    const unsigned lo = __builtin_amdgcn_readfirstlane((unsigned)v), hi = __builtin_amdgcn_readfirstlane((unsigned)(v >> 32));
    return asglobal((const float*)(((unsigned long long)hi << 32) | lo)); }
};

__device__ __forceinline__ void norm_rows(const float* X, const float* g, bf16_t* out, int gw, int NGW, int lane) {
  asm volatile("" : "+v"(lane));
  f32x4 gv[8];
#pragma unroll
  for (int j = 0; j < 8; ++j) gv[j] = ((const GAS f32x4*)g)[lane + 64 * j];
  for (int m = gw; m < M; m += NGW) {
    const GAS f32x4* xr = (const GAS f32x4*)(X + (size_t)m * DM) + lane;
    f32x4 v[8]; float s = 0.f;
#pragma unroll
    for (int j = 0; j < 8; ++j) { v[j] = xr[64 * j]; s += (v[j].x * v[j].x + v[j].y * v[j].y) + (v[j].z * v[j].z + v[j].w * v[j].w); }
    const float r = rsqrtf(wave_sum(s) * (1.f / DM) + EPS);
    GAS u32x2* o = (GAS u32x2*)(out + (size_t)m * DM) + lane;
#pragma unroll
    for (int j = 0; j < 8; ++j) { u32x2 w; w.x = pk2(v[j].x * r * gv[j].x, v[j].y * r * gv[j].y); w.y = pk2(v[j].z * r * gv[j].z, v[j].w * r * gv[j].w); o[64 * j] = w; }
  }
}

__device__ __forceinline__ void xb_init_rows(const float* X, bf16_t* xb, float* ss, int rb0, int lw, int nlw, int lane)     {
  asm volatile("" : "+v"(lane));
  for (int m = rb0 + lw; m < rb0 + SEQ; m += nlw) {
    const GAS f32x4* xr = (const GAS f32x4*)(X + (size_t)m * DM) + lane;
    f32x4 v[8]; float s = 0.f;
#pragma unroll
    for (int j = 0; j < 8; ++j) { v[j] = __builtin_nontemporal_load(xr + 64 * j); s += (v[j].x * v[j].x + v[j].y * v[j].y) + (v[j].z * v[j].z + v[j].w * v[j].w); }
    s = wave_sum(s);
    GAS u32x2* o = (GAS u32x2*)(xb + (size_t)m * DM) + lane;
#pragma unroll
    for (int j = 0; j < 8; ++j) { u32x2 w; w.x = pk2(v[j].x, v[j].y); w.y = pk2(v[j].z, v[j].w); o[64 * j] = w; }
    if (lane == 0) *(GAS unsigned long long*)((unsigned long long*)ss + m) = (unsigned long long)(s * pg8::SS_SCALE);
  }
}
__device__ __forceinline__ void zero_f32(float* p, int n, int gtid, int nthreads) { for (int i = gtid; i < n; i += nthreads) *(GAS float*)(p + i) = 0.f; }

__device__ __forceinline__ void convert_weights(const PT& a, int l, LAS unsigned char* lds, int gw, int NGW, int wave, int lane) {
  asm volatile("" : "+v"(lane));
  LAS float* scr = (LAS float*)(lds + wave * 16384);
  unsigned char* wb = a.ws + WS_WB;
  const int I_GU = (DM / 64) * (2 * DFF / 32), I_D = (DFF / 64) * (DM / 32), I_IN = (DM / 64) * (WIN_N / 32), I_OUT = (DM / 64) * (DM / 32),
            I_CQ = (CQR / 64) * (CQW / 32), I_CKV = (CKVR / 64) * (CKVW / 32);
  const int NIT = 2 * I_GU + 2 * I_D + I_IN + I_OUT + I_CQ + I_CKV;
  for (int it = gw; it < NIT; it += NGW) {
    int r = it;
    if (r < I_GU) { transpose_item(a.in(2) + (size_t)l * DM * 2 * DFF, DM, 2 * DFF, (bf16_t*)(wb + WB_GU1), 1, a.in(1) + l * DM, scr, r, lane); continue; } r -= I_GU;
    if (r < I_GU) { transpose_item(a.in(19) + (size_t)l * DM * 2 * DFF, DM, 2 * DFF, (bf16_t*)(wb + WB_GU2), 1, a.in(18) + l * DM, scr, r, lane); continue; } r -= I_GU;
    if (r < I_D) { transpose_item(a.in(3) + (size_t)l * DFF * DM, DFF, DM, (bf16_t*)(wb + WB_D1), 0, nullptr, scr, r, lane); continue; } r -= I_D;
    if (r < I_D) { transpose_item(a.in(20) + (size_t)l * DFF * DM, DFF, DM, (bf16_t*)(wb + WB_D2), 0, nullptr, scr, r, lane); continue; } r -= I_D;
    if (r < I_IN) { transpose_item(a.in(5) + (size_t)l * DM * WIN_N, DM, WIN_N, (bf16_t*)(wb + WB_IN), 0, a.in(4) + l * DM, scr, r, lane); continue; } r -= I_IN;
    if (r < I_OUT) { transpose_item(a.in(17) + (size_t)l * DM * DM, DM, DM, (bf16_t*)(wb + WB_OUT), 0, nullptr, scr, r, lane); continue; } r -= I_OUT;
    if (r < I_CQ) { transpose_item(a.in(11) + (size_t)l * CQR * CQW, CQR, CQW, (bf16_t*)(wb + WB_CQ), 0, nullptr, scr, r, lane); continue; } r -= I_CQ;
    transpose_item(a.in(13) + (size_t)l * CKVR * CKVW, CKVR, CKVW, (bf16_t*)(wb + WB_CKV), 0, nullptr, scr, r, lane);
  }
  GAS u32x4* pad = (GAS u32x4*)(wb + WB_IN + (size_t)WIN_N * DM * 2);
  for (int i = gw * 64 + lane; i < (ZP - WIN_N) * DM * 2 / 16; i += NGW * 64) pad[i] = (u32x4){0u, 0u, 0u, 0u};
}

__device__ __forceinline__ void rope_tables(unsigned char* ws, int gtid, int nthreads) {
  GAS float* ta = (GAS float*)(ws + WS_ROPE_A); GAS float* tc = (GAS float*)(ws + WS_ROPE_C);
  for (int i = gtid; i < SEQ * 32; i += nthreads) {
    const int pos = i >> 5, f = i & 31;
    const float inv = powf(10000.0f, -(float)f / 32.0f);
    const float ang = (float)pos * inv;
    const float c = cosf(ang), s = sinf(ang);
    tc[i] = c; tc[SEQ * 32 + i] = s;
    if (pos < 64) { ta[i] = c; ta[64 * 32 + i] = s; }
  }
}

__device__ __forceinline__ void ld8f(const float* p, float* g) { const f32x4 g0 = *(const GAS f32x4*)p, g1 = *(const GAS f32x4*)(p + 4);
  g[0] = g0.x; g[1] = g0.y; g[2] = g0.z; g[3] = g0.w; g[4] = g1.x; g[5] = g1.y; g[6] = g1.z; g[7] = g1.w; }
__device__ __forceinline__ void prep_rows(const PT& a, int l, int rb0, int lw, int nlw, int lane)     {
  asm volatile("" : "+v"(lane));
  bf16_t* Z = (bf16_t*)(a.ws + WS_Z); bf16_t* CQA = (bf16_t*)(a.ws + WS_CQA); bf16_t* CKVA = (bf16_t*)(a.ws + WS_CKVA);
  const float* ta = (const float*)(a.ws + WS_ROPE_A);
  const int j = lane & 15, hq = lane >> 4;
  float gaq[8], gak[8], gbq[8], gbk[8], gcq[8];
  ld8f(a.in(6) + l * 128 + 8 * j, gaq); ld8f(a.in(7) + l * 128 + 8 * j, gak); ld8f(a.in(8) + l * 128 + 8 * j, gbq); ld8f(a.in(9) + l * 128 + 8 * j, gbk);
  ld8f(a.in(10) + l * CQR + 8 * lane, gcq);
  const f32x4 gckv = *(const GAS f32x4*)(a.in(12) + l * CKVR + 4 * lane);
  constexpr int RR = 1;
  for (int m0 = rb0 + lw * RR; m0 < rb0 + SEQ; m0 += nlw * RR) {
    u32x4 raw[RR][9], rawq[RR]; u32x2 rawkv[RR]; f32x4 tcs[RR][4];
#pragma unroll
    for (int rr = 0; rr < RR; ++rr) { const int m = m0 + rr; const bf16_t* zr = Z + (size_t)m * ZP; const int t = m % SEQ, prow = t >> 6, pcol = t & 63;
#pragma unroll
      for (int it = 0; it < 9; ++it) { int hh = it * 4 + hq; hh = hh < 34 ? hh : 33; const int col = hh < 10 ? hh * 128 : 1536 + (hh - 10) * 128; raw[rr][it] = *(const GAS u32x4*)(zr + col + 8 * j); }
      rawq[rr] = *(const GAS u32x4*)(zr + 6144 + 8 * lane); rawkv[rr] = *(const GAS u32x2*)(zr + 6656 + 4 * lane);
      const int pos = (j < 8) ? prow : pcol; const int fi = 8 * (j & 3);
      tcs[rr][0] = *(const GAS f32x4*)(ta + pos * 32 + fi); tcs[rr][1] = *(const GAS f32x4*)(ta + pos * 32 + fi + 4);
      tcs[rr][2] = *(const GAS f32x4*)(ta + 2048 + pos * 32 + fi); tcs[rr][3] = *(const GAS f32x4*)(ta + 2048 + pos * 32 + fi + 4); }
#pragma unroll
    for (int rr = 0; rr < RR; ++rr) { const int m = m0 + rr; bf16_t* zr = Z + (size_t)m * ZP;
#pragma unroll
      for (int it = 0; it < 9; ++it) {
        const int hh = it * 4 + hq; const bool act = hh < 34; const bool isA = hh < 10; const int hb = hh - 10;
        const int col = isA ? hh * 128 : 1536 + hb * 128;
        float x[8]; unpack8(raw[rr][it], x);
        float ss = 0.f;
#pragma unroll
        for (int e = 0; e < 8; ++e) ss += x[e] * x[e];
        ss += __shfl_xor(ss, 1); ss += __shfl_xor(ss, 2); ss += __shfl_xor(ss, 4); ss += __shfl_xor(ss, 8);
        const float r = rsqrtf(ss * (1.f / 128.f) + EPS);
        float y[8];
#pragma unroll
        for (int e = 0; e < 8; ++e) { const float g = isA ? (hh < 8 ? gaq[e] : gak[e]) : (hb < 12 ? gbq[e] : gbk[e]); y[e] = x[e] * r * g; }
        if (it < 3) {
          float xp[8];
#pragma unroll
          for (int e = 0; e < 8; ++e) xp[e] = __shfl_xor(y[e], 4);
          if (isA) {
            const float cs[8] = {tcs[rr][0].x, tcs[rr][0].y, tcs[rr][0].z, tcs[rr][0].w, tcs[rr][1].x, tcs[rr][1].y, tcs[rr][1].z, tcs[rr][1].w};
            const float sn[8] = {tcs[rr][2].x, tcs[rr][2].y, tcs[rr][2].z, tcs[rr][2].w, tcs[rr][3].x, tcs[rr][3].y, tcs[rr][3].z, tcs[rr][3].w};
            const bool first = (j & 4) == 0;
#pragma unroll
            for (int e = 0; e < 8; ++e) y[e] = first ? (y[e] * cs[e] - xp[e] * sn[e]) : (xp[e] * sn[e] + y[e] * cs[e]);
          }
        }
        if (act) *(GAS u32x4*)(zr + col + 8 * j) = pack8(y);
      }
      { float x[8]; unpack8(rawq[rr], x); float ss = 0.f;
#pragma unroll
        for (int e = 0; e < 8; ++e) ss += x[e] * x[e];
        const float r = rsqrtf(wave_sum(ss) * (1.f / CQR) + EPS);
        float y[8];
#pragma unroll
        for (int e = 0; e < 8; ++e) y[e] = x[e] * r * gcq[e];
        *(GAS u32x4*)(CQA + (size_t)m * CQR + 8 * lane) = pack8(y); }
      { const u32x2 w = rawkv[rr];
        const float x0 = __uint_as_float(w.x << 16), x1 = __uint_as_float(w.x & 0xffff0000u), x2 = __uint_as_float(w.y << 16), x3 = __uint_as_float(w.y & 0xffff0000u);
        const float r = rsqrtf(wave_sum((x0 * x0 + x1 * x1) + (x2 * x2 + x3 * x3)) * (1.f / CKVR) + EPS);
        u32x2 o; o.x = pk2(x0 * r * gckv.x, x1 * r * gckv.y); o.y = pk2(x2 * r * gckv.z, x3 * r * gckv.w);
        *(GAS u32x2*)(CKVA + (size_t)m * CKVR + 4 * lane) = o; }
    }
  }
}

__device__ __forceinline__ void cpost_rows(const PT& a, int l, int rb0, int lw, int nlw, int lane)     {
  asm volatile("" : "+v"(lane));
  bf16_t* Z = (bf16_t*)(a.ws + WS_Z); bf16_t* CQ = (bf16_t*)(a.ws + WS_CQ); bf16_t* CKV = (bf16_t*)(a.ws + WS_CKV); bf16_t* KC = (bf16_t*)(a.ws + WS_KC);
  const float* tc = (const float*)(a.ws + WS_ROPE_C);
  const bool act = lane < 48; const int e0 = 4 * lane; const bool isrope = lane >= 32 && act, first = lane < 40;
  const int ri = 4 * ((lane - 32) & 7);
  const f32x4 z4 = {0.f, 0.f, 0.f, 0.f};
  const f32x4 gqv = act ? *(const GAS f32x4*)(a.in(14) + l * 192 + e0) : z4, gkv = act ? *(const GAS f32x4*)(a.in(15) + l * 192 + e0) : z4;
  constexpr int RR = 4;
  for (int m0 = rb0 + lw * RR; m0 < rb0 + SEQ; m0 += nlw * RR) {
    u32x2 rq[RR][4], rk[RR][4]; f32x4 csv[RR], snv[RR]; const u32x2 zz = {0u, 0u};
#pragma unroll
    for (int rr = 0; rr < RR; ++rr) { const int m = m0 + rr, t = m % SEQ;
      csv[rr] = *(const GAS f32x4*)(tc + t * 32 + ri); snv[rr] = *(const GAS f32x4*)(tc + SEQ * 32 + t * 32 + ri);
#pragma unroll
      for (int h = 0; h < 4; ++h) {
        rq[rr][h] = act ? *(const GAS u32x2*)(CQ + (size_t)m * CQW + h * 192 + e0) : zz;
        const bf16_t* ksrc = lane < 32 ? CKV + (size_t)m * CKVW + h * 256 + e0 : Z + (size_t)m * ZP + 6912 + (e0 - 128);
        rk[rr][h] = act ? *(const GAS u32x2*)ksrc : zz; } }
#pragma unroll
    for (int rr = 0; rr < RR; ++rr) { const int m = m0 + rr;
#pragma unroll
      for (int h = 0; h < 4; ++h) {
#pragma unroll
        for (int qk = 0; qk < 2; ++qk) {
          const u32x2 w = qk == 0 ? rq[rr][h] : rk[rr][h]; const f32x4 g = qk == 0 ? gqv : gkv;
          const f32x4 x = {__uint_as_float(w.x << 16), __uint_as_float(w.x & 0xffff0000u), __uint_as_float(w.y << 16), __uint_as_float(w.y & 0xffff0000u)};
          const float r = rsqrtf(wave_sum((x.x * x.x + x.y * x.y) + (x.z * x.z + x.w * x.w)) * (1.f / 192.f) + EPS);
          f32x4 y = x * r * g;
          f32x4 yp; yp.x = __shfl_xor(y.x, 8); yp.y = __shfl_xor(y.y, 8); yp.z = __shfl_xor(y.z, 8); yp.w = __shfl_xor(y.w, 8);
          if (isrope) y = first ? (y * csv[rr] - yp * snv[rr]) : (yp * snv[rr] + y * csv[rr]);
          u32x2 o; o.x = pk2(y.x, y.y); o.y = pk2(y.z, y.w);
          bf16_t* dst = qk == 0 ? CQ + (size_t)m * CQW + h * 192 + e0 : KC + (size_t)m * CQW + h * 192 + e0;
          if (act) *(GAS u32x2*)dst = o;
        }
      }
    }
  }
}

__device__ __forceinline__ void ynorm_rows(const PT& a, int l, bf16_t* Y, int rb0, int lw, int nlw, int lane)     {
  asm volatile("" : "+v"(lane));
  const bf16_t* Z = (const bf16_t*)(a.ws + WS_Z); const bf16_t* OC = (const bf16_t*)(a.ws + WS_CQA); const GAS float* LSE = (const GAS float*)(a.ws + WS_LSE);
  const float* gn = a.in(16) + l * DM;
  float gA0[8], gA1[8], gB[8], gC[8];
  ld8f(gn + 8 * lane, gA0); ld8f(gn + 512 + 8 * lane, gA1); ld8f(gn + 1024 + 8 * lane, gB); ld8f(gn + 1536 + 8 * lane, gC);
  const int jh = lane >> 4, d = (lane & 15) * 8;
  constexpr int RR = 2;
  for (int m0 = rb0 + lw * RR; m0 < rb0 + SEQ; m0 += nlw * RR) {
    u32x4 ra0[RR], ra1[RR], rb0[RR], rb1[RR], rb2[RR], rc[RR]; float l0[RR], l1[RR], l2[RR];
#pragma unroll
    for (int rr = 0; rr < RR; ++rr) { const int m = m0 + rr; const bf16_t* zr = Z + (size_t)m * ZP;
      ra0[rr] = *(const GAS u32x4*)(zr + 8 * lane); ra1[rr] = *(const GAS u32x4*)(zr + 512 + 8 * lane);
      rb0[rr] = *(const GAS u32x4*)(zr + 1536 + jh * 128 + d); rb1[rr] = *(const GAS u32x4*)(zr + 1536 + (4 + jh) * 128 + d); rb2[rr] = *(const GAS u32x4*)(zr + 1536 + (8 + jh) * 128 + d);
      rc[rr] = *(const GAS u32x4*)(OC + (size_t)m * 512 + jh * 128 + d);
      l0[rr] = LSE[(size_t)m * 12 + jh]; l1[rr] = LSE[(size_t)m * 12 + 4 + jh]; l2[rr] = LSE[(size_t)m * 12 + 8 + jh]; }
#pragma unroll
    for (int rr = 0; rr < RR; ++rr) { const int m = m0 + rr; bf16_t* yr = Y + (size_t)m * DM;
      { float x[16]; unpack8(ra0[rr], x); unpack8(ra1[rr], x + 8); float ss = 0.f;
#pragma unroll
        for (int e = 0; e < 16; ++e) ss += x[e] * x[e];
        const float r = rsqrtf(wave_sum(ss) * (1.f / 1024.f) + EPS);
        float y0[8], y1[8];
#pragma unroll
        for (int e = 0; e < 8; ++e) { y0[e] = x[e] * r * gA0[e]; y1[e] = x[8 + e] * r * gA1[e]; }
        *(GAS u32x4*)(yr + 8 * lane) = pack8(y0); *(GAS u32x4*)(yr + 512 + 8 * lane) = pack8(y1); }
      { const float mx = fmaxf(l0[rr], fmaxf(l1[rr], l2[rr])); const float e0 = __expf(l0[rr] - mx), e1 = __expf(l1[rr] - mx), e2 = __expf(l2[rr] - mx); const float inv = 1.f / (e0 + e1 + e2);
        float x0[8], x1[8], x2[8], ob[8]; unpack8(rb0[rr], x0); unpack8(rb1[rr], x1); unpack8(rb2[rr], x2);
        float ss = 0.f;
#pragma unroll
        for (int e = 0; e < 8; ++e) { ob[e] = (e0 * inv) * x0[e] + (e1 * inv) * x1[e] + (e2 * inv) * x2[e]; ss += ob[e] * ob[e]; }
        const float r = rsqrtf(wave_sum(ss) * (1.f / 512.f) + EPS);
        float y[8];
#pragma unroll
        for (int e = 0; e < 8; ++e) y[e] = ob[e] * r * gB[e];
        *(GAS u32x4*)(yr + 1024 + 8 * lane) = pack8(y); }
      { float x[8]; unpack8(rc[rr], x); float ss = 0.f;
#pragma unroll
        for (int e = 0; e < 8; ++e) ss += x[e] * x[e];
        const float r = rsqrtf(wave_sum(ss) * (1.f / 512.f) + EPS);
        float y[8];
#pragma unroll
        for (int e = 0; e < 8; ++e) y[e] = x[e] * r * gC[e];
        *(GAS u32x4*)(yr + 1536 + 8 * lane) = pack8(y); }
    }
  }
}

__device__ __forceinline__ void attention_phase(const PT& a, char* lds, int bid, int G) {
  bf16_t* Z = (bf16_t*)(a.ws + WS_Z); bf16_t* CQ = (bf16_t*)(a.ws + WS_CQ); const bf16_t* CKV = (const bf16_t*)(a.ws + WS_CKV); const bf16_t* KC = (const bf16_t*)(a.ws + WS_KC);
  float* LSE = (float*)(a.ws + WS_LSE);
  const int xcd = bid & 7, li = bid >> 3, nloc = G >> 3;
  const size_t rb = (size_t)xcd * SEQ;
#ifndef ATM
#define ATM 7
#endif
#ifndef REPA
#define REPA 0
#endif
#ifndef REPC
#define REPC 0
#endif
#ifndef REPB
#define REPB 0
#endif
  bf16_t* OC = (bf16_t*)(a.ws + WS_CQA);
  if constexpr (ATM & 1) for (int u = li; u < 128; u += nloc) { const int h = u >> 4, qb = u & 15, kvh = h >> 2;
    bf16_t* q = Z + (rb + (size_t)qb * 256) * ZP + h * 128;
    att::attn_unit<128, 2, false>(q, ZP, Z + rb * ZP + 1024 + kvh * 128, ZP, Z + rb * ZP + 1280 + kvh * 128, ZP, q, ZP, 0, SEQ / 64, 0.08838834764831845f, 0, 0.f, nullptr, 0, lds); }
  if constexpr (ATM & 2) for (int u = li; u < 64; u += nloc) { const int h = u >> 4, qb = u & 15;
    const bf16_t* q = CQ + (rb + (size_t)qb * 256) * CQW + h * 192;
    att::attn_unit_simple<192, false>(q, CQW, KC + rb * CQW + h * 192, CQW, CKV + rb * CKVW + h * 256 + 128, CKVW, OC + (rb + (size_t)qb * 256) * 512 + h * 128, 512, 0, SEQ / 64, 0.07216878364870323f, 0, 0.f, nullptr, 0, lds); }
  if constexpr (ATM & 4) for (int u = li; u < 192; u += nloc) { const int g = u >> 6, jh = (u >> 4) & 3, w = u & 15;
    const int dil = g == 0 ? 1 : (g == 1 ? 4 : 16), ups = 16 / dil, r = w / ups, qb = w % ups, L = SEQ / dil, hb = g * 4 + jh;
    const int q0 = qb * 256; int lo = q0 / 64 - 1; if (lo < 0) lo = 0; int hi = q0 / 64 + 5; if (hi > L / 64) hi = L / 64;
    if ((hi - lo) & 1) { if (lo > 0) --lo; else ++hi; }
    const float slope = exp2f(-8.0f * (float)(hb + 1) / 12.0f);
    const float slope_raw = slope * (float)dil * 11.313708498984761f;
    const long ld = (long)dil * ZP; const size_t base = (rb + r) * ZP;
    bf16_t* q = Z + base + (size_t)q0 * ld + 1536 + hb * 128;
    att::attn_unit_simple<128, true>(q, ld, Z + base + 3072 + hb * 128, ld, Z + base + 4608 + hb * 128, ld, q, ld, lo, hi - lo, 0.08838834764831845f, q0, slope_raw,
                                 LSE + (rb + r + (size_t)q0 * dil) * 12 + hb, (long)dil * 12, lds); }
}


#define XB_TMO      128
#define XB_XCNT(j)  (256  + 64 * (j))
#define XB_XSUB(j)  (1280 + 64 * (j))
#define XB_XGEN(j)  (2304 + 64 * (j))
#define XB_TOP      3328
#define XB_TOPGEN   3392
#define XB_LSUB(j)  (3456 + 64 * (j))
#define XB_LGEN(j)  (4480 + 64 * (j))
#define XCD_BAR_WORDS 5504
#define XB_SPIN_CAP (1u << 18)
__device__ __forceinline__ unsigned xb_ld(unsigned* p)              { return __hip_atomic_load(p, __ATOMIC_RELAXED, __HIP_MEMORY_SCOPE_AGENT); }
__device__ __forceinline__ unsigned xb_add(unsigned* p, unsigned v) { return __hip_atomic_fetch_add(p, v, __ATOMIC_RELAXED, __HIP_MEMORY_SCOPE_AGENT); }
__device__ __forceinline__ unsigned xb_xcc_id() { return (unsigned)__builtin_amdgcn_s_getreg((3 << 11) | 20) & 0xFu; }
#define XB_SPIN(cond, bar) do { unsigned _sp = 0; while (cond) { __builtin_amdgcn_s_sleep(1); \
    if ((++_sp & 255u) == 0u) { if (xb_ld(&(bar)[XB_TMO])) break; if (_sp > XB_SPIN_CAP) { atomicAdd(&(bar)[XB_TMO], 1u); break; } } } } while (0)
struct XcdBarrier { unsigned* bar; unsigned x; volatile LAS unsigned* st; };
__device__ __forceinline__ XcdBarrier xcd_barrier_post(unsigned* bar, volatile LAS unsigned* st) {
    XcdBarrier b; b.bar = bar; b.x = xb_xcc_id(); b.st = st;
    if (threadIdx.x == 0) st[4] = xb_add(&bar[XB_XCNT(b.x)], 1u);
    return b;
}
__device__ __forceinline__ void xcd_barrier_complete(unsigned* bar, unsigned x, unsigned& nloc, unsigned& nx, unsigned& even8) {
    const unsigned G = gridDim.x * gridDim.y * gridDim.z;
    unsigned sum, cnt, mine, sp = 0u;
    for (;;) {
        sum = 0u; cnt = 0u; mine = 0u;
#pragma unroll
        for (unsigned j = 0; j < 16; ++j) { const unsigned c = xb_ld(&bar[XB_XCNT(j)]); sum += c; cnt += (c > 0u) ? 1u : 0u; mine = (j == x) ? c : mine; }
        if (sum == G) break;
        __builtin_amdgcn_s_sleep(1);
        if ((++sp & 255u) == 0u) { if (xb_ld(&bar[XB_TMO])) break; if (sp > XB_SPIN_CAP) { atomicAdd(&bar[XB_TMO], 1u); break; } }
    }
    nloc = mine > 0u ? mine : 1u; nx = cnt > 0u ? cnt : 1u;
    unsigned eq = (cnt == 8u && sum == G) ? 1u : 0u;
#pragma unroll
    for (unsigned j = 0; j < 8; ++j) { if (xb_ld(&bar[XB_XCNT(j)]) * 8u != G) eq = 0u; }
    even8 = eq;
}
__device__ __forceinline__ void xcd_barrier(const XcdBarrier& b) {
    asm volatile("s_waitcnt vmcnt(0)" ::: "memory");
    __syncthreads();
    if (threadIdx.x == 0) {
        unsigned* bar = b.bar;
        __builtin_amdgcn_s_waitcnt(0);
        unsigned nloc = b.st[0], nx = b.st[1];
        if (nloc == 0u) { unsigned e8; xcd_barrier_complete(bar, b.x, nloc, nx, e8); b.st[0] = nloc; b.st[1] = nx; b.st[2] = e8; b.st[3] = e8 ? (b.x + 8u * b.st[4]) : blockIdx.x; }
        const unsigned old = xb_add(&bar[XB_XSUB(b.x)], 1u);
        const unsigned gen = old / nloc;
        if (old + 1u == (gen + 1u) * nloc) {
            __builtin_amdgcn_fence(__ATOMIC_RELEASE, "agent");
            asm volatile("s_waitcnt vmcnt(0)" ::: "memory");
            const unsigned og = xb_add(&bar[XB_TOP], 1u);
            const unsigned tg = og / nx;
            if (og + 1u == (tg + 1u) * nx) xb_add(&bar[XB_TOPGEN], 1u);
            else XB_SPIN(xb_ld(&bar[XB_TOPGEN]) == tg, bar);
            __builtin_amdgcn_fence(__ATOMIC_ACQUIRE, "agent");
            xb_add(&bar[XB_XGEN(b.x)], 1u);
            asm volatile("s_waitcnt vmcnt(0)" ::: "memory");
        } else {
            XB_SPIN(xb_ld(&bar[XB_XGEN(b.x)]) == gen, bar);
            __builtin_amdgcn_fence(__ATOMIC_ACQUIRE, "agent");
            asm volatile("s_waitcnt vmcnt(0)" ::: "memory");
        }
    }
    __syncthreads();
}

__device__ __forceinline__ void xcd_local_barrier(const XcdBarrier& b) {
    asm volatile("s_waitcnt vmcnt(0)" ::: "memory");
    __syncthreads();
    if (threadIdx.x == 0) {
        unsigned* bar = b.bar;
        __builtin_amdgcn_s_waitcnt(0);
        const unsigned nloc = b.st[0];
        const unsigned old = xb_add(&bar[XB_LSUB(b.x)], 1u);
        const unsigned gen = old / nloc;
        if (old + 1u == (gen + 1u) * nloc) xb_add(&bar[XB_LGEN(b.x)], 1u);
        else XB_SPIN(xb_ld(&bar[XB_LGEN(b.x)]) == gen, bar);
        __builtin_amdgcn_fence(__ATOMIC_ACQUIRE, "agent");
        asm volatile("s_waitcnt vmcnt(0)" ::: "memory");
    }
    __syncthreads();
}

#ifndef PHM
#define PHM 0xFFFF
#endif
#define PH(k) if constexpr ((PHM >> (k)) & 1)
#ifndef WGM_GU
#define WGM_GU 4
#endif
#ifndef WGM_IN
#define WGM_IN 4
#endif
#ifndef REPGU
#define REPGU 1
#endif
#ifndef REPIN
#define REPIN 1
#endif
#ifndef REPNC
#define REPNC 1
#endif
__global__ void __launch_bounds__(NWAVES * 64, 2) fwd_megakernel(Args ka) {
  extern __shared__ __attribute__((aligned(16))) unsigned char lds[];
  cg::grid_group grid = cg::this_grid();
  LAS unsigned char* ldsl = (LAS unsigned char*)lds;
  const int tid = threadIdx.x, lane = tid & 63, wave = __builtin_amdgcn_readfirstlane(tid >> 6);
  int G = gridDim.x, bid = blockIdx.x;
  int gw = bid * NWAVES + wave, NGW = G * NWAVES;
#define FRESH() do { asm volatile("" : "+s"(G), "+s"(bid), "+s"(gw), "+s"(NGW), "+s"(ws), "+s"(wb), "+s"(out), "+s"(XN), "+s"(Z), "+s"(H)); \
    ws = asglobal(ws); wb = asglobal(wb); out = asglobal(out); XN = asglobal(XN); Z = asglobal(Z); H = asglobal(H); } while (0)
  { LAS unsigned long long* pt = (LAS unsigned long long*)(ldsl + LDS_PTAB);
    if (tid == 0) {
#define PTS(k) pt[k] = (unsigned long long)ka.in[k]
      PTS(0); PTS(1); PTS(2); PTS(3); PTS(4); PTS(5); PTS(6); PTS(7); PTS(8); PTS(9); PTS(10); PTS(11); PTS(12); PTS(13); PTS(14); PTS(15); PTS(16); PTS(17); PTS(18); PTS(19); PTS(20);
#undef PTS
      pt[32] = 0ull; pt[33] = 0ull;
    } }
  if (blockIdx.x == 0) for (int i = tid; i < XCD_BAR_WORDS; i += NWAVES * 64) *(GAS unsigned*)((unsigned*)(ka.ws + WS_BAR) + i) = 0u;
  __syncthreads();
  unsigned char* ws = ka.ws; unsigned char* wb = ws + WS_WB;
  PT a; a.t = (LAS const unsigned long long*)(ldsl + LDS_PTAB); a.out = ka.out; a.ws = ka.ws;
  bf16_t* XN = (bf16_t*)(ws + WS_XN); bf16_t* Z = (bf16_t*)(ws + WS_Z); bf16_t* H = Z;
  float* out = a.out;
  PH(0) rope_tables(ws, bid * (NWAVES * 64) + tid, G * NWAVES * 64);
  XcdBarrier xbar; xbar.bar = (unsigned*)(ka.ws + WS_BAR); xbar.x = 0; xbar.st = (volatile LAS unsigned*)(ldsl + LDS_PTAB + 256);
#define GSYNC() do { xcd_barrier(xbar); FRESH(); a.ws = ws; a.out = out; } while (0)
#define LSYNC() do { if (xlocal) xcd_local_barrier(xbar); else xcd_barrier(xbar); FRESH(); a.ws = ws; a.out = out; } while (0)
  bool xlocal = false;
  float* SSa = (float*)(ws + WS_SS);
  PH(2) xb_init_rows(a.in(0), XN, SSa, (bid & 7) * SEQ, (bid >> 3) * NWAVES + wave, (G >> 3) * NWAVES, lane);
#pragma unroll 1
  for (int l = 0; l < DEPTH; ++l) {
    FRESH(); a.ws = ws; a.out = out;
    for (int rep_ = 0; rep_ < REPNC; ++rep_) { PH(1) convert_weights(a, l, ldsl, gw, NGW, wave, lane); }
    zero_f32((float*)(ws + WS_SS) + 2 * M, 4 * M, bid * (NWAVES * 64) + tid, G * NWAVES * 64);
    if (l == 0) { grid.sync(); xbar = xcd_barrier_post((unsigned*)(ka.ws + WS_BAR), (volatile LAS unsigned*)(ldsl + LDS_PTAB + 256)); xcd_barrier(xbar);
      bid = __builtin_amdgcn_readfirstlane((int)xbar.st[3]); gw = bid * NWAVES + wave; xlocal = false  ; FRESH(); a.ws = ws; a.out = out; }
    else GSYNC();
    for (int rep_ = 0; rep_ < REPGU; ++rep_) PH(3) { pg8::Gemm g{XN, (const bf16_t*)(wb + WB_GU1), M, 2 * DFF, DM, DM}; pg8::StaticOrder S; S.init(M, 2 * DFF, G, bid, WGM_GU); pg8::EpiSwiGLU E{H, DFF, (const float*)(ws + WS_SS)};
      pg8::gemm_phase(ldsl, g, S, E); }
    LSYNC();
    PH(4) { pg8::Gemm g{H, (const bf16_t*)(wb + WB_D1), M, DM, DFF, DFF}; pg8::StaticOrder S; S.init(M, DM, G, bid); pg8::EpiResid<1, WS_XN, WS_SS + (size_t)M * 8, false> E{out, ws};
      pg8::gemm_phase(ldsl, g, S, E); }
    LSYNC();
    for (int rep_ = 0; rep_ < REPIN; ++rep_) PH(5) { pg8::Gemm g{XN, (const bf16_t*)(wb + WB_IN), M, ZP, DM, DM}; pg8::StaticOrder S; S.init(M, ZP, G, bid, WGM_IN); pg8::EpiBf16 E{Z, ZP, (const float*)(ws + WS_SS + (size_t)M * 8)};
      pg8::gemm_phase(ldsl, g, S, E); }
    LSYNC();
    PH(6) prep_rows(a, l, (bid & 7) * SEQ, (bid >> 3) * NWAVES + wave, (G >> 3) * NWAVES, lane);
    { unsigned long long* ssa = (unsigned long long*)(ws + WS_SS) + (bid & 7) * SEQ;
      for (int i = (bid >> 3) * (NWAVES * 64) + tid; i < SEQ; i += (G >> 3) * (NWAVES * 64)) __hip_atomic_store(ssa + i, 0ull, __ATOMIC_RELAXED, __HIP_MEMORY_SCOPE_AGENT); }
    LSYNC();
    PH(5) { pg8::Gemm g{(const bf16_t*)(ws + WS_CQA), (const bf16_t*)(wb + WB_CQ), M, CQW, CQR, CQR}; pg8::StaticOrder S; S.init(M, CQW, G, bid); pg8::EpiBf16 E{(bf16_t*)(ws + WS_CQ), CQW, nullptr};
      pg8::gemm_phase(ldsl, g, S, E); }
    PH(5) { pg8::Gemm g{(const bf16_t*)(ws + WS_CKVA), (const bf16_t*)(wb + WB_CKV), M, CKVW, CKVR, CKVR}; pg8::StaticOrder S; S.init(M, CKVW, G, bid); pg8::EpiBf16 E{(bf16_t*)(ws + WS_CKV), CKVW, nullptr};
      pg8::gemm_phase(ldsl, g, S, E); }
    LSYNC();
    PH(7) cpost_rows(a, l, (bid & 7) * SEQ, (bid >> 3) * NWAVES + wave, (G >> 3) * NWAVES, lane);
    LSYNC();
    PH(8) attention_phase(a, (char*)lds, bid, G);
    LSYNC();
    PH(9) ynorm_rows(a, l, (bf16_t*)(ws + WS_CQ), (bid & 7) * SEQ, (bid >> 3) * NWAVES + wave, (G >> 3) * NWAVES, lane);
    LSYNC();
    PH(4) { pg8::Gemm g{(const bf16_t*)(ws + WS_CQ), (const bf16_t*)(wb + WB_OUT), M, DM, DM, DM}; pg8::StaticOrder S; S.init(M, DM, G, bid); pg8::EpiResid<2, WS_XN, WS_SS + (size_t)M * 16, false> E{out, ws};
      pg8::gemm_phase(ldsl, g, S, E); }
    LSYNC();
    for (int rep_ = 0; rep_ < REPGU; ++rep_) PH(3) { pg8::Gemm g{XN, (const bf16_t*)(wb + WB_GU2), M, 2 * DFF, DM, DM}; pg8::StaticOrder S; S.init(M, 2 * DFF, G, bid, WGM_GU); pg8::EpiSwiGLU E{H, DFF, (const float*)(ws + WS_SS + (size_t)M * 16)};
      pg8::gemm_phase(ldsl, g, S, E); }
    LSYNC();
    if (l + 1 < DEPTH) { pg8::Gemm g{H, (const bf16_t*)(wb + WB_D2), M, DM, DFF, DFF}; pg8::StaticOrder S; S.init(M, DM, G, bid); pg8::EpiResid<1, WS_XN, WS_SS, false> E{out, ws};
      pg8::gemm_phase(ldsl, g, S, E); }
    else { pg8::Gemm g{H, (const bf16_t*)(wb + WB_D2), M, DM, DFF, DFF}; pg8::StaticOrder S; S.init(M, DM, G, bid); pg8::EpiResid<1, WS_XN, WS_SS, true> E{out, ws};
      pg8::gemm_phase(ldsl, g, S, E); }
    GSYNC();
  }
}

extern "C" void kernel_launch(void* const* d_in, const int* in_sizes, int n_in, void* d_out, int out_size, void* d_ws, size_t ws_size, hipStream_t stream) {
  static int grid = 0;
  if (grid == 0) {
    if (n_in != 21 || in_sizes[0] != M * DM || out_size != M * DM || ws_size < WS_END) { fprintf(stderr, "kernel_launch: unexpected shapes (n_in %d, ws %zu)\n", n_in, ws_size); grid = -1; return; }
    int dev = 0, cus = 0, per_cu = 0;
    hipGetDevice(&dev); hipDeviceGetAttribute(&cus, hipDeviceAttributeMultiprocessorCount, dev);
    hipFuncSetAttribute((const void*)fwd_megakernel, hipFuncAttributeMaxDynamicSharedMemorySize, LDS_BYTES);
    hipOccupancyMaxActiveBlocksPerMultiprocessor(&per_cu, (const void*)fwd_megakernel, NWAVES * 64, LDS_BYTES);
    if (per_cu < 1) { fprintf(stderr, "kernel_launch: occupancy query says %d blocks per CU\n", per_cu); per_cu = 1; }
    (void)hipGetLastError();
    grid = cus * 1;
    grid -= grid % 8;
  }
  if (grid < 0) return;
  Args a{};
  for (int i = 0; i < 21; ++i) a.in[i] = (const float*)d_in[i];
  a.out = (float*)d_out; a.ws = (unsigned char*)d_ws;
  void* args[] = {&a};
  hipError_t e = hipLaunchCooperativeKernel((const void*)fwd_megakernel, dim3(grid), dim3(NWAVES * 64), args, LDS_BYTES, stream);
  if (e != hipSuccess) fprintf(stderr, "cooperative launch failed: %s (grid %d)\n", hipGetErrorString(e), grid);
}
```

```cpp
#include <hip/hip_runtime.h>
#include <hip/hip_bf16.h>
#include <hip/hip_cooperative_groups.h>
#include <cstdio>
#include <cstdint>
namespace cg = cooperative_groups;

namespace pg8 {
#define PG8_LAS __attribute__((address_space(3)))
#define PG8_GAS __attribute__((address_space(1)))
typedef unsigned short bf16_t;
typedef short bf16x8 __attribute__((ext_vector_type(8)));
typedef float f32x4 __attribute__((ext_vector_type(4)));
typedef unsigned u32x4 __attribute__((ext_vector_type(4)));
constexpr int BM = 256, BK = 64, HALF = 128, HTB = HALF * BK * 2  , STAGE_BYTES = 8 * HTB, NXCD = 8, WGM = 4;

__host__ __device__ __forceinline__ int lds_byte(int r, int c) { const int st = (r >> 4) * 2 + (c >> 5), rr = r & 15, cc = c & 31, ob = rr * 64 + cc * 2; return st * 1024 + (ob ^ (((ob >> 9) & 1) << 5)); }
__host__ __device__ __forceinline__ void stage_rc(int b, int& R, int& C) { const int st = b / 1024, sb = b % 1024, swz = sb ^ (((sb >> 9) & 1) << 5); R = (st >> 1) * 16 + swz / 64; C = (st & 1) * 32 + (swz % 64) / 2; }
__host__ __device__ __forceinline__ int perm32(int rho) { const int n = rho >> 4, i = rho & 15; return 8 * (i >> 2) + 4 * n + (i & 3); }

struct Unit { int pm, pn; };
struct Gemm { const bf16_t* A; const bf16_t* Bt; int M, N, K, lda; };

struct StaticOrder {
    int nM, nN, nwg, G, c, wgm;
    __host__ __device__ void init(int M, int N, int G_, int c_, int wgm_ = 4) { nM = M / BM; nN = N / BM; nwg = nM * nN; G = G_; c = c_; wgm = wgm_; }
    __host__ __device__ bool next(int i, Unit& u) const {
        const long L = (long)i * G + c; if (L >= nwg) return false;
        int wgid = (int)L; { const int q = nwg / NXCD, r = nwg % NXCD, xcd = wgid % NXCD, off = wgid / NXCD; wgid = (xcd < r ? xcd * (q + 1) : r * (q + 1) + (xcd - r) * q) + off; }
        const int nig = wgm * nN, gid = wgid / nig, fm = gid * wgm, gsz = (nM - fm) < wgm ? (nM - fm) : wgm;
        u.pm = fm + ((wgid % nig) % gsz); u.pn = (wgid % nig) / gsz; return true;
    }
};

__device__ __forceinline__ unsigned cvt_pk_bf16(float lo, float hi) { unsigned r; asm volatile("v_cvt_pk_bf16_f32 %0, %1, %2" : "=v"(r) : "v"(lo), "v"(hi)); return r; }

constexpr float SS_SCALE = 4194304.0f, SS_INV = 1.0f / 4194304.0f;
__device__ __forceinline__ float row_rstd(const float* ss, int row, float invn) { const unsigned long long v = *(const PG8_GAS unsigned long long*)((const unsigned long long*)ss + row); return __builtin_amdgcn_rsqf((float)v * SS_INV * invn + 1e-6f); }
constexpr int RSTD_TAB_OFF = 131072 + 1024;
struct EpiBf16 {
    static constexpr bool PERM = true;
    static constexpr bool RSTD_TAB = true;
    bf16_t* O; int ldc; const float* ss;
    __device__ __forceinline__ void operator()(const f32x4 (&acc)[2][2][4][2], const Unit& u, int wr, int wc, int fr, int fq, PG8_LAS unsigned char* lds) const {
        const int row0 = u.pm * BM + wr * 64 + fr; const int col0 = u.pn * BM + wc * 32 + 8 * fq;
        const PG8_LAS float* tab = (const PG8_LAS float*)(lds + RSTD_TAB_OFF) + wr * 64 + fr;
#pragma unroll
        for (int ai = 0; ai < 2; ++ai)
#pragma unroll
            for (int m = 0; m < 4; ++m) { const int row = row0 + ai * HALF + m * 16; bf16_t* rowp = O + (size_t)row * ldc + col0;
                const float r = ss ? tab[ai * HALF + m * 16] : 1.0f;
#pragma unroll
                for (int bj = 0; bj < 2; ++bj) { const f32x4 v0 = acc[ai][bj][m][0] * r, v1 = acc[ai][bj][m][1] * r;
                    u32x4 w; w.x = cvt_pk_bf16(v0[0], v0[1]); w.y = cvt_pk_bf16(v0[2], v0[3]); w.z = cvt_pk_bf16(v1[0], v1[1]); w.w = cvt_pk_bf16(v1[2], v1[3]);
                    *(PG8_GAS u32x4*)(rowp + bj * HALF) = w; } }
    }
};
__device__ __forceinline__ float silu_mul(float g, float u) { return g * u * __builtin_amdgcn_rcpf(1.0f + __builtin_amdgcn_exp2f(-1.4426950408889634f * g)); }
struct EpiSwiGLU {
    static constexpr bool PERM = true;
    static constexpr bool RSTD_TAB = true;
    bf16_t* H; int ldh; const float* ss;
    __device__ __forceinline__ void operator()(const f32x4 (&acc)[2][2][4][2], const Unit& u, int wr, int wc, int fr, int fq, PG8_LAS unsigned char* lds) const {
        const int row0 = u.pm * BM + wr * 64 + fr; const int col0 = u.pn * HALF + wc * 32 + 8 * fq;
        const PG8_LAS float* tab = (const PG8_LAS float*)(lds + RSTD_TAB_OFF) + wr * 64 + fr;
#pragma unroll
        for (int ai = 0; ai < 2; ++ai)
#pragma unroll
            for (int m = 0; m < 4; ++m) { const int row = row0 + ai * HALF + m * 16; bf16_t* rowp = H + (size_t)row * ldh + col0;
                const float r = tab[ai * HALF + m * 16];
                const f32x4 g0 = acc[ai][0][m][0] * r, g1 = acc[ai][0][m][1] * r, u0 = acc[ai][1][m][0] * r, u1 = acc[ai][1][m][1] * r;
                u32x4 w; w.x = cvt_pk_bf16(silu_mul(g0[0], u0[0]), silu_mul(g0[1], u0[1])); w.y = cvt_pk_bf16(silu_mul(g0[2], u0[2]), silu_mul(g0[3], u0[3]));
                w.z = cvt_pk_bf16(silu_mul(g1[0], u1[0]), silu_mul(g1[1], u1[1])); w.w = cvt_pk_bf16(silu_mul(g1[2], u1[2]), silu_mul(g1[3], u1[3]));
                *(PG8_GAS u32x4*)rowp = w; }
    }
};
template <int ALPHA2, size_t ROFF, size_t SSOFF, bool F32OUT>
struct EpiResid {
    static constexpr bool PERM = true;
    static constexpr int ldc = 2048; static constexpr float alpha = 0.5f * ALPHA2;
    static constexpr bool RSTD_TAB = false;
    float* out; unsigned char* ws;
    __device__ __forceinline__ void operator()(const f32x4 (&acc)[2][2][4][2], const Unit& u, int wr, int wc, int fr, int fq, PG8_LAS unsigned char*) const {
        const int row0 = u.pm * BM + wr * 64 + fr; const int col0 = u.pn * BM + wc * 32 + 8 * fq;
        bf16_t* R = (bf16_t*)(ws + ROFF); float* ssq = (float*)(ws + SSOFF);
#pragma unroll
        for (int ai = 0; ai < 2; ++ai) {
            u32x4 pre[4][2];
#pragma unroll
            for (int m = 0; m < 4; ++m) { const size_t off = (size_t)(row0 + ai * HALF + m * 16) * ldc + col0;
#pragma unroll
                for (int bj = 0; bj < 2; ++bj) pre[m][bj] = *(const PG8_GAS u32x4*)(R + off + bj * HALF); }
#pragma unroll
            for (int m = 0; m < 4; ++m) { const int row = row0 + ai * HALF + m * 16; const size_t off = (size_t)row * ldc + col0; float sq = 0.f;
#pragma unroll
                for (int bj = 0; bj < 2; ++bj) { const u32x4 b = pre[m][bj];
                    const f32x4 b0 = {__uint_as_float(b.x << 16), __uint_as_float(b.x & 0xffff0000u), __uint_as_float(b.y << 16), __uint_as_float(b.y & 0xffff0000u)};
                    const f32x4 b1 = {__uint_as_float(b.z << 16), __uint_as_float(b.z & 0xffff0000u), __uint_as_float(b.w << 16), __uint_as_float(b.w & 0xffff0000u)};
                    const f32x4 o0 = b0 + acc[ai][bj][m][0] * alpha, o1 = b1 + acc[ai][bj][m][1] * alpha;
                    if constexpr (F32OUT) { __builtin_nontemporal_store(o0, (PG8_GAS f32x4*)(out + off + bj * HALF)); __builtin_nontemporal_store(o1, (PG8_GAS f32x4*)(out + off + bj * HALF + 4)); }
                    u32x4 w; w.x = cvt_pk_bf16(o0[0], o0[1]); w.y = cvt_pk_bf16(o0[2], o0[3]); w.z = cvt_pk_bf16(o1[0], o1[1]); w.w = cvt_pk_bf16(o1[2], o1[3]);
                    if constexpr (!F32OUT) *(PG8_GAS u32x4*)(R + off + bj * HALF) = w;
                    sq += ((o0[0] * o0[0] + o0[1] * o0[1]) + (o0[2] * o0[2] + o0[3] * o0[3])) + ((o1[0] * o1[0] + o1[1] * o1[1]) + (o1[2] * o1[2] + o1[3] * o1[3])); }
                sq += __shfl_xor(sq, 16); sq += __shfl_xor(sq, 32);
                if constexpr (!F32OUT) { if (fq == 0) __hip_atomic_fetch_add((PG8_GAS unsigned long long*)((unsigned long long*)ssq + row), (unsigned long long)(sq * SS_SCALE), __ATOMIC_RELAXED, __HIP_MEMORY_SCOPE_AGENT); } }
        }
    }
};

template <class Epi, class Sched>
__device__ __forceinline__ void gemm_phase(PG8_LAS unsigned char* lds, const Gemm g, const Sched& S, const Epi& E) {
    int tid_ = threadIdx.x; asm volatile("" : "+v"(tid_));
    const int tid = tid_, wid = __builtin_amdgcn_readfirstlane(tid >> 6), lane = tid & 63, wr = wid >> 2, wc = wid & 3, fr = lane & 15, fq = lane >> 4;
    const int K = g.K, nt = K / BK, lda = g.lda;
    unsigned voffA[2], voffB[2];
#pragma unroll
    for (int i = 0; i < 2; ++i) { int R, C; stage_rc(tid * 16 + i * 8192, R, C); const int Rb = Epi::PERM ? ((R & ~31) + perm32(R & 31)) : R;
        voffA[i] = (unsigned)(R * lda + C) * 2u; voffB[i] = (unsigned)(Rb * K + C) * 2u; }
    const size_t kstep = (size_t)(BK * 2);
    const size_t hA = (size_t)HALF * lda * 2, hB = (size_t)HALF * K * 2;
    const size_t tA = 2 * hA, tB = 2 * hB;
    const unsigned ldsw = (unsigned)wid * 1024u;
    const int aoff = lds_byte(wr * 64 + fr, fq * 8), boff = lds_byte(wc * 32 + fr, fq * 8);
#define PG8_SA(b, h) (((b) * 2 + (h)) * HTB)
#define PG8_SB(b, h) ((4 + (b) * 2 + (h)) * HTB)
#define PG8_STAGE(bufoff, gbase, voff) do { _Pragma("unroll") for (int _i = 0; _i < 2; ++_i) \
        __builtin_amdgcn_global_load_lds((const unsigned*)((const char*)(gbase) + (voff)[_i]), (PG8_LAS unsigned*)(lds + (bufoff) + ldsw + _i * 8192), 16, 0, 0); } while (0)
#define PG8_LDA(dst, b, h) do { _Pragma("unroll") for (int m = 0; m < 4; ++m) _Pragma("unroll") for (int k = 0; k < 2; ++k) dst[m][k] = *(const PG8_LAS bf16x8*)(lds + PG8_SA(b, h) + aoff + m * 2048 + k * 1024); } while (0)
#define PG8_LDB(dst, b, h) do { _Pragma("unroll") for (int n = 0; n < 2; ++n) _Pragma("unroll") for (int k = 0; k < 2; ++k) dst[n][k] = *(const PG8_LAS bf16x8*)(lds + PG8_SB(b, h) + boff + n * 2048 + k * 1024); } while (0)
#define PG8_MMA(ai, bj, At, Bt) do { __builtin_amdgcn_s_setprio(1); _Pragma("unroll") for (int m = 0; m < 4; ++m) _Pragma("unroll") for (int n = 0; n < 2; ++n) _Pragma("unroll") for (int k = 0; k < 2; ++k) \
        acc[ai][bj][m][n] = __builtin_amdgcn_mfma_f32_16x16x32_bf16(Bt[n][k], At[m][k], acc[ai][bj][m][n], 0, 0, 0); __builtin_amdgcn_s_setprio(0); } while (0)
#define PG8_WAIT_V(n) asm volatile("s_waitcnt vmcnt(" #n ")" ::: "memory")
#define PG8_WAIT_L(n) asm volatile("s_waitcnt lgkmcnt(" #n ")" ::: "memory")
#define PG8_BAR __builtin_amdgcn_s_barrier()
#define PG8_SCHED __builtin_amdgcn_sched_barrier(0)
    Unit cur, nxt; int ui = 0;
    if (!S.next(0, cur)) return;
    int pmc = -1;
    f32x4 acc[2][2][4][2];
#pragma unroll
    for (int a = 0; a < 2; ++a)
#pragma unroll
        for (int b = 0; b < 2; ++b)
#pragma unroll
            for (int m = 0; m < 4; ++m)
#pragma unroll
                for (int n = 0; n < 2; ++n) acc[a][b][m][n] = (f32x4){0.f, 0.f, 0.f, 0.f};
    bf16x8 At[4][2], B0[2][2], B1[2][2];
    const char* cA = (const char*)g.A + (size_t)cur.pm * tA; const char* cB = (const char*)g.Bt + (size_t)cur.pn * tB;
    PG8_STAGE(PG8_SB(0, 0), cB, voffB); PG8_STAGE(PG8_SB(0, 1), cB + hB, voffB); PG8_STAGE(PG8_SA(0, 0), cA, voffA); PG8_STAGE(PG8_SA(0, 1), cA + hA, voffA);
    if (wr == 1) PG8_BAR;
    PG8_WAIT_V(2); PG8_BAR;
    PG8_STAGE(PG8_SB(1, 0), cB + kstep, voffB); PG8_STAGE(PG8_SA(1, 0), cA + kstep, voffA); PG8_STAGE(PG8_SB(1, 1), cB + hB + kstep, voffB);
    PG8_WAIT_V(6); PG8_BAR;
    for (;;) {
        const bool has_next = S.next(ui + 1, nxt);
        const char* nA = has_next ? (const char*)g.A + (size_t)nxt.pm * tA : cA; const char* nB = has_next ? (const char*)g.Bt + (size_t)nxt.pn * tB : cB;
        for (int t = 0; t < nt; t += 2) {
            const bool last = (t == nt - 2);
            const char* a1 = cA + (size_t)(t + 1) * kstep;
            const char* a2 = last ? nA : cA + (size_t)(t + 2) * kstep; const char* b2 = last ? nB : cB + (size_t)(t + 2) * kstep;
            const char* a3 = a2 + kstep; const char* b3 = b2 + kstep;
            PG8_LDB(B0, 0, 0); PG8_LDB(B1, 0, 1); PG8_SCHED; PG8_LDA(At, 0, 0); PG8_STAGE(PG8_SA(1, 1), a1 + hA, voffA);
            PG8_WAIT_V(8); PG8_WAIT_L(0); PG8_BAR; PG8_MMA(0, 0, At, B0); PG8_MMA(0, 1, At, B1); PG8_BAR; PG8_SCHED;
            PG8_LDA(At, 0, 1); PG8_STAGE(PG8_SB(0, 0), b2, voffB); PG8_STAGE(PG8_SB(0, 1), b2 + hB, voffB); PG8_STAGE(PG8_SA(0, 0), a2, voffA);
            PG8_WAIT_V(8); PG8_WAIT_L(0); PG8_BAR; PG8_MMA(1, 0, At, B0); PG8_MMA(1, 1, At, B1); PG8_BAR; PG8_SCHED;
            PG8_LDB(B0, 1, 0); PG8_LDB(B1, 1, 1); PG8_SCHED; PG8_LDA(At, 1, 0); PG8_STAGE(PG8_SA(0, 1), a2 + hA, voffA);
            PG8_WAIT_V(8); PG8_WAIT_L(0); PG8_BAR; PG8_MMA(0, 0, At, B0); PG8_MMA(0, 1, At, B1); PG8_BAR; PG8_SCHED;
            PG8_LDA(At, 1, 1); PG8_STAGE(PG8_SB(1, 0), b3, voffB); PG8_STAGE(PG8_SB(1, 1), b3 + hB, voffB); PG8_STAGE(PG8_SA(1, 0), a3, voffA);
            PG8_WAIT_V(8); PG8_WAIT_L(0); PG8_BAR; PG8_MMA(1, 0, At, B0); PG8_MMA(1, 1, At, B1); PG8_BAR; PG8_SCHED;
        }
        if (wr == 0) PG8_BAR;
        if constexpr (Epi::RSTD_TAB) {
            if (E.ss && pmc != cur.pm) { pmc = cur.pm;
                if (tid < BM) *(PG8_LAS float*)(lds + RSTD_TAB_OFF + tid * 4) = row_rstd(E.ss, cur.pm * BM + tid, 1.0f / 2048.0f);
                PG8_WAIT_L(0); PG8_BAR; } }
        E(acc, cur, wr, wc, fr, fq, lds);
        if (!has_next) break;
#pragma unroll
        for (int a = 0; a < 2; ++a)
#pragma unroll
            for (int b = 0; b < 2; ++b)
#pragma unroll
                for (int m = 0; m < 4; ++m)
#pragma unroll
                    for (int n = 0; n < 2; ++n) acc[a][b][m][n] = (f32x4){0.f, 0.f, 0.f, 0.f};
        cur = nxt; cA = nA; cB = nB; ++ui;
        if (wr == 1) PG8_BAR;
    }
    PG8_WAIT_V(0);
    PG8_BAR;
#undef PG8_SA
#undef PG8_SB
#undef PG8_STAGE
#undef PG8_LDA
#undef PG8_LDB
#undef PG8_MMA
#undef PG8_WAIT_V
#undef PG8_WAIT_L
#undef PG8_BAR
#undef PG8_SCHED
}
}

namespace att {
typedef unsigned short bf16_t;
using bf16x8 = __attribute__((ext_vector_type(8))) short;
using s16x4  = __attribute__((ext_vector_type(4))) short;
using f32x16 = __attribute__((ext_vector_type(16))) float;
using u32x4  = __attribute__((ext_vector_type(4))) unsigned;
#define SBAR() __builtin_amdgcn_sched_barrier(0)
#define AGAS __attribute__((address_space(1)))
__device__ __forceinline__ int crow(int r, int hi) { return (r & 3) + 8 * (r >> 2) + 4 * hi; }
__device__ __forceinline__ unsigned cvtpk(float lo, float hi) { unsigned r; asm volatile("v_cvt_pk_bf16_f32 %0, %1, %2" : "=v"(r) : "v"(lo), "v"(hi)); return r; }

__device__ __forceinline__ void partialSM(f32x16& p0, f32x16& p1, float& m_reg, float& mn, float& alpha, float C, float thr_raw) {
  float pmax = p0[0];
#pragma unroll
  for (int r = 1; r < 16; ++r) pmax = fmaxf(pmax, p0[r]);
#pragma unroll
  for (int r = 0; r < 16; ++r) pmax = fmaxf(pmax, p1[r]);
  { auto rr = __builtin_amdgcn_permlane32_swap(__float_as_uint(pmax), __float_as_uint(pmax), false, false);
    pmax = fmaxf(__uint_as_float(rr[0]), __uint_as_float(rr[1])); }
  if (__builtin_expect(__all(pmax - m_reg <= thr_raw), 1)) { mn = m_reg; alpha = 1.f; }
  else { mn = fmaxf(m_reg, pmax); alpha = __builtin_amdgcn_exp2f((m_reg - mn) * C); m_reg = mn; }
  float mnC = -mn * C;
#pragma unroll
  for (int r = 0; r < 16; ++r) p0[r] = fmaf(p0[r], C, mnC);
#pragma unroll
  for (int r = 0; r < 16; ++r) p1[r] = fmaf(p1[r], C, mnC);
#pragma unroll
  for (int r = 0; r < 16; ++r) p0[r] = __builtin_amdgcn_exp2f(p0[r]);
}
__device__ __forceinline__ void finishSM(f32x16& p0, f32x16& p1, float alpha, float& l_reg, bf16x8& pa0, bf16x8& pa1, bf16x8& pa2, bf16x8& pa3) {
#pragma unroll
  for (int r = 0; r < 16; ++r) p1[r] = __builtin_amdgcn_exp2f(p1[r]);
  float ps = 0;
#pragma unroll
  for (int r = 0; r < 16; ++r) ps += p0[r];
#pragma unroll
  for (int r = 0; r < 16; ++r) ps += p1[r];
  { auto rr = __builtin_amdgcn_permlane32_swap(__float_as_uint(ps), __float_as_uint(ps), false, false);
    ps = __uint_as_float(rr[0]) + __uint_as_float(rr[1]); }
  l_reg = l_reg * alpha + ps;
#define PK4(P, BASE, OUT) do { unsigned a0 = cvtpk(P[BASE + 0], P[BASE + 1]), a1 = cvtpk(P[BASE + 2], P[BASE + 3]);   \
    unsigned b0 = cvtpk(P[BASE + 4], P[BASE + 5]), b1 = cvtpk(P[BASE + 6], P[BASE + 7]);                              \
    auto r0 = __builtin_amdgcn_permlane32_swap(a0, b0, false, false); auto r1 = __builtin_amdgcn_permlane32_swap(a1, b1, false, false); \
    u32x4 w = {r0[0], r1[0], r0[1], r1[1]}; OUT = *reinterpret_cast<bf16x8*>(&w); } while (0)
  PK4(p0, 0, pa0); PK4(p0, 8, pa1); PK4(p1, 0, pa2); PK4(p1, 8, pa3);
#undef PK4
}
template <int DQK>
__device__ __forceinline__ void qkt(f32x16& p0, f32x16& p1, const char* Ks, const bf16x8* qr, int r32, int hi) {
  p0 = f32x16{}; p1 = f32x16{};
  constexpr int KST = DQK * 2, SWM = (DQK == 128) ? 15 : 7;
  const int sw = (r32 & SWM) << 4;
#pragma unroll
  for (int d0 = 0; d0 < DQK / 16; ++d0) { const int cb = (d0 * 16 + hi * 8) * 2;
    bf16x8 b0 = *reinterpret_cast<const bf16x8*>(Ks + r32 * KST + (cb ^ sw));
    bf16x8 b1 = *reinterpret_cast<const bf16x8*>(Ks + (32 + r32) * KST + (cb ^ sw));
    p0 = __builtin_amdgcn_mfma_f32_32x32x16_bf16(b0, qr[d0], p0, 0, 0, 0);
    p1 = __builtin_amdgcn_mfma_f32_32x32x16_bf16(b1, qr[d0], p1, 0, 0, 0); }
}
__device__ __forceinline__ int v_st(int k, int c) { const int kk = (k & ~0xC) | ((k & 4) << 1) | ((k & 8) >> 1); return ((kk >> 3) * 4 + (c >> 5)) * 512 + ((kk & 7) * 32 + (c & 31)) * 2; }
__device__ __forceinline__ int v_rd_base(int lane) { return ((lane & 3) << 3) | (((lane >> 2) & 3) << 6) | (((lane >> 4) & 1) << 5) | (((lane >> 5) & 1) << 8); }
constexpr int v_rd_off(int d0, int ks, int half) { return d0 * 512 + ks * 4096 + half * 2048; }
template <int OFF> __device__ __forceinline__ s16x4 tr_read(int vb) {
  s16x4 r; asm volatile("ds_read_b64_tr_b16 %0, %1 offset:%2" : "=&v"(r) : "v"(vb), "i"(OFF) : "memory"); return r;
}
template <int D0> __device__ __forceinline__ void pv_one(f32x16& od, int vb, bf16x8 pa0, bf16x8 pa1, bf16x8 pa2, bf16x8 pa3) {
  const s16x4 l0 = tr_read<v_rd_off(D0, 0, 0)>(vb), h0 = tr_read<v_rd_off(D0, 0, 1)>(vb), l1 = tr_read<v_rd_off(D0, 1, 0)>(vb), h1 = tr_read<v_rd_off(D0, 1, 1)>(vb);
  const s16x4 l2 = tr_read<v_rd_off(D0, 2, 0)>(vb), h2 = tr_read<v_rd_off(D0, 2, 1)>(vb), l3 = tr_read<v_rd_off(D0, 3, 0)>(vb), h3 = tr_read<v_rd_off(D0, 3, 1)>(vb);
  asm volatile("s_waitcnt lgkmcnt(0)" ::: "memory"); SBAR();
#define PK(L, H) (bf16x8){L[0], L[1], L[2], L[3], H[0], H[1], H[2], H[3]}
  od = __builtin_amdgcn_mfma_f32_32x32x16_bf16(pa0, PK(l0, h0), od, 0, 0, 0);
  od = __builtin_amdgcn_mfma_f32_32x32x16_bf16(pa1, PK(l1, h1), od, 0, 0, 0);
  od = __builtin_amdgcn_mfma_f32_32x32x16_bf16(pa2, PK(l2, h2), od, 0, 0, 0);
  od = __builtin_amdgcn_mfma_f32_32x32x16_bf16(pa3, PK(l3, h3), od, 0, 0, 0);
#undef PK
}
__device__ __forceinline__ void pv_d0(f32x16* o, int vb, bf16x8 pa0, bf16x8 pa1, bf16x8 pa2, bf16x8 pa3) {
  pv_one<0>(o[0], vb, pa0, pa1, pa2, pa3); pv_one<1>(o[1], vb, pa0, pa1, pa2, pa3); pv_one<2>(o[2], vb, pa0, pa1, pa2, pa3); pv_one<3>(o[3], vb, pa0, pa1, pa2, pa3);
}
constexpr float MASKV = -3.0e4f;
__device__ __forceinline__ void bandmask(f32x16& p0, f32x16& p1, int kb, int qi, int hi, float slope_raw) {
#pragma unroll
  for (int r = 0; r < 16; ++r) {
    int d0 = kb + crow(r, hi) - qi; d0 = d0 < 0 ? -d0 : d0; int d1 = kb + 32 + crow(r, hi) - qi; d1 = d1 < 0 ? -d1 : d1;
    p0[r] = d0 > 64 ? MASKV : fmaf(-slope_raw, (float)d0, p0[r]);
    p1[r] = d1 > 64 ? MASKV : fmaf(-slope_raw, (float)d1, p1[r]);
  }
}

template <int DQK, int SD, bool BAND>
__device__ __forceinline__ void attn_unit(const bf16_t* __restrict__ Qb, long ldq, const bf16_t* __restrict__ Kh, long ldk, const bf16_t* __restrict__ Vh, long ldv,
                                          bf16_t* Ob, long ldo, int kt0, int NT, float scale, int q0, float slope_raw, float* lse, long ld_lse, char* lds) {
  constexpr int ND = DQK / 16, NKC = DQK / 8, KPT = NKC / 8;
  constexpr int SHM_V = 64 * 128 * 2, SHM_K = 64 * DQK * 2;
  int tid_ = threadIdx.x; asm volatile("" : "+v"(tid_));
  const int tid = tid_, wid = tid >> 6, lane = tid & 63, r32 = lane & 31, hi = lane >> 5;
  char* V_lds = lds; char* K_lds = lds + 2 * SHM_V;
  float* ws = (float*)(lds + 2 * SHM_V + 2 * SHM_K) + wid * 64; float* li_l = ws; float* al_l = ws + 32;
  const float C = scale * 1.4426950408889634f, thr_raw = 8.f / scale;
  float m_reg = BAND ? MASKV : -1e30f, l_reg = 0; f32x16 o[4] = {}; bf16x8 qr[ND];
  const bf16_t* Qw = Qb + (long)(wid * 32 + r32) * ldq + hi * 8;
#pragma unroll
  for (int d0 = 0; d0 < ND; ++d0) qr[d0] = *(const AGAS bf16x8*)(Qw + d0 * 16);
  static_assert(DQK == 128, "pipelined body: DQK = 128");
  const int sr = tid >> 4, sc = (tid & 15) * 8, vst0 = v_st(sr, sc);
  const unsigned vgo0 = (unsigned)(sr * (int)ldv + sc) * 2u, kgo0 = (unsigned)(sr * (int)ldk + sc) * 2u;
  const int klo0 = sr * 256 + ((sc * 2) ^ ((sr & 15) << 4));
  const int vb0 = (int)(uintptr_t)V_lds + v_rd_base(lane);
  const int qi = q0 + wid * 32 + r32;
  bf16x8 vsA0, vsA1, ksA[KPT], vsB0, vsB1, ksB[KPT];
#define KLOADS(KS, k0) do { const char* kb_ = (const char*)Kh + (long)(k0) * ldk * 2; KS[0] = *(const AGAS bf16x8*)(kb_ + kgo0); KS[1] = *(const AGAS bf16x8*)(kb_ + 32 * ldk * 2 + kgo0); } while (0)
#define KWRITES(KS, b) do { *(bf16x8*)(K_lds + (b) * SHM_K + klo0) = KS[0]; *(bf16x8*)(K_lds + (b) * SHM_K + 8192 + klo0) = KS[1]; } while (0)
#define SLOAD_A(k0) do { const char* vb_ = (const char*)Vh + (long)(k0) * ldv * 2; vsA0 = *(const AGAS bf16x8*)(vb_ + vgo0); vsA1 = *(const AGAS bf16x8*)(vb_ + 32 * ldv * 2 + vgo0); KLOADS(ksA, k0); } while (0)
#define SLOAD_B(k0) do { const char* vb_ = (const char*)Vh + (long)(k0) * ldv * 2; vsB0 = *(const AGAS bf16x8*)(vb_ + vgo0); vsB1 = *(const AGAS bf16x8*)(vb_ + 32 * ldv * 2 + vgo0); KLOADS(ksB, k0); } while (0)
#define SWRITE_A(b) do { *(bf16x8*)(V_lds + (b) * SHM_V + vst0) = vsA0; *(bf16x8*)(V_lds + (b) * SHM_V + 8192 + vst0) = vsA1; KWRITES(ksA, b); } while (0)
#define SWRITE_B(b) do { *(bf16x8*)(V_lds + (b) * SHM_V + vst0) = vsB0; *(bf16x8*)(V_lds + (b) * SHM_V + 8192 + vst0) = vsB1; KWRITES(ksB, b); } while (0)
#define SLOAD_E(k0) SLOAD_A(k0)
#define SWRITE_E(b) SWRITE_A(b)
#define SLOAD_O(k0) do { if constexpr (SD == 2) { SLOAD_B(k0); } else { SLOAD_A(k0); } } while (0)
#define SWRITE_O(b) do { if constexpr (SD == 2) { SWRITE_B(b); } else { SWRITE_A(b); } } while (0)
#define SWAIT() do { if constexpr (SD == 2) { if constexpr (KPT == 2) asm volatile("s_waitcnt vmcnt(4)" ::: "memory"); else asm volatile("s_waitcnt vmcnt(5)" ::: "memory"); } else asm volatile("s_waitcnt vmcnt(0)" ::: "memory"); } while (0)
#define RESC(a) do { if (__any((a) < 1.f)) { if (hi == 0) al_l[r32] = (a); asm volatile("s_waitcnt lgkmcnt(0)" ::: "memory"); \
    _Pragma("unroll") for (int d = 0; d < 4; ++d) _Pragma("unroll") for (int r = 0; r < 16; ++r) o[d][r] *= al_l[crow(r, hi)]; } } while (0)
#define BMASK(P0, P1, t) do { if constexpr (BAND) bandmask(P0, P1, (kt0 + (t)) * 64, qi, hi, slope_raw); } while (0)
  f32x16 pA0, pA1, pB0, pB1; float mnA, mnB, alA, alB; bf16x8 pa0, pa1, pa2, pa3;
  const int kbase = kt0 * 64;
  SLOAD_E(kbase); asm volatile("s_waitcnt vmcnt(0)" ::: "memory"); SWRITE_E(0); __syncthreads();
  qkt<DQK>(pA0, pA1, K_lds, qr, r32, hi); BMASK(pA0, pA1, 0); partialSM(pA0, pA1, m_reg, mnA, alA, C, thr_raw);
  SLOAD_O(kbase + 64); if constexpr (SD == 2) { if (2 < NT) SLOAD_E(kbase + 128); }
  SWAIT(); SWRITE_O(1); __syncthreads();
  for (int j = 1; j + 1 < NT; j += 2) {
    SBAR(); qkt<DQK>(pB0, pB1, K_lds + SHM_K, qr, r32, hi); BMASK(pB0, pB1, j);
    finishSM(pA0, pA1, alA, l_reg, pa0, pa1, pa2, pa3); SBAR();
    SLOAD_O(kbase + (j + SD) * 64); SBAR();
    pv_d0(o, vb0, pa0, pa1, pa2, pa3); partialSM(pB0, pB1, m_reg, mnB, alB, C, thr_raw);
    __syncthreads(); SWAIT(); SWRITE_E(0);
    RESC(alB); __syncthreads();
    SBAR(); qkt<DQK>(pA0, pA1, K_lds, qr, r32, hi); BMASK(pA0, pA1, j + 1);
    finishSM(pB0, pB1, alB, l_reg, pa0, pa1, pa2, pa3); SBAR();
    if (SD == 1 || j + 3 < NT) SLOAD_E(kbase + (j + 1 + SD) * 64); SBAR();
    pv_d0(o, vb0 + SHM_V, pa0, pa1, pa2, pa3); partialSM(pA0, pA1, m_reg, mnA, alA, C, thr_raw);
    __syncthreads(); SWAIT(); SWRITE_O(1);
    RESC(alA); __syncthreads();
  }
  SBAR(); qkt<DQK>(pB0, pB1, K_lds + SHM_K, qr, r32, hi); BMASK(pB0, pB1, NT - 1);
  finishSM(pA0, pA1, alA, l_reg, pa0, pa1, pa2, pa3); SBAR();
  pv_d0(o, vb0, pa0, pa1, pa2, pa3); partialSM(pB0, pB1, m_reg, mnB, alB, C, thr_raw);
  __syncthreads(); RESC(alB);
  finishSM(pB0, pB1, alB, l_reg, pa0, pa1, pa2, pa3); SBAR();
  pv_d0(o, vb0 + SHM_V, pa0, pa1, pa2, pa3);
  if (hi == 0) li_l[r32] = l_reg; asm volatile("s_waitcnt lgkmcnt(0)" ::: "memory");
  if constexpr (BAND) { if (hi == 0) *(AGAS float*)(lse + (long)(wid * 32 + r32) * ld_lse) = m_reg * scale + __logf(l_reg); }
  float rli[16];
#pragma unroll
  for (int r = 0; r < 16; ++r) rli[r] = __builtin_amdgcn_rcpf(li_l[crow(r, hi)]);
  bf16_t* Ow = Ob + (long)(wid * 32) * ldo;
  {
    char* stg = lds + 2 * SHM_V + 2 * SHM_K + 2048 + wid * 4608;
#pragma unroll
    for (int h = 0; h < 2; ++h) {
#pragma unroll
      for (int r = 0; r < 16; ++r) { const int orow = crow(r, hi);
#pragma unroll
        for (int dd = 0; dd < 2; ++dd) { const float v = o[2 * h + dd][r] * rli[r]; *(bf16_t*)(stg + orow * 144 + (dd * 32 + r32) * 2) = (bf16_t)(cvtpk(v, v) & 0xffffu); } }
      asm volatile("s_waitcnt lgkmcnt(0)" ::: "memory");
#pragma unroll
      for (int i = 0; i < 4; ++i) { const int row = i * 8 + (lane >> 3), ch = lane & 7; const u32x4 v = *(const u32x4*)(stg + row * 144 + ch * 16);
        *(AGAS u32x4*)(Ow + (long)row * ldo + h * 64 + ch * 8) = v; }
      asm volatile("s_waitcnt lgkmcnt(0)" ::: "memory");
    } }
  __syncthreads();
#undef KLOADS
#undef KWRITES
#undef SLOAD_A
#undef SLOAD_B
#undef SWRITE_A
#undef SWRITE_B
#undef SLOAD_E
#undef SWRITE_E
#undef SLOAD_O
#undef SWRITE_O
#undef SWAIT
#undef RESC
#undef BMASK
}

template <int DQK, bool BAND>
__device__ __forceinline__ void attn_unit_simple(const bf16_t* __restrict__ Qb, long ldq, const bf16_t* __restrict__ Kh, long ldk, const bf16_t* __restrict__ Vh, long ldv,
                                                 bf16_t* Ob, long ldo, int kt0, int NT, float scale, int q0, float slope_raw, float* lse, long ld_lse, char* lds) {
  constexpr int ND = DQK / 16, NKC = DQK / 8, KPT = NKC / 8;
  constexpr int KST = DQK * 2, SWM = (DQK == 128) ? 15 : 7;
  constexpr int SHM_V = 64 * 128 * 2, SHM_K = 64 * KST;
  int tid_ = threadIdx.x; asm volatile("" : "+v"(tid_));
  const int tid = tid_, wid = tid >> 6, lane = tid & 63, r32 = lane & 31, hi = lane >> 5;
  char* V_lds = lds; char* K_lds = lds + 2 * SHM_V;
  float* ws = (float*)(lds + 2 * SHM_V + 2 * SHM_K) + wid * 64; float* li_l = ws; float* al_l = ws + 32;
  const float C = scale * 1.4426950408889634f, thr_raw = 8.f / scale;
  float m_reg = BAND ? MASKV : -1e30f, l_reg = 0; f32x16 o[4] = {}; bf16x8 qr[ND];
  const bf16_t* Qw = Qb + (long)(wid * 32 + r32) * ldq + hi * 8;
#pragma unroll
  for (int d0 = 0; d0 < ND; ++d0) qr[d0] = *(const AGAS bf16x8*)(Qw + d0 * 16);
  const int sr = tid >> 4, sc = (tid & 15) * 8, vst0 = v_st(sr, sc), vst1 = v_st(32 + sr, sc);
  const unsigned vgo0 = (unsigned)(sr * (int)ldv + sc) * 2u, vgo1 = vgo0 + (unsigned)(32 * (int)ldv) * 2u;
  unsigned kgo[KPT]; int klo[KPT];
#pragma unroll
  for (int i = 0; i < KPT; ++i) { const int c = tid + 512 * i, row = c / NKC, cc = c % NKC; kgo[i] = (unsigned)(row * (int)ldk + cc * 8) * 2u; klo[i] = row * KST + ((cc * 16) ^ ((row & SWM) << 4)); }
  const int vb0 = (int)(uintptr_t)V_lds + v_rd_base(lane);
  const int qi = q0 + wid * 32 + r32;
  bf16x8 vsA0, vsA1, ksA[KPT], vsB0, vsB1, ksB[KPT];
#define SLOADX(VS0, VS1, KS, t) do { const char* vb_ = (const char*)Vh + (long)(kt0 + (t)) * 64 * ldv * 2; const char* kb_ = (const char*)Kh + (long)(kt0 + (t)) * 64 * ldk * 2; \
    VS0 = *(const AGAS bf16x8*)(vb_ + vgo0); VS1 = *(const AGAS bf16x8*)(vb_ + vgo1); \
    _Pragma("unroll") for (int i_ = 0; i_ < KPT; ++i_) KS[i_] = *(const AGAS bf16x8*)(kb_ + kgo[i_]); } while (0)
#define SWRITEX(VS0, VS1, KS, b) do { *(bf16x8*)(V_lds + (b) * SHM_V + vst0) = VS0; *(bf16x8*)(V_lds + (b) * SHM_V + vst1) = VS1; \
    _Pragma("unroll") for (int i_ = 0; i_ < KPT; ++i_) *(bf16x8*)(K_lds + (b) * SHM_K + klo[i_]) = KS[i_]; } while (0)
  f32x16 p0, p1; float mn, al; bf16x8 pa0, pa1, pa2, pa3;
#define STEP(j, b) do { \
    bool active = true; \
    if constexpr (BAND) { const int kb = (kt0 + (j)) * 64, qw0 = q0 + wid * 32; active = (kb <= qw0 + 31 + 64) && (kb + 63 >= qw0 - 64); } \
    if (active) { \
      qkt<DQK>(p0, p1, K_lds + (b) * SHM_K, qr, r32, hi); \
      if constexpr (BAND) bandmask(p0, p1, (kt0 + (j)) * 64, qi, hi, slope_raw); \
      partialSM(p0, p1, m_reg, mn, al, C, thr_raw); \
      if (__any(al < 1.f)) { if (hi == 0) al_l[r32] = al; asm volatile("s_waitcnt lgkmcnt(0)" ::: "memory"); \
        _Pragma("unroll") for (int d = 0; d < 4; ++d) _Pragma("unroll") for (int r = 0; r < 16; ++r) o[d][r] *= al_l[crow(r, hi)]; } \
      finishSM(p0, p1, al, l_reg, pa0, pa1, pa2, pa3); SBAR(); \
      pv_d0(o, vb0 + (b) * SHM_V, pa0, pa1, pa2, pa3); \
    } } while (0)
  constexpr bool TWO = (DQK == 128);
  SLOADX(vsA0, vsA1, ksA, 0); SWRITEX(vsA0, vsA1, ksA, 0);
  if constexpr (TWO) {
    if (1 < NT) SLOADX(vsB0, vsB1, ksB, 1);
    for (int j = 0; j < NT; j += 2) {
      __syncthreads();
      if (j + 2 < NT) SLOADX(vsA0, vsA1, ksA, j + 2);
      STEP(j, 0);
      if (j + 1 < NT) SWRITEX(vsB0, vsB1, ksB, 1);
      if (j + 1 >= NT) break;
      __syncthreads();
      if (j + 3 < NT) SLOADX(vsB0, vsB1, ksB, j + 3);
      STEP(j + 1, 1);
      if (j + 2 < NT) SWRITEX(vsA0, vsA1, ksA, 0);
    }
  } else {
    for (int j = 0; j < NT; ++j) {
      const int b = j & 1;
      __syncthreads();
      if (j + 1 < NT) SLOADX(vsA0, vsA1, ksA, j + 1);
      STEP(j, b);
      if (j + 1 < NT) SWRITEX(vsA0, vsA1, ksA, b ^ 1);
    }
  }
  if (hi == 0) li_l[r32] = l_reg; asm volatile("s_waitcnt lgkmcnt(0)" ::: "memory");
  if constexpr (BAND) { if (hi == 0) *(AGAS float*)(lse + (long)(wid * 32 + r32) * ld_lse) = m_reg * scale + __logf(l_reg); }
  float rli[16];
#pragma unroll
  for (int r = 0; r < 16; ++r) rli[r] = __builtin_amdgcn_rcpf(li_l[crow(r, hi)]);
  bf16_t* Ow = Ob + (long)(wid * 32) * ldo;
  if constexpr (true)
  {
    char* stg = lds + 2 * SHM_V + 2 * SHM_K + 2048 + wid * 4608;
#pragma unroll
    for (int h = 0; h < 2; ++h) {
#pragma unroll
      for (int r = 0; r < 16; ++r) { const int orow = crow(r, hi);
#pragma unroll
        for (int dd = 0; dd < 2; ++dd) { const float v = o[2 * h + dd][r] * rli[r]; *(bf16_t*)(stg + orow * 144 + (dd * 32 + r32) * 2) = (bf16_t)(cvtpk(v, v) & 0xffffu); } }
      asm volatile("s_waitcnt lgkmcnt(0)" ::: "memory");
#pragma unroll
      for (int i = 0; i < 4; ++i) { const int row = i * 8 + (lane >> 3), ch = lane & 7; const u32x4 v = *(const u32x4*)(stg + row * 144 + ch * 16);
        *(AGAS u32x4*)(Ow + (long)row * ldo + h * 64 + ch * 8) = v; }
      asm volatile("s_waitcnt lgkmcnt(0)" ::: "memory");
    } }
  else {
#pragma unroll
  for (int r = 0; r < 16; ++r) { const int orow = crow(r, hi);
#pragma unroll
    for (int d0 = 0; d0 < 4; ++d0) { const float v = o[d0][r] * rli[r]; *(AGAS bf16_t*)(Ow + (long)orow * ldo + d0 * 32 + r32) = (bf16_t)(cvtpk(v, v) & 0xffffu); } }
  }
  __syncthreads();
#undef SLOADX
#undef SWRITEX
#undef STEP
}
#undef SBAR
}

#define LAS __attribute__((address_space(3)))
#define GAS __attribute__((address_space(1)))
typedef unsigned short bf16_t;
typedef float f32x4 __attribute__((ext_vector_type(4)));
typedef unsigned u32x4 __attribute__((ext_vector_type(4)));
typedef unsigned u32x2 __attribute__((ext_vector_type(2)));

constexpr int DM = 2048, NB = 8, SEQ = 4096, M = NB * SEQ, DFF = 5632, WIN_N = 6976, ZP = 7168, DEPTH = 2;
constexpr int CQR = 512, CKVR = 256, CQW = 768, CKVW = 1024;
constexpr float EPS = 1e-6f;
constexpr int NWAVES = 8;
constexpr size_t MiB = 1u << 20;
constexpr size_t WS_ROPE_A = 0;
constexpr size_t WS_ROPE_C = 64 * 1024;
constexpr size_t WS_BAR = 1152 * 1024;
constexpr size_t WS_SS = 1216 * 1024;
constexpr size_t WS_WB = 2 * MiB;
constexpr size_t WB_GU1 = 0, WB_D1 = WB_GU1 + (size_t)2 * DFF * DM * 2, WB_IN = WB_D1 + (size_t)DM * DFF * 2, WB_OUT = WB_IN + (size_t)ZP * DM * 2,
                 WB_GU2 = WB_OUT + (size_t)DM * DM * 2, WB_D2 = WB_GU2 + (size_t)2 * DFF * DM * 2, WB_CQ = WB_D2 + (size_t)DM * DFF * 2, WB_CKV = WB_CQ + (size_t)CQW * CQR * 2,
                 WB_END = WB_CKV + (size_t)CKVW * CKVR * 2;
static_assert(WB_END <= 170 * MiB, "weights");
constexpr size_t WS_XN = 172 * MiB;
constexpr size_t WS_LSE = 300 * MiB;
constexpr size_t WS_CQA = 302 * MiB;
constexpr size_t WS_CKVA = 334 * MiB;
constexpr size_t WS_CQ = 350 * MiB;
constexpr size_t WS_CKV = 398 * MiB;
constexpr size_t WS_KC = 462 * MiB;
constexpr size_t WS_Z = 510 * MiB;
constexpr size_t WS_END = WS_Z + (size_t)M * ZP * 2;
static_assert(WS_END <= 1024 * MiB, "ws");
constexpr int LDS_BYTES = 147456;

__device__ __forceinline__ float wave_sum(float v) {
#pragma unroll
  for (int o = 1; o < 64; o <<= 1) v += __shfl_xor(v, o);
  return v;
}
__device__ __forceinline__ float bf2f(unsigned h) { return __uint_as_float(h << 16); }
__device__ __forceinline__ unsigned pk2(float lo, float hi) { return pg8::cvt_pk_bf16(lo, hi); }
__device__ __forceinline__ void unpack8(u32x4 w, float* x) {
  x[0] = __uint_as_float(w.x << 16); x[1] = __uint_as_float(w.x & 0xffff0000u); x[2] = __uint_as_float(w.y << 16); x[3] = __uint_as_float(w.y & 0xffff0000u);
  x[4] = __uint_as_float(w.z << 16); x[5] = __uint_as_float(w.z & 0xffff0000u); x[6] = __uint_as_float(w.w << 16); x[7] = __uint_as_float(w.w & 0xffff0000u);
}
__device__ __forceinline__ u32x4 pack8(const float* x) { u32x4 w; w.x = pk2(x[0], x[1]); w.y = pk2(x[2], x[3]); w.z = pk2(x[4], x[5]); w.w = pk2(x[6], x[7]); return w; }

__device__ __forceinline__ int dest_row(int n0, int mode) {
  if (mode == 0) return n0;
  return n0 < DFF ? 256 * (n0 / 128) + (n0 % 128) : 256 * ((n0 - DFF) / 128) + 128 + ((n0 - DFF) % 128);
}
__device__ __forceinline__ void transpose_item(const float* W, int K, int N, bf16_t* WT, int mode, const float* gain, LAS float* scr, int item, int lane) {
  const int nblk = N / 32, kb = item / nblk, nb = item % nblk, k0 = 64 * kb, n0 = 32 * nb;
  const int dr0 = dest_row(n0, mode);
#pragma unroll 16
  for (int i = 0; i < 32; ++i) { const int kk = 2 * i + (lane >> 5); scr[kk * 33 + (lane & 31)] = __builtin_nontemporal_load((const GAS float*)(W + (size_t)(k0 + kk) * N + n0 + (lane & 31))); }
  asm volatile("s_waitcnt lgkmcnt(0)" ::: "memory");
  const int c = lane & 7;
  f32x4 ga = (f32x4){1.f, 1.f, 1.f, 1.f}, gb = ga;
  if (gain) { ga = *(const GAS f32x4*)(gain + k0 + 8 * c); gb = *(const GAS f32x4*)(gain + k0 + 8 * c + 4); }
#pragma unroll
  for (int j = 0; j < 4; ++j) { const int n = (lane >> 3) + 8 * j; const LAS float* s = scr + (8 * c) * 33 + n;
    u32x4 o; o.x = pk2(s[0 * 33] * ga.x, s[1 * 33] * ga.y); o.y = pk2(s[2 * 33] * ga.z, s[3 * 33] * ga.w); o.z = pk2(s[4 * 33] * gb.x, s[5 * 33] * gb.y); o.w = pk2(s[6 * 33] * gb.z, s[7 * 33] * gb.w);
    *(GAS u32x4*)(WT + (size_t)(dr0 + n) * K + k0 + 8 * c) = o; }
  asm volatile("s_waitcnt lgkmcnt(0)" ::: "memory");
}

struct Args { const float* in[21]; float* out; unsigned char* ws; };
template <class T> __device__ __forceinline__ T* asglobal(T* p) { return (T*)(__attribute__((address_space(1))) T*)p; }
constexpr int LDS_PTAB = 131072;
struct PT {
  LAS const unsigned long long* t; float* out; unsigned char* ws;
  __device__ __forceinline__ const float* in(int k) const { const unsigned long long v = t[k];
    const unsigned lo = __builtin_amdgcn_readfirstlane((unsigned)v), hi = __builtin_amdgcn_readfirstlane((unsigned)(v >> 32));
    return asglobal((const float*)(((unsigned long long)hi << 32) | lo)); }
};

__device__ __forceinline__ void norm_rows(const float* X, const float* g, bf16_t* out, int gw, int NGW, int lane) {
  asm volatile("" : "+v"(lane));
  f32x4 gv[8];
#pragma unroll
  for (int j = 0; j < 8; ++j) gv[j] = ((const GAS f32x4*)g)[lane + 64 * j];
  for (int m = gw; m < M; m += NGW) {
    const GAS f32x4* xr = (const GAS f32x4*)(X + (size_t)m * DM) + lane;
    f32x4 v[8]; float s = 0.f;
#pragma unroll
    for (int j = 0; j < 8; ++j) { v[j] = xr[64 * j]; s += (v[j].x * v[j].x + v[j].y * v[j].y) + (v[j].z * v[j].z + v[j].w * v[j].w); }
    const float r = rsqrtf(wave_sum(s) * (1.f / DM) + EPS);
    GAS u32x2* o = (GAS u32x2*)(out + (size_t)m * DM) + lane;
#pragma unroll
    for (int j = 0; j < 8; ++j) { u32x2 w; w.x = pk2(v[j].x * r * gv[j].x, v[j].y * r * gv[j].y); w.y = pk2(v[j].z * r * gv[j].z, v[j].w * r * gv[j].w); o[64 * j] = w; }
  }
}

__device__ __forceinline__ void xb_init_rows(const float* X, bf16_t* xb, float* ss, int rb0, int lw, int nlw, int lane)     {
  asm volatile("" : "+v"(lane));
  for (int m = rb0 + lw; m < rb0 + SEQ; m += nlw) {
    const GAS f32x4* xr = (const GAS f32x4*)(X + (size_t)m * DM) + lane;
    f32x4 v[8]; float s = 0.f;
#pragma unroll
    for (int j = 0; j < 8; ++j) { v[j] = __builtin_nontemporal_load(xr + 64 * j); s += (v[j].x * v[j].x + v[j].y * v[j].y) + (v[j].z * v[j].z + v[j].w * v[j].w); }
    s = wave_sum(s);
    GAS u32x2* o = (GAS u32x2*)(xb + (size_t)m * DM) + lane;
#pragma unroll
    for (int j = 0; j < 8; ++j) { u32x2 w; w.x = pk2(v[j].x, v[j].y); w.y = pk2(v[j].z, v[j].w); o[64 * j] = w; }
    if (lane == 0) *(GAS unsigned long long*)((unsigned long long*)ss + m) = (unsigned long long)(s * pg8::SS_SCALE);
  }
}
__device__ __forceinline__ void zero_f32(float* p, int n, int gtid, int nthreads) { for (int i = gtid; i < n; i += nthreads) *(GAS float*)(p + i) = 0.f; }

__device__ __forceinline__ void convert_weights(const PT& a, int l, LAS unsigned char* lds, int gw, int NGW, int wave, int lane) {
  asm volatile("" : "+v"(lane));
  LAS float* scr = (LAS float*)(lds + wave * 16384);
  unsigned char* wb = a.ws + WS_WB;
  const int I_GU = (DM / 64) * (2 * DFF / 32), I_D = (DFF / 64) * (DM / 32), I_IN = (DM / 64) * (WIN_N / 32), I_OUT = (DM / 64) * (DM / 32),
            I_CQ = (CQR / 64) * (CQW / 32), I_CKV = (CKVR / 64) * (CKVW / 32);
  const int NIT = 2 * I_GU + 2 * I_D + I_IN + I_OUT + I_CQ + I_CKV;
  for (int it = gw; it < NIT; it += NGW) {
    int r = it;
    if (r < I_GU) { transpose_item(a.in(2) + (size_t)l * DM * 2 * DFF, DM, 2 * DFF, (bf16_t*)(wb + WB_GU1), 1, a.in(1) + l * DM, scr, r, lane); continue; } r -= I_GU;
    if (r < I_GU) { transpose_item(a.in(19) + (size_t)l * DM * 2 * DFF, DM, 2 * DFF, (bf16_t*)(wb + WB_GU2), 1, a.in(18) + l * DM, scr, r, lane); continue; } r -= I_GU;
    if (r < I_D) { transpose_item(a.in(3) + (size_t)l * DFF * DM, DFF, DM, (bf16_t*)(wb + WB_D1), 0, nullptr, scr, r, lane); continue; } r -= I_D;
    if (r < I_D) { transpose_item(a.in(20) + (size_t)l * DFF * DM, DFF, DM, (bf16_t*)(wb + WB_D2), 0, nullptr, scr, r, lane); continue; } r -= I_D;
    if (r < I_IN) { transpose_item(a.in(5) + (size_t)l * DM * WIN_N, DM, WIN_N, (bf16_t*)(wb + WB_IN), 0, a.in(4) + l * DM, scr, r, lane); continue; } r -= I_IN;
    if (r < I_OUT) { transpose_item(a.in(17) + (size_t)l * DM * DM, DM, DM, (bf16_t*)(wb + WB_OUT), 0, nullptr, scr, r, lane); continue; } r -= I_OUT;
    if (r < I_CQ) { transpose_item(a.in(11) + (size_t)l * CQR * CQW, CQR, CQW, (bf16_t*)(wb + WB_CQ), 0, nullptr, scr, r, lane); continue; } r -= I_CQ;
    transpose_item(a.in(13) + (size_t)l * CKVR * CKVW, CKVR, CKVW, (bf16_t*)(wb + WB_CKV), 0, nullptr, scr, r, lane);
  }
  GAS u32x4* pad = (GAS u32x4*)(wb + WB_IN + (size_t)WIN_N * DM * 2);
  for (int i = gw * 64 + lane; i < (ZP - WIN_N) * DM * 2 / 16; i += NGW * 64) pad[i] = (u32x4){0u, 0u, 0u, 0u};
}

__device__ __forceinline__ void rope_tables(unsigned char* ws, int gtid, int nthreads) {
  GAS float* ta = (GAS float*)(ws + WS_ROPE_A); GAS float* tc = (GAS float*)(ws + WS_ROPE_C);
  for (int i = gtid; i < SEQ * 32; i += nthreads) {
    const int pos = i >> 5, f = i & 31;
    const float inv = powf(10000.0f, -(float)f / 32.0f);
    const float ang = (float)pos * inv;
    const float c = cosf(ang), s = sinf(ang);
    tc[i] = c; tc[SEQ * 32 + i] = s;
    if (pos < 64) { ta[i] = c; ta[64 * 32 + i] = s; }
  }
}

__device__ __forceinline__ void ld8f(const float* p, float* g) { const f32x4 g0 = *(const GAS f32x4*)p, g1 = *(const GAS f32x4*)(p + 4);
  g[0] = g0.x; g[1] = g0.y; g[2] = g0.z; g[3] = g0.w; g[4] = g1.x; g[5] = g1.y; g[6] = g1.z; g[7] = g1.w; }
__device__ __forceinline__ void prep_rows(const PT& a, int l, int rb0, int lw, int nlw, int lane)     {
  asm volatile("" : "+v"(lane));
  bf16_t* Z = (bf16_t*)(a.ws + WS_Z); bf16_t* CQA = (bf16_t*)(a.ws + WS_CQA); bf16_t* CKVA = (bf16_t*)(a.ws + WS_CKVA);
  const float* ta = (const float*)(a.ws + WS_ROPE_A);
  const int j = lane & 15, hq = lane >> 4;
  float gaq[8], gak[8], gbq[8], gbk[8], gcq[8];
  ld8f(a.in(6) + l * 128 + 8 * j, gaq); ld8f(a.in(7) + l * 128 + 8 * j, gak); ld8f(a.in(8) + l * 128 + 8 * j, gbq); ld8f(a.in(9) + l * 128 + 8 * j, gbk);
  ld8f(a.in(10) + l * CQR + 8 * lane, gcq);
  const f32x4 gckv = *(const GAS f32x4*)(a.in(12) + l * CKVR + 4 * lane);
  constexpr int RR = 1;
  for (int m0 = rb0 + lw * RR; m0 < rb0 + SEQ; m0 += nlw * RR) {
    u32x4 raw[RR][9], rawq[RR]; u32x2 rawkv[RR]; f32x4 tcs[RR][4];
#pragma unroll
    for (int rr = 0; rr < RR; ++rr) { const int m = m0 + rr; const bf16_t* zr = Z + (size_t)m * ZP; const int t = m % SEQ, prow = t >> 6, pcol = t & 63;
#pragma unroll
      for (int it = 0; it < 9; ++it) { int hh = it * 4 + hq; hh = hh < 34 ? hh : 33; const int col = hh < 10 ? hh * 128 : 1536 + (hh - 10) * 128; raw[rr][it] = *(const GAS u32x4*)(zr + col + 8 * j); }
      rawq[rr] = *(const GAS u32x4*)(zr + 6144 + 8 * lane); rawkv[rr] = *(const GAS u32x2*)(zr + 6656 + 4 * lane);
      const int pos = (j < 8) ? prow : pcol; const int fi = 8 * (j & 3);
      tcs[rr][0] = *(const GAS f32x4*)(ta + pos * 32 + fi); tcs[rr][1] = *(const GAS f32x4*)(ta + pos * 32 + fi + 4);
      tcs[rr][2] = *(const GAS f32x4*)(ta + 2048 + pos * 32 + fi); tcs[rr][3] = *(const GAS f32x4*)(ta + 2048 + pos * 32 + fi + 4); }
#pragma unroll
    for (int rr = 0; rr < RR; ++rr) { const int m = m0 + rr; bf16_t* zr = Z + (size_t)m * ZP;
#pragma unroll
      for (int it = 0; it < 9; ++it) {
        const int hh = it * 4 + hq; const bool act = hh < 34; const bool isA = hh < 10; const int hb = hh - 10;
        const int col = isA ? hh * 128 : 1536 + hb * 128;
        float x[8]; unpack8(raw[rr][it], x);
        float ss = 0.f;
#pragma unroll
        for (int e = 0; e < 8; ++e) ss += x[e] * x[e];
        ss += __shfl_xor(ss, 1); ss += __shfl_xor(ss, 2); ss += __shfl_xor(ss, 4); ss += __shfl_xor(ss, 8);
        const float r = rsqrtf(ss * (1.f / 128.f) + EPS);
        float y[8];
#pragma unroll
        for (int e = 0; e < 8; ++e) { const float g = isA ? (hh < 8 ? gaq[e] : gak[e]) : (hb < 12 ? gbq[e] : gbk[e]); y[e] = x[e] * r * g; }
        if (it < 3) {
          float xp[8];
#pragma unroll
          for (int e = 0; e < 8; ++e) xp[e] = __shfl_xor(y[e], 4);
          if (isA) {
            const float cs[8] = {tcs[rr][0].x, tcs[rr][0].y, tcs[rr][0].z, tcs[rr][0].w, tcs[rr][1].x, tcs[rr][1].y, tcs[rr][1].z, tcs[rr][1].w};
            const float sn[8] = {tcs[rr][2].x, tcs[rr][2].y, tcs[rr][2].z, tcs[rr][2].w, tcs[rr][3].x, tcs[rr][3].y, tcs[rr][3].z, tcs[rr][3].w};
            const bool first = (j & 4) == 0;
#pragma unroll
            for (int e = 0; e < 8; ++e) y[e] = first ? (y[e] * cs[e] - xp[e] * sn[e]) : (xp[e] * sn[e] + y[e] * cs[e]);
          }
        }
        if (act) *(GAS u32x4*)(zr + col + 8 * j) = pack8(y);
      }
      { float x[8]; unpack8(rawq[rr], x); float ss = 0.f;
#pragma unroll
        for (int e = 0; e < 8; ++e) ss += x[e] * x[e];
        const float r = rsqrtf(wave_sum(ss) * (1.f / CQR) + EPS);
        float y[8];
#pragma unroll
        for (int e = 0; e < 8; ++e) y[e] = x[e] * r * gcq[e];
        *(GAS u32x4*)(CQA + (size_t)m * CQR + 8 * lane) = pack8(y); }
      { const u32x2 w = rawkv[rr];
        const float x0 = __uint_as_float(w.x << 16), x1 = __uint_as_float(w.x & 0xffff0000u), x2 = __uint_as_float(w.y << 16), x3 = __uint_as_float(w.y & 0xffff0000u);
        const float r = rsqrtf(wave_sum((x0 * x0 + x1 * x1) + (x2 * x2 + x3 * x3)) * (1.f / CKVR) + EPS);
        u32x2 o; o.x = pk2(x0 * r * gckv.x, x1 * r * gckv.y); o.y = pk2(x2 * r * gckv.z, x3 * r * gckv.w);
        *(GAS u32x2*)(CKVA + (size_t)m * CKVR + 4 * lane) = o; }
    }
  }
}

__device__ __forceinline__ void cpost_rows(const PT& a, int l, int rb0, int lw, int nlw, int lane)     {
  asm volatile("" : "+v"(lane));
  bf16_t* Z = (bf16_t*)(a.ws + WS_Z); bf16_t* CQ = (bf16_t*)(a.ws + WS_CQ); bf16_t* CKV = (bf16_t*)(a.ws + WS_CKV); bf16_t* KC = (bf16_t*)(a.ws + WS_KC);
  const float* tc = (const float*)(a.ws + WS_ROPE_C);
  const bool act = lane < 48; const int e0 = 4 * lane; const bool isrope = lane >= 32 && act, first = lane < 40;
  const int ri = 4 * ((lane - 32) & 7);
  const f32x4 z4 = {0.f, 0.f, 0.f, 0.f};
  const f32x4 gqv = act ? *(const GAS f32x4*)(a.in(14) + l * 192 + e0) : z4, gkv = act ? *(const GAS f32x4*)(a.in(15) + l * 192 + e0) : z4;
  constexpr int RR = 4;
  for (int m0 = rb0 + lw * RR; m0 < rb0 + SEQ; m0 += nlw * RR) {
    u32x2 rq[RR][4], rk[RR][4]; f32x4 csv[RR], snv[RR]; const u32x2 zz = {0u, 0u};
#pragma unroll
    for (int rr = 0; rr < RR; ++rr) { const int m = m0 + rr, t = m % SEQ;
      csv[rr] = *(const GAS f32x4*)(tc + t * 32 + ri); snv[rr] = *(const GAS f32x4*)(tc + SEQ * 32 + t * 32 + ri);
#pragma unroll
      for (int h = 0; h < 4; ++h) {
        rq[rr][h] = act ? *(const GAS u32x2*)(CQ + (size_t)m * CQW + h * 192 + e0) : zz;
        const bf16_t* ksrc = lane < 32 ? CKV + (size_t)m * CKVW + h * 256 + e0 : Z + (size_t)m * ZP + 6912 + (e0 - 128);
        rk[rr][h] = act ? *(const GAS u32x2*)ksrc : zz; } }
#pragma unroll
    for (int rr = 0; rr < RR; ++rr) { const int m = m0 + rr;
#pragma unroll
      for (int h = 0; h < 4; ++h) {
#pragma unroll
        for (int qk = 0; qk < 2; ++qk) {
          const u32x2 w = qk == 0 ? rq[rr][h] : rk[rr][h]; const f32x4 g = qk == 0 ? gqv : gkv;
          const f32x4 x = {__uint_as_float(w.x << 16), __uint_as_float(w.x & 0xffff0000u), __uint_as_float(w.y << 16), __uint_as_float(w.y & 0xffff0000u)};
          const float r = rsqrtf(wave_sum((x.x * x.x + x.y * x.y) + (x.z * x.z + x.w * x.w)) * (1.f / 192.f) + EPS);
          f32x4 y = x * r * g;
          f32x4 yp; yp.x = __shfl_xor(y.x, 8); yp.y = __shfl_xor(y.y, 8); yp.z = __shfl_xor(y.z, 8); yp.w = __shfl_xor(y.w, 8);
          if (isrope) y = first ? (y * csv[rr] - yp * snv[rr]) : (yp * snv[rr] + y * csv[rr]);
          u32x2 o; o.x = pk2(y.x, y.y); o.y = pk2(y.z, y.w);
          bf16_t* dst = qk == 0 ? CQ + (size_t)m * CQW + h * 192 + e0 : KC + (size_t)m * CQW + h * 192 + e0;
          if (act) *(GAS u32x2*)dst = o;
        }
      }
    }
  }
}

__device__ __forceinline__ void ynorm_rows(const PT& a, int l, bf16_t* Y, int rb0, int lw, int nlw, int lane)     {
  asm volatile("" : "+v"(lane));
  const bf16_t* Z = (const bf16_t*)(a.ws + WS_Z); const bf16_t* OC = (const bf16_t*)(a.ws + WS_CQA); const GAS float* LSE = (const GAS float*)(a.ws + WS_LSE);
  const float* gn = a.in(16) + l * DM;
  float gA0[8], gA1[8], gB[8], gC[8];
  ld8f(gn + 8 * lane, gA0); ld8f(gn + 512 + 8 * lane, gA1); ld8f(gn + 1024 + 8 * lane, gB); ld8f(gn + 1536 + 8 * lane, gC);
  const int jh = lane >> 4, d = (lane & 15) * 8;
  constexpr int RR = 2;
  for (int m0 = rb0 + lw * RR; m0 < rb0 + SEQ; m0 += nlw * RR) {
    u32x4 ra0[RR], ra1[RR], rb0[RR], rb1[RR], rb2[RR], rc[RR]; float l0[RR], l1[RR], l2[RR];
#pragma unroll
    for (int rr = 0; rr < RR; ++rr) { const int m = m0 + rr; const bf16_t* zr = Z + (size_t)m * ZP;
      ra0[rr] = *(const GAS u32x4*)(zr + 8 * lane); ra1[rr] = *(const GAS u32x4*)(zr + 512 + 8 * lane);
      rb0[rr] = *(const GAS u32x4*)(zr + 1536 + jh * 128 + d); rb1[rr] = *(const GAS u32x4*)(zr + 1536 + (4 + jh) * 128 + d); rb2[rr] = *(const GAS u32x4*)(zr + 1536 + (8 + jh) * 128 + d);
      rc[rr] = *(const GAS u32x4*)(OC + (size_t)m * 512 + jh * 128 + d);
      l0[rr] = LSE[(size_t)m * 12 + jh]; l1[rr] = LSE[(size_t)m * 12 + 4 + jh]; l2[rr] = LSE[(size_t)m * 12 + 8 + jh]; }
#pragma unroll
    for (int rr = 0; rr < RR; ++rr) { const int m = m0 + rr; bf16_t* yr = Y + (size_t)m * DM;
      { float x[16]; unpack8(ra0[rr], x); unpack8(ra1[rr], x + 8); float ss = 0.f;
#pragma unroll
        for (int e = 0; e < 16; ++e) ss += x[e] * x[e];
        const float r = rsqrtf(wave_sum(ss) * (1.f / 1024.f) + EPS);
        float y0[8], y1[8];
#pragma unroll
        for (int e = 0; e < 8; ++e) { y0[e] = x[e] * r * gA0[e]; y1[e] = x[8 + e] * r * gA1[e]; }
        *(GAS u32x4*)(yr + 8 * lane) = pack8(y0); *(GAS u32x4*)(yr + 512 + 8 * lane) = pack8(y1); }
      { const float mx = fmaxf(l0[rr], fmaxf(l1[rr], l2[rr])); const float e0 = __expf(l0[rr] - mx), e1 = __expf(l1[rr] - mx), e2 = __expf(l2[rr] - mx); const float inv = 1.f / (e0 + e1 + e2);
        float x0[8], x1[8], x2[8], ob[8]; unpack8(rb0[rr], x0); unpack8(rb1[rr], x1); unpack8(rb2[rr], x2);
        float ss = 0.f;
#pragma unroll
        for (int e = 0; e < 8; ++e) { ob[e] = (e0 * inv) * x0[e] + (e1 * inv) * x1[e] + (e2 * inv) * x2[e]; ss += ob[e] * ob[e]; }
        const float r = rsqrtf(wave_sum(ss) * (1.f / 512.f) + EPS);
        float y[8];
#pragma unroll
        for (int e = 0; e < 8; ++e) y[e] = ob[e] * r * gB[e];
        *(GAS u32x4*)(yr + 1024 + 8 * lane) = pack8(y); }
      { float x[8]; unpack8(rc[rr], x); float ss = 0.f;
#pragma unroll
        for (int e = 0; e < 8; ++e) ss += x[e] * x[e];
        const float r = rsqrtf(wave_sum(ss) * (1.f / 512.f) + EPS);
        float y[8];
#pragma unroll
        for (int e = 0; e < 8; ++e) y[e] = x[e] * r * gC[e];
        *(GAS u32x4*)(yr + 1536 + 8 * lane) = pack8(y); }
    }
  }
}

__device__ __forceinline__ void attention_phase(const PT& a, char* lds, int bid, int G) {
  bf16_t* Z = (bf16_t*)(a.ws + WS_Z); bf16_t* CQ = (bf16_t*)(a.ws + WS_CQ); const bf16_t* CKV = (const bf16_t*)(a.ws + WS_CKV); const bf16_t* KC = (const bf16_t*)(a.ws + WS_KC);
  float* LSE = (float*)(a.ws + WS_LSE);
  const int xcd = bid & 7, li = bid >> 3, nloc = G >> 3;
  const size_t rb = (size_t)xcd * SEQ;
#ifndef ATM
#define ATM 7
#endif
#ifndef REPA
#define REPA 0
#endif
#ifndef REPC
#define REPC 0
#endif
#ifndef REPB
#define REPB 0
#endif
  bf16_t* OC = (bf16_t*)(a.ws + WS_CQA);
  if constexpr (ATM & 1) for (int u = li; u < 128; u += nloc) { const int h = u >> 4, qb = u & 15, kvh = h >> 2;
    bf16_t* q = Z + (rb + (size_t)qb * 256) * ZP + h * 128;
    att::attn_unit<128, 2, false>(q, ZP, Z + rb * ZP + 1024 + kvh * 128, ZP, Z + rb * ZP + 1280 + kvh * 128, ZP, q, ZP, 0, SEQ / 64, 0.08838834764831845f, 0, 0.f, nullptr, 0, lds); }
  if constexpr (ATM & 2) for (int u = li; u < 64; u += nloc) { const int h = u >> 4, qb = u & 15;
    const bf16_t* q = CQ + (rb + (size_t)qb * 256) * CQW + h * 192;
    att::attn_unit_simple<192, false>(q, CQW, KC + rb * CQW + h * 192, CQW, CKV + rb * CKVW + h * 256 + 128, CKVW, OC + (rb + (size_t)qb * 256) * 512 + h * 128, 512, 0, SEQ / 64, 0.07216878364870323f, 0, 0.f, nullptr, 0, lds); }
  if constexpr (ATM & 4) for (int u = li; u < 192; u += nloc) { const int g = u >> 6, jh = (u >> 4) & 3, w = u & 15;
    const int dil = g == 0 ? 1 : (g == 1 ? 4 : 16), ups = 16 / dil, r = w / ups, qb = w % ups, L = SEQ / dil, hb = g * 4 + jh;
    const int q0 = qb * 256; int lo = q0 / 64 - 1; if (lo < 0) lo = 0; int hi = q0 / 64 + 5; if (hi > L / 64) hi = L / 64;
    if ((hi - lo) & 1) { if (lo > 0) --lo; else ++hi; }
    const float slope = exp2f(-8.0f * (float)(hb + 1) / 12.0f);
    const float slope_raw = slope * (float)dil * 11.313708498984761f;
    const long ld = (long)dil * ZP; const size_t base = (rb + r) * ZP;
    bf16_t* q = Z + base + (size_t)q0 * ld + 1536 + hb * 128;
    att::attn_unit_simple<128, true>(q, ld, Z + base + 3072 + hb * 128, ld, Z + base + 4608 + hb * 128, ld, q, ld, lo, hi - lo, 0.08838834764831845f, q0, slope_raw,
                                 LSE + (rb + r + (size_t)q0 * dil) * 12 + hb, (long)dil * 12, lds); }
}


#define XB_TMO      128
#define XB_XCNT(j)  (256  + 64 * (j))
#define XB_XSUB(j)  (1280 + 64 * (j))
#define XB_XGEN(j)  (2304 + 64 * (j))
#define XB_TOP      3328
#define XB_TOPGEN   3392
#define XB_LSUB(j)  (3456 + 64 * (j))
#define XB_LGEN(j)  (4480 + 64 * (j))
#define XCD_BAR_WORDS 5504
#define XB_SPIN_CAP (1u << 18)
__device__ __forceinline__ unsigned xb_ld(unsigned* p)              { return __hip_atomic_load(p, __ATOMIC_RELAXED, __HIP_MEMORY_SCOPE_AGENT); }
__device__ __forceinline__ unsigned xb_add(unsigned* p, unsigned v) { return __hip_atomic_fetch_add(p, v, __ATOMIC_RELAXED, __HIP_MEMORY_SCOPE_AGENT); }
__device__ __forceinline__ unsigned xb_xcc_id() { return (unsigned)__builtin_amdgcn_s_getreg((3 << 11) | 20) & 0xFu; }
#define XB_SPIN(cond, bar) do { unsigned _sp = 0; while (cond) { __builtin_amdgcn_s_sleep(1); \
    if ((++_sp & 255u) == 0u) { if (xb_ld(&(bar)[XB_TMO])) break; if (_sp > XB_SPIN_CAP) { atomicAdd(&(bar)[XB_TMO], 1u); break; } } } } while (0)
struct XcdBarrier { unsigned* bar; unsigned x; volatile LAS unsigned* st; };
__device__ __forceinline__ XcdBarrier xcd_barrier_post(unsigned* bar, volatile LAS unsigned* st) {
    XcdBarrier b; b.bar = bar; b.x = xb_xcc_id(); b.st = st;
    if (threadIdx.x == 0) st[4] = xb_add(&bar[XB_XCNT(b.x)], 1u);
    return b;
}
__device__ __forceinline__ void xcd_barrier_complete(unsigned* bar, unsigned x, unsigned& nloc, unsigned& nx, unsigned& even8) {
    const unsigned G = gridDim.x * gridDim.y * gridDim.z;
    unsigned sum, cnt, mine, sp = 0u;
    for (;;) {
        sum = 0u; cnt = 0u; mine = 0u;
#pragma unroll
        for (unsigned j = 0; j < 16; ++j) { const unsigned c = xb_ld(&bar[XB_XCNT(j)]); sum += c; cnt += (c > 0u) ? 1u : 0u; mine = (j == x) ? c : mine; }
        if (sum == G) break;
        __builtin_amdgcn_s_sleep(1);
        if ((++sp & 255u) == 0u) { if (xb_ld(&bar[XB_TMO])) break; if (sp > XB_SPIN_CAP) { atomicAdd(&bar[XB_TMO], 1u); break; } }
    }
    nloc = mine > 0u ? mine : 1u; nx = cnt > 0u ? cnt : 1u;
    unsigned eq = (cnt == 8u && sum == G) ? 1u : 0u;
#pragma unroll
    for (unsigned j = 0; j < 8; ++j) { if (xb_ld(&bar[XB_XCNT(j)]) * 8u != G) eq = 0u; }
    even8 = eq;
}
__device__ __forceinline__ void xcd_barrier(const XcdBarrier& b) {
    asm volatile("s_waitcnt vmcnt(0)" ::: "memory");
    __syncthreads();
    if (threadIdx.x == 0) {
        unsigned* bar = b.bar;
        __builtin_amdgcn_s_waitcnt(0);
        unsigned nloc = b.st[0], nx = b.st[1];
        if (nloc == 0u) { unsigned e8; xcd_barrier_complete(bar, b.x, nloc, nx, e8); b.st[0] = nloc; b.st[1] = nx; b.st[2] = e8; b.st[3] = e8 ? (b.x + 8u * b.st[4]) : blockIdx.x; }
        const unsigned old = xb_add(&bar[XB_XSUB(b.x)], 1u);
        const unsigned gen = old / nloc;
        if (old + 1u == (gen + 1u) * nloc) {
            __builtin_amdgcn_fence(__ATOMIC_RELEASE, "agent");
            asm volatile("s_waitcnt vmcnt(0)" ::: "memory");
            const unsigned og = xb_add(&bar[XB_TOP], 1u);
            const unsigned tg = og / nx;
            if (og + 1u == (tg + 1u) * nx) xb_add(&bar[XB_TOPGEN], 1u);
            else XB_SPIN(xb_ld(&bar[XB_TOPGEN]) == tg, bar);
            __builtin_amdgcn_fence(__ATOMIC_ACQUIRE, "agent");
            xb_add(&bar[XB_XGEN(b.x)], 1u);
            asm volatile("s_waitcnt vmcnt(0)" ::: "memory");
        } else {
            XB_SPIN(xb_ld(&bar[XB_XGEN(b.x)]) == gen, bar);
            __builtin_amdgcn_fence(__ATOMIC_ACQUIRE, "agent");
            asm volatile("s_waitcnt vmcnt(0)" ::: "memory");
        }
    }
    __syncthreads();
}

__device__ __forceinline__ void xcd_local_barrier(const XcdBarrier& b) {
    asm volatile("s_waitcnt vmcnt(0)" ::: "memory");
    __syncthreads();
    if (threadIdx.x == 0) {
        unsigned* bar = b.bar;
        __builtin_amdgcn_s_waitcnt(0);
        const unsigned nloc = b.st[0];
        const unsigned old = xb_add(&bar[XB_LSUB(b.x)], 1u);
        const unsigned gen = old / nloc;
        if (old + 1u == (gen + 1u) * nloc) xb_add(&bar[XB_LGEN(b.x)], 1u);
        else XB_SPIN(xb_ld(&bar[XB_LGEN(b.x)]) == gen, bar);
        __builtin_amdgcn_fence(__ATOMIC_ACQUIRE, "agent");
        asm volatile("s_waitcnt vmcnt(0)" ::: "memory");
    }
    __syncthreads();
}

#ifndef PHM
#define PHM 0xFFFF
#endif
#define PH(k) if constexpr ((PHM >> (k)) & 1)
#ifndef WGM_GU
#define WGM_GU 4
#endif
#ifndef WGM_IN
#define WGM_IN 4
#endif
#ifndef REPGU
#define REPGU 1
#endif
#ifndef REPIN
#define REPIN 1
#endif
#ifndef REPNC
#define REPNC 1
#endif
__global__ void __launch_bounds__(NWAVES * 64, 2) fwd_megakernel(Args ka) {
  extern __shared__ __attribute__((aligned(16))) unsigned char lds[];
  cg::grid_group grid = cg::this_grid();
  LAS unsigned char* ldsl = (LAS unsigned char*)lds;
  const int tid = threadIdx.x, lane = tid & 63, wave = __builtin_amdgcn_readfirstlane(tid >> 6);
  int G = gridDim.x, bid = blockIdx.x;
  int gw = bid * NWAVES + wave, NGW = G * NWAVES;
#define FRESH() do { asm volatile("" : "+s"(G), "+s"(bid), "+s"(gw), "+s"(NGW), "+s"(ws), "+s"(wb), "+s"(out), "+s"(XN), "+s"(Z), "+s"(H)); \
    ws = asglobal(ws); wb = asglobal(wb); out = asglobal(out); XN = asglobal(XN); Z = asglobal(Z); H = asglobal(H); } while (0)
  { LAS unsigned long long* pt = (LAS unsigned long long*)(ldsl + LDS_PTAB);
    if (tid == 0) {
#define PTS(k) pt[k] = (unsigned long long)ka.in[k]
      PTS(0); PTS(1); PTS(2); PTS(3); PTS(4); PTS(5); PTS(6); PTS(7); PTS(8); PTS(9); PTS(10); PTS(11); PTS(12); PTS(13); PTS(14); PTS(15); PTS(16); PTS(17); PTS(18); PTS(19); PTS(20);
#undef PTS
      pt[32] = 0ull; pt[33] = 0ull;
    } }
  if (blockIdx.x == 0) for (int i = tid; i < XCD_BAR_WORDS; i += NWAVES * 64) *(GAS unsigned*)((unsigned*)(ka.ws + WS_BAR) + i) = 0u;
  __syncthreads();
  unsigned char* ws = ka.ws; unsigned char* wb = ws + WS_WB;
  PT a; a.t = (LAS const unsigned long long*)(ldsl + LDS_PTAB); a.out = ka.out; a.ws = ka.ws;
  bf16_t* XN = (bf16_t*)(ws + WS_XN); bf16_t* Z = (bf16_t*)(ws + WS_Z); bf16_t* H = Z;
  float* out = a.out;
  PH(0) rope_tables(ws, bid * (NWAVES * 64) + tid, G * NWAVES * 64);
  XcdBarrier xbar; xbar.bar = (unsigned*)(ka.ws + WS_BAR); xbar.x = 0; xbar.st = (volatile LAS unsigned*)(ldsl + LDS_PTAB + 256);
#define GSYNC() do { xcd_barrier(xbar); FRESH(); a.ws = ws; a.out = out; } while (0)
#define LSYNC() do { if (xlocal) xcd_local_barrier(xbar); else xcd_barrier(xbar); FRESH(); a.ws = ws; a.out = out; } while (0)
  bool xlocal = false;
  float* SSa = (float*)(ws + WS_SS);
  PH(2) xb_init_rows(a.in(0), XN, SSa, (bid & 7) * SEQ, (bid >> 3) * NWAVES + wave, (G >> 3) * NWAVES, lane);
#pragma unroll 1
  for (int l = 0; l < DEPTH; ++l) {
    FRESH(); a.ws = ws; a.out = out;
    for (int rep_ = 0; rep_ < REPNC; ++rep_) { PH(1) convert_weights(a, l, ldsl, gw, NGW, wave, lane); }
    zero_f32((float*)(ws + WS_SS) + 2 * M, 4 * M, bid * (NWAVES * 64) + tid, G * NWAVES * 64);
    if (l == 0) { grid.sync(); xbar = xcd_barrier_post((unsigned*)(ka.ws + WS_BAR), (volatile LAS unsigned*)(ldsl + LDS_PTAB + 256)); xcd_barrier(xbar);
      bid = __builtin_amdgcn_readfirstlane((int)xbar.st[3]); gw = bid * NWAVES + wave; xlocal = false  ; FRESH(); a.ws = ws; a.out = out; }
    else GSYNC();
    for (int rep_ = 0; rep_ < REPGU; ++rep_) PH(3) { pg8::Gemm g{XN, (const bf16_t*)(wb + WB_GU1), M, 2 * DFF, DM, DM}; pg8::StaticOrder S; S.init(M, 2 * DFF, G, bid, WGM_GU); pg8::EpiSwiGLU E{H, DFF, (const float*)(ws + WS_SS)};
      pg8::gemm_phase(ldsl, g, S, E); }
    LSYNC();
    PH(4) { pg8::Gemm g{H, (const bf16_t*)(wb + WB_D1), M, DM, DFF, DFF}; pg8::StaticOrder S; S.init(M, DM, G, bid); pg8::EpiResid<1, WS_XN, WS_SS + (size_t)M * 8, false> E{out, ws};
      pg8::gemm_phase(ldsl, g, S, E); }
    LSYNC();
    for (int rep_ = 0; rep_ < REPIN; ++rep_) PH(5) { pg8::Gemm g{XN, (const bf16_t*)(wb + WB_IN), M, ZP, DM, DM}; pg8::StaticOrder S; S.init(M, ZP, G, bid, WGM_IN); pg8::EpiBf16 E{Z, ZP, (const float*)(ws + WS_SS + (size_t)M * 8)};
      pg8::gemm_phase(ldsl, g, S, E); }
    LSYNC();
    PH(6) prep_rows(a, l, (bid & 7) * SEQ, (bid >> 3) * NWAVES + wave, (G >> 3) * NWAVES, lane);
    { unsigned long long* ssa = (unsigned long long*)(ws + WS_SS) + (bid & 7) * SEQ;
      for (int i = (bid >> 3) * (NWAVES * 64) + tid; i < SEQ; i += (G >> 3) * (NWAVES * 64)) __hip_atomic_store(ssa + i, 0ull, __ATOMIC_RELAXED, __HIP_MEMORY_SCOPE_AGENT); }
    LSYNC();
    PH(5) { pg8::Gemm g{(const bf16_t*)(ws + WS_CQA), (const bf16_t*)(wb + WB_CQ), M, CQW, CQR, CQR}; pg8::StaticOrder S; S.init(M, CQW, G, bid); pg8::EpiBf16 E{(bf16_t*)(ws + WS_CQ), CQW, nullptr};
      pg8::gemm_phase(ldsl, g, S, E); }
    PH(5) { pg8::Gemm g{(const bf16_t*)(ws + WS_CKVA), (const bf16_t*)(wb + WB_CKV), M, CKVW, CKVR, CKVR}; pg8::StaticOrder S; S.init(M, CKVW, G, bid); pg8::EpiBf16 E{(bf16_t*)(ws + WS_CKV), CKVW, nullptr};
      pg8::gemm_phase(ldsl, g, S, E); }
    LSYNC();
    PH(7) cpost_rows(a, l, (bid & 7) * SEQ, (bid >> 3) * NWAVES + wave, (G >> 3) * NWAVES, lane);
    LSYNC();
    PH(8) attention_phase(a, (char*)lds, bid, G);
    LSYNC();
    PH(9) ynorm_rows(a, l, (bf16_t*)(ws + WS_CQ), (bid & 7) * SEQ, (bid >> 3) * NWAVES + wave, (G >> 3) * NWAVES, lane);
    LSYNC();
    PH(4) { pg8::Gemm g{(const bf16_t*)(ws + WS_CQ), (const bf16_t*)(wb + WB_OUT), M, DM, DM, DM}; pg8::StaticOrder S; S.init(M, DM, G, bid); pg8::EpiResid<2, WS_XN, WS_SS + (size_t)M * 16, false> E{out, ws};
      pg8::gemm_phase(ldsl, g, S, E); }
    LSYNC();
    for (int rep_ = 0; rep_ < REPGU; ++rep_) PH(3) { pg8::Gemm g{XN, (const bf16_t*)(wb + WB_GU2), M, 2 * DFF, DM, DM}; pg8::StaticOrder S; S.init(M, 2 * DFF, G, bid, WGM_GU); pg8::EpiSwiGLU E{H, DFF, (const float*)(ws + WS_SS + (size_t)M * 16)};
      pg8::gemm_phase(ldsl, g, S, E); }
    LSYNC();
    if (l + 1 < DEPTH) { pg8::Gemm g{H, (const bf16_t*)(wb + WB_D2), M, DM, DFF, DFF}; pg8::StaticOrder S; S.init(M, DM, G, bid); pg8::EpiResid<1, WS_XN, WS_SS, false> E{out, ws};
      pg8::gemm_phase(ldsl, g, S, E); }
    else { pg8::Gemm g{H, (const bf16_t*)(wb + WB_D2), M, DM, DFF, DFF}; pg8::StaticOrder S; S.init(M, DM, G, bid); pg8::EpiResid<1, WS_XN, WS_SS, true> E{out, ws};
      pg8::gemm_phase(ldsl, g, S, E); }
    if (l + 1 < DEPTH) GSYNC();
  }
}

extern "C" void kernel_launch(void* const* d_in, const int* in_sizes, int n_in, void* d_out, int out_size, void* d_ws, size_t ws_size, hipStream_t stream) {
  static int grid = 0;
  if (grid == 0) {
    if (n_in != 21 || in_sizes[0] != M * DM || out_size != M * DM || ws_size < WS_END) { fprintf(stderr, "kernel_launch: unexpected shapes (n_in %d, ws %zu)\n", n_in, ws_size); grid = -1; return; }
    int dev = 0, cus = 0, per_cu = 0;
    hipGetDevice(&dev); hipDeviceGetAttribute(&cus, hipDeviceAttributeMultiprocessorCount, dev);
    hipFuncSetAttribute((const void*)fwd_megakernel, hipFuncAttributeMaxDynamicSharedMemorySize, LDS_BYTES);
    hipOccupancyMaxActiveBlocksPerMultiprocessor(&per_cu, (const void*)fwd_megakernel, NWAVES * 64, LDS_BYTES);
    if (per_cu < 1) { fprintf(stderr, "kernel_launch: occupancy query says %d blocks per CU\n", per_cu); per_cu = 1; }
    (void)hipGetLastError();
    grid = cus * 1;
    grid -= grid % 8;
  }
  if (grid < 0) return;
  Args a{};
  for (int i = 0; i < 21; ++i) a.in[i] = (const float*)d_in[i];
  a.out = (float*)d_out; a.ws = (unsigned char*)d_ws;
  void* args[] = {&a};
  hipError_t e = hipLaunchCooperativeKernel((const void*)fwd_megakernel, dim3(grid), dim3(NWAVES * 64), args, LDS_BYTES, stream);
  if (e != hipSuccess) fprintf(stderr, "cooperative launch failed: %s (grid %d)\n", hipGetErrorString(e), grid);
}
```

```cpp
#include <hip/hip_runtime.h>
#include <hip/hip_bf16.h>
#include <hip/hip_cooperative_groups.h>
#include <cstdio>
#include <cstdint>
namespace cg = cooperative_groups;

namespace pg8 {
#define PG8_LAS __attribute__((address_space(3)))
#define PG8_GAS __attribute__((address_space(1)))
typedef unsigned short bf16_t;
typedef short bf16x8 __attribute__((ext_vector_type(8)));
typedef float f32x4 __attribute__((ext_vector_type(4)));
typedef unsigned u32x4 __attribute__((ext_vector_type(4)));
constexpr int BM = 256, BK = 64, HALF = 128, HTB = HALF * BK * 2  , STAGE_BYTES = 8 * HTB, NXCD = 8, WGM = 4;

__host__ __device__ __forceinline__ int lds_byte(int r, int c) { const int st = (r >> 4) * 2 + (c >> 5), rr = r & 15, cc = c & 31, ob = rr * 64 + cc * 2; return st * 1024 + (ob ^ (((ob >> 9) & 1) << 5)); }
__host__ __device__ __forceinline__ void stage_rc(int b, int& R, int& C) { const int st = b / 1024, sb = b % 1024, swz = sb ^ (((sb >> 9) & 1) << 5); R = (st >> 1) * 16 + swz / 64; C = (st & 1) * 32 + (swz % 64) / 2; }
__host__ __device__ __forceinline__ int perm32(int rho) { const int n = rho >> 4, i = rho & 15; return 8 * (i >> 2) + 4 * n + (i & 3); }

struct Unit { int pm, pn; };
struct Gemm { const bf16_t* A; const bf16_t* Bt; int M, N, K, lda; };

struct StaticOrder {
    int nM, nN, nwg, G, c, wgm;
    __host__ __device__ void init(int M, int N, int G_, int c_, int wgm_ = 4) { nM = M / BM; nN = N / BM; nwg = nM * nN; G = G_; c = c_; wgm = wgm_; }
    __host__ __device__ bool next(int i, Unit& u) const {
        const long L = (long)i * G + c; if (L >= nwg) return false;
        int wgid = (int)L; { const int q = nwg / NXCD, r = nwg % NXCD, xcd = wgid % NXCD, off = wgid / NXCD; wgid = (xcd < r ? xcd * (q + 1) : r * (q + 1) + (xcd - r) * q) + off; }
        const int nig = wgm * nN, gid = wgid / nig, fm = gid * wgm, gsz = (nM - fm) < wgm ? (nM - fm) : wgm;
        u.pm = fm + ((wgid % nig) % gsz); u.pn = (wgid % nig) / gsz; return true;
    }
};

__device__ __forceinline__ unsigned cvt_pk_bf16(float lo, float hi) { unsigned r; asm volatile("v_cvt_pk_bf16_f32 %0, %1, %2" : "=v"(r) : "v"(lo), "v"(hi)); return r; }

constexpr float SS_SCALE = 4194304.0f, SS_INV = 1.0f / 4194304.0f;
__device__ __forceinline__ float row_rstd(const float* ss, int row, float invn) { const unsigned long long v = *(const PG8_GAS unsigned long long*)((const unsigned long long*)ss + row); return __builtin_amdgcn_rsqf((float)v * SS_INV * invn + 1e-6f); }
constexpr int RSTD_TAB_OFF = 131072 + 1024;
struct EpiBf16 {
    static constexpr bool PERM = true;
    static constexpr bool RSTD_TAB = true;
    bf16_t* O; int ldc; const float* ss;
    __device__ __forceinline__ void operator()(const f32x4 (&acc)[2][2][4][2], const Unit& u, int wr, int wc, int fr, int fq, PG8_LAS unsigned char* lds) const {
        const int row0 = u.pm * BM + wr * 64 + fr; const int col0 = u.pn * BM + wc * 32 + 8 * fq;
        const PG8_LAS float* tab = (const PG8_LAS float*)(lds + RSTD_TAB_OFF) + wr * 64 + fr;
#pragma unroll
        for (int ai = 0; ai < 2; ++ai)
#pragma unroll
            for (int m = 0; m < 4; ++m) { const int row = row0 + ai * HALF + m * 16; bf16_t* rowp = O + (size_t)row * ldc + col0;
                const float r = ss ? tab[ai * HALF + m * 16] : 1.0f;
#pragma unroll
                for (int bj = 0; bj < 2; ++bj) { const f32x4 v0 = acc[ai][bj][m][0] * r, v1 = acc[ai][bj][m][1] * r;
                    u32x4 w; w.x = cvt_pk_bf16(v0[0], v0[1]); w.y = cvt_pk_bf16(v0[2], v0[3]); w.z = cvt_pk_bf16(v1[0], v1[1]); w.w = cvt_pk_bf16(v1[2], v1[3]);
                    *(PG8_GAS u32x4*)(rowp + bj * HALF) = w; } }
    }
};
__device__ __forceinline__ float silu_mul(float g, float u) { return g * u * __builtin_amdgcn_rcpf(1.0f + __builtin_amdgcn_exp2f(-1.4426950408889634f * g)); }
struct EpiSwiGLU {
    static constexpr bool PERM = true;
    static constexpr bool RSTD_TAB = true;
    bf16_t* H; int ldh; const float* ss;
    __device__ __forceinline__ void operator()(const f32x4 (&acc)[2][2][4][2], const Unit& u, int wr, int wc, int fr, int fq, PG8_LAS unsigned char* lds) const {
        const int row0 = u.pm * BM + wr * 64 + fr; const int col0 = u.pn * HALF + wc * 32 + 8 * fq;
        const PG8_LAS float* tab = (const PG8_LAS float*)(lds + RSTD_TAB_OFF) + wr * 64 + fr;
#pragma unroll
        for (int ai = 0; ai < 2; ++ai)
#pragma unroll
            for (int m = 0; m < 4; ++m) { const int row = row0 + ai * HALF + m * 16; bf16_t* rowp = H + (size_t)row * ldh + col0;
                const float r = tab[ai * HALF + m * 16];
                const f32x4 g0 = acc[ai][0][m][0] * r, g1 = acc[ai][0][m][1] * r, u0 = acc[ai][1][m][0] * r, u1 = acc[ai][1][m][1] * r;
                u32x4 w; w.x = cvt_pk_bf16(silu_mul(g0[0], u0[0]), silu_mul(g0[1], u0[1])); w.y = cvt_pk_bf16(silu_mul(g0[2], u0[2]), silu_mul(g0[3], u0[3]));
                w.z = cvt_pk_bf16(silu_mul(g1[0], u1[0]), silu_mul(g1[1], u1[1])); w.w = cvt_pk_bf16(silu_mul(g1[2], u1[2]), silu_mul(g1[3], u1[3]));
                *(PG8_GAS u32x4*)rowp = w; }
    }
};
template <int ALPHA2, size_t ROFF, size_t SSOFF, bool F32OUT>
struct EpiResid {
    static constexpr bool PERM = true;
    static constexpr int ldc = 2048; static constexpr float alpha = 0.5f * ALPHA2;
    static constexpr bool RSTD_TAB = false;
    float* out; unsigned char* ws;
    __device__ __forceinline__ void operator()(const f32x4 (&acc)[2][2][4][2], const Unit& u, int wr, int wc, int fr, int fq, PG8_LAS unsigned char*) const {
        const int row0 = u.pm * BM + wr * 64 + fr; const int col0 = u.pn * BM + wc * 32 + 8 * fq;
        bf16_t* R = (bf16_t*)(ws + ROFF); float* ssq = (float*)(ws + SSOFF);
#pragma unroll
        for (int ai = 0; ai < 2; ++ai) {
            u32x4 pre[4][2];
#pragma unroll
            for (int m = 0; m < 4; ++m) { const size_t off = (size_t)(row0 + ai * HALF + m * 16) * ldc + col0;
#pragma unroll
                for (int bj = 0; bj < 2; ++bj) pre[m][bj] = *(const PG8_GAS u32x4*)(R + off + bj * HALF); }
#pragma unroll
            for (int m = 0; m < 4; ++m) { const int row = row0 + ai * HALF + m * 16; const size_t off = (size_t)row * ldc + col0; float sq = 0.f;
#pragma unroll
                for (int bj = 0; bj < 2; ++bj) { const u32x4 b = pre[m][bj];
                    const f32x4 b0 = {__uint_as_float(b.x << 16), __uint_as_float(b.x & 0xffff0000u), __uint_as_float(b.y << 16), __uint_as_float(b.y & 0xffff0000u)};
                    const f32x4 b1 = {__uint_as_float(b.z << 16), __uint_as_float(b.z & 0xffff0000u), __uint_as_float(b.w << 16), __uint_as_float(b.w & 0xffff0000u)};
                    const f32x4 o0 = b0 + acc[ai][bj][m][0] * alpha, o1 = b1 + acc[ai][bj][m][1] * alpha;
                    if constexpr (F32OUT) { __builtin_nontemporal_store(o0, (PG8_GAS f32x4*)(out + off + bj * HALF)); __builtin_nontemporal_store(o1, (PG8_GAS f32x4*)(out + off + bj * HALF + 4)); }
                    u32x4 w; w.x = cvt_pk_bf16(o0[0], o0[1]); w.y = cvt_pk_bf16(o0[2], o0[3]); w.z = cvt_pk_bf16(o1[0], o1[1]); w.w = cvt_pk_bf16(o1[2], o1[3]);
                    if constexpr (!F32OUT) *(PG8_GAS u32x4*)(R + off + bj * HALF) = w;
                    sq += ((o0[0] * o0[0] + o0[1] * o0[1]) + (o0[2] * o0[2] + o0[3] * o0[3])) + ((o1[0] * o1[0] + o1[1] * o1[1]) + (o1[2] * o1[2] + o1[3] * o1[3])); }
                sq += __shfl_xor(sq, 16); sq += __shfl_xor(sq, 32);
                if constexpr (!F32OUT) { if (fq == 0) __hip_atomic_fetch_add((PG8_GAS unsigned long long*)((unsigned long long*)ssq + row), (unsigned long long)(sq * SS_SCALE), __ATOMIC_RELAXED, __HIP_MEMORY_SCOPE_AGENT); } }
        }
    }
};

template <class Epi, class Sched>
__device__ __forceinline__ void gemm_phase(PG8_LAS unsigned char* lds, const Gemm g, const Sched& S, const Epi& E) {
    int tid_ = threadIdx.x; asm volatile("" : "+v"(tid_));
    const int tid = tid_, wid = __builtin_amdgcn_readfirstlane(tid >> 6), lane = tid & 63, wr = wid >> 2, wc = wid & 3, fr = lane & 15, fq = lane >> 4;
    const int K = g.K, nt = K / BK, lda = g.lda;
    unsigned voffA[2], voffB[2];
#pragma unroll
    for (int i = 0; i < 2; ++i) { int R, C; stage_rc(tid * 16 + i * 8192, R, C); const int Rb = Epi::PERM ? ((R & ~31) + perm32(R & 31)) : R;
        voffA[i] = (unsigned)(R * lda + C) * 2u; voffB[i] = (unsigned)(Rb * K + C) * 2u; }
    const size_t kstep = (size_t)(BK * 2);
    const size_t hA = (size_t)HALF * lda * 2, hB = (size_t)HALF * K * 2;
    const size_t tA = 2 * hA, tB = 2 * hB;
    const unsigned ldsw = (unsigned)wid * 1024u;
    const int aoff = lds_byte(wr * 64 + fr, fq * 8), boff = lds_byte(wc * 32 + fr, fq * 8);
#define PG8_SA(b, h) (((b) * 2 + (h)) * HTB)
#define PG8_SB(b, h) ((4 + (b) * 2 + (h)) * HTB)
#define PG8_STAGE(bufoff, gbase, voff) do { _Pragma("unroll") for (int _i = 0; _i < 2; ++_i) \
        __builtin_amdgcn_global_load_lds((const unsigned*)((const char*)(gbase) + (voff)[_i]), (PG8_LAS unsigned*)(lds + (bufoff) + ldsw + _i * 8192), 16, 0, 0); } while (0)
#define PG8_LDA(dst, b, h) do { _Pragma("unroll") for (int m = 0; m < 4; ++m) _Pragma("unroll") for (int k = 0; k < 2; ++k) dst[m][k] = *(const PG8_LAS bf16x8*)(lds + PG8_SA(b, h) + aoff + m * 2048 + k * 1024); } while (0)
#define PG8_LDB(dst, b, h) do { _Pragma("unroll") for (int n = 0; n < 2; ++n) _Pragma("unroll") for (int k = 0; k < 2; ++k) dst[n][k] = *(const PG8_LAS bf16x8*)(lds + PG8_SB(b, h) + boff + n * 2048 + k * 1024); } while (0)
#define PG8_MMA(ai, bj, At, Bt) do { __builtin_amdgcn_s_setprio(1); _Pragma("unroll") for (int m = 0; m < 4; ++m) _Pragma("unroll") for (int n = 0; n < 2; ++n) _Pragma("unroll") for (int k = 0; k < 2; ++k) \
        acc[ai][bj][m][n] = __builtin_amdgcn_mfma_f32_16x16x32_bf16(Bt[n][k], At[m][k], acc[ai][bj][m][n], 0, 0, 0); __builtin_amdgcn_s_setprio(0); } while (0)
#define PG8_WAIT_V(n) asm volatile("s_waitcnt vmcnt(" #n ")" ::: "memory")
#define PG8_WAIT_L(n) asm volatile("s_waitcnt lgkmcnt(" #n ")" ::: "memory")
#define PG8_BAR __builtin_amdgcn_s_barrier()
#define PG8_SCHED __builtin_amdgcn_sched_barrier(0)
    Unit cur, nxt; int ui = 0;
    if (!S.next(0, cur)) return;
    int pmc = -1;
    f32x4 acc[2][2][4][2];
#pragma unroll
    for (int a = 0; a < 2; ++a)
#pragma unroll
        for (int b = 0; b < 2; ++b)
#pragma unroll
            for (int m = 0; m < 4; ++m)
#pragma unroll
                for (int n = 0; n < 2; ++n) acc[a][b][m][n] = (f32x4){0.f, 0.f, 0.f, 0.f};
    bf16x8 At[4][2], B0[2][2], B1[2][2];
    const char* cA = (const char*)g.A + (size_t)cur.pm * tA; const char* cB = (const char*)g.Bt + (size_t)cur.pn * tB;
    PG8_STAGE(PG8_SB(0, 0), cB, voffB); PG8_STAGE(PG8_SB(0, 1), cB + hB, voffB); PG8_STAGE(PG8_SA(0, 0), cA, voffA); PG8_STAGE(PG8_SA(0, 1), cA + hA, voffA);
    if (wr == 1) PG8_BAR;
    PG8_WAIT_V(2); PG8_BAR;
    PG8_STAGE(PG8_SB(1, 0), cB + kstep, voffB); PG8_STAGE(PG8_SA(1, 0), cA + kstep, voffA); PG8_STAGE(PG8_SB(1, 1), cB + hB + kstep, voffB);
    PG8_WAIT_V(6); PG8_BAR;
    for (;;) {
        const bool has_next = S.next(ui + 1, nxt);
        const char* nA = has_next ? (const char*)g.A + (size_t)nxt.pm * tA : cA; const char* nB = has_next ? (const char*)g.Bt + (size_t)nxt.pn * tB : cB;
        for (int t = 0; t < nt; t += 2) {
            const bool last = (t == nt - 2);
            const char* a1 = cA + (size_t)(t + 1) * kstep;
            const char* a2 = last ? nA : cA + (size_t)(t + 2) * kstep; const char* b2 = last ? nB : cB + (size_t)(t + 2) * kstep;
            const char* a3 = a2 + kstep; const char* b3 = b2 + kstep;
            PG8_LDB(B0, 0, 0); PG8_LDB(B1, 0, 1); PG8_SCHED; PG8_LDA(At, 0, 0); PG8_STAGE(PG8_SA(1, 1), a1 + hA, voffA);
            PG8_WAIT_V(8); PG8_WAIT_L(0); PG8_BAR; PG8_MMA(0, 0, At, B0); PG8_MMA(0, 1, At, B1); PG8_BAR; PG8_SCHED;
            PG8_LDA(At, 0, 1); PG8_STAGE(PG8_SB(0, 0), b2, voffB); PG8_STAGE(PG8_SB(0, 1), b2 + hB, voffB); PG8_STAGE(PG8_SA(0, 0), a2, voffA);
            PG8_WAIT_V(8); PG8_WAIT_L(0); PG8_BAR; PG8_MMA(1, 0, At, B0); PG8_MMA(1, 1, At, B1); PG8_BAR; PG8_SCHED;
            PG8_LDB(B0, 1, 0); PG8_LDB(B1, 1, 1); PG8_SCHED; PG8_LDA(At, 1, 0); PG8_STAGE(PG8_SA(0, 1), a2 + hA, voffA);
            PG8_WAIT_V(8); PG8_WAIT_L(0); PG8_BAR; PG8_MMA(0, 0, At, B0); PG8_MMA(0, 1, At, B1); PG8_BAR; PG8_SCHED;
            PG8_LDA(At, 1, 1); PG8_STAGE(PG8_SB(1, 0), b3, voffB); PG8_STAGE(PG8_SB(1, 1), b3 + hB, voffB); PG8_STAGE(PG8_SA(1, 0), a3, voffA);
            PG8_WAIT_V(8); PG8_WAIT_L(0); PG8_BAR; PG8_MMA(1, 0, At, B0); PG8_MMA(1, 1, At, B1); PG8_BAR; PG8_SCHED;
        }
        if (wr == 0) PG8_BAR;
        if constexpr (Epi::RSTD_TAB) {
            if (E.ss && pmc != cur.pm) { pmc = cur.pm;
                if (tid < BM) *(PG8_LAS float*)(lds + RSTD_TAB_OFF + tid * 4) = row_rstd(E.ss, cur.pm * BM + tid, 1.0f / 2048.0f);
                PG8_WAIT_L(0); PG8_BAR; } }
        E(acc, cur, wr, wc, fr, fq, lds);
        if (!has_next) break;
#pragma unroll
        for (int a = 0; a < 2; ++a)
#pragma unroll
            for (int b = 0; b < 2; ++b)
#pragma unroll
                for (int m = 0; m < 4; ++m)
#pragma unroll
                    for (int n = 0; n < 2; ++n) acc[a][b][m][n] = (f32x4){0.f, 0.f, 0.f, 0.f};
        cur = nxt; cA = nA; cB = nB; ++ui;
        if (wr == 1) PG8_BAR;
    }
    PG8_WAIT_V(0);
    PG8_BAR;
#undef PG8_SA
#undef PG8_SB
#undef PG8_STAGE
#undef PG8_LDA
#undef PG8_LDB
#undef PG8_MMA
#undef PG8_WAIT_V
#undef PG8_WAIT_L
#undef PG8_BAR
#undef PG8_SCHED
}
}

namespace att {
typedef unsigned short bf16_t;
using bf16x8 = __attribute__((ext_vector_type(8))) short;
using s16x4  = __attribute__((ext_vector_type(4))) short;
using f32x16 = __attribute__((ext_vector_type(16))) float;
using u32x4  = __attribute__((ext_vector_type(4))) unsigned;
#define SBAR() __builtin_amdgcn_sched_barrier(0)
#define AGAS __attribute__((address_space(1)))
__device__ __forceinline__ int crow(int r, int hi) { return (r & 3) + 8 * (r >> 2) + 4 * hi; }
__device__ __forceinline__ unsigned cvtpk(float lo, float hi) { unsigned r; asm volatile("v_cvt_pk_bf16_f32 %0, %1, %2" : "=v"(r) : "v"(lo), "v"(hi)); return r; }

__device__ __forceinline__ void partialSM(f32x16& p0, f32x16& p1, float& m_reg, float& mn, float& alpha, float C, float thr_raw) {
  float pmax = p0[0];
#pragma unroll
  for (int r = 1; r < 16; ++r) pmax = fmaxf(pmax, p0[r]);
#pragma unroll
  for (int r = 0; r < 16; ++r) pmax = fmaxf(pmax, p1[r]);
  { auto rr = __builtin_amdgcn_permlane32_swap(__float_as_uint(pmax), __float_as_uint(pmax), false, false);
    pmax = fmaxf(__uint_as_float(rr[0]), __uint_as_float(rr[1])); }
  if (__builtin_expect(__all(pmax - m_reg <= thr_raw), 1)) { mn = m_reg; alpha = 1.f; }
  else { mn = fmaxf(m_reg, pmax); alpha = __builtin_amdgcn_exp2f((m_reg - mn) * C); m_reg = mn; }
  float mnC = -mn * C;
#pragma unroll
  for (int r = 0; r < 16; ++r) p0[r] = fmaf(p0[r], C, mnC);
#pragma unroll
  for (int r = 0; r < 16; ++r) p1[r] = fmaf(p1[r], C, mnC);
#pragma unroll
  for (int r = 0; r < 16; ++r) p0[r] = __builtin_amdgcn_exp2f(p0[r]);
}
__device__ __forceinline__ void finishSM(f32x16& p0, f32x16& p1, float alpha, float& l_reg, bf16x8& pa0, bf16x8& pa1, bf16x8& pa2, bf16x8& pa3) {
#pragma unroll
  for (int r = 0; r < 16; ++r) p1[r] = __builtin_amdgcn_exp2f(p1[r]);
  float ps = 0;
#pragma unroll
  for (int r = 0; r < 16; ++r) ps += p0[r];
#pragma unroll
  for (int r = 0; r < 16; ++r) ps += p1[r];
  { auto rr = __builtin_amdgcn_permlane32_swap(__float_as_uint(ps), __float_as_uint(ps), false, false);
    ps = __uint_as_float(rr[0]) + __uint_as_float(rr[1]); }
  l_reg = l_reg * alpha + ps;
#define PK4(P, BASE, OUT) do { unsigned a0 = cvtpk(P[BASE + 0], P[BASE + 1]), a1 = cvtpk(P[BASE + 2], P[BASE + 3]);   \
    unsigned b0 = cvtpk(P[BASE + 4], P[BASE + 5]), b1 = cvtpk(P[BASE + 6], P[BASE + 7]);                              \
    auto r0 = __builtin_amdgcn_permlane32_swap(a0, b0, false, false); auto r1 = __builtin_amdgcn_permlane32_swap(a1, b1, false, false); \
    u32x4 w = {r0[0], r1[0], r0[1], r1[1]}; OUT = *reinterpret_cast<bf16x8*>(&w); } while (0)
  PK4(p0, 0, pa0); PK4(p0, 8, pa1); PK4(p1, 0, pa2); PK4(p1, 8, pa3);
#undef PK4
}
template <int DQK>
__device__ __forceinline__ void qkt(f32x16& p0, f32x16& p1, const char* Ks, const bf16x8* qr, int r32, int hi) {
  p0 = f32x16{}; p1 = f32x16{};
  constexpr int KST = DQK * 2, SWM = (DQK == 128) ? 15 : 7;
  const int sw = (r32 & SWM) << 4;
#pragma unroll
  for (int d0 = 0; d0 < DQK / 16; ++d0) { const int cb = (d0 * 16 + hi * 8) * 2;
    bf16x8 b0 = *reinterpret_cast<const bf16x8*>(Ks + r32 * KST + (cb ^ sw));
    bf16x8 b1 = *reinterpret_cast<const bf16x8*>(Ks + (32 + r32) * KST + (cb ^ sw));
    p0 = __builtin_amdgcn_mfma_f32_32x32x16_bf16(b0, qr[d0], p0, 0, 0, 0);
    p1 = __builtin_amdgcn_mfma_f32_32x32x16_bf16(b1, qr[d0], p1, 0, 0, 0); }
}
__device__ __forceinline__ int v_st(int k, int c) { const int kk = (k & ~0xC) | ((k & 4) << 1) | ((k & 8) >> 1); return ((kk >> 3) * 4 + (c >> 5)) * 512 + ((kk & 7) * 32 + (c & 31)) * 2; }
__device__ __forceinline__ int v_rd_base(int lane) { return ((lane & 3) << 3) | (((lane >> 2) & 3) << 6) | (((lane >> 4) & 1) << 5) | (((lane >> 5) & 1) << 8); }
constexpr int v_rd_off(int d0, int ks, int half) { return d0 * 512 + ks * 4096 + half * 2048; }
template <int OFF> __device__ __forceinline__ s16x4 tr_read(int vb) {
  s16x4 r; asm volatile("ds_read_b64_tr_b16 %0, %1 offset:%2" : "=&v"(r) : "v"(vb), "i"(OFF) : "memory"); return r;
}
template <int D0> __device__ __forceinline__ void pv_one(f32x16& od, int vb, bf16x8 pa0, bf16x8 pa1, bf16x8 pa2, bf16x8 pa3) {
  const s16x4 l0 = tr_read<v_rd_off(D0, 0, 0)>(vb), h0 = tr_read<v_rd_off(D0, 0, 1)>(vb), l1 = tr_read<v_rd_off(D0, 1, 0)>(vb), h1 = tr_read<v_rd_off(D0, 1, 1)>(vb);
  const s16x4 l2 = tr_read<v_rd_off(D0, 2, 0)>(vb), h2 = tr_read<v_rd_off(D0, 2, 1)>(vb), l3 = tr_read<v_rd_off(D0, 3, 0)>(vb), h3 = tr_read<v_rd_off(D0, 3, 1)>(vb);
  asm volatile("s_waitcnt lgkmcnt(0)" ::: "memory"); SBAR();
#define PK(L, H) (bf16x8){L[0], L[1], L[2], L[3], H[0], H[1], H[2], H[3]}
  od = __builtin_amdgcn_mfma_f32_32x32x16_bf16(pa0, PK(l0, h0), od, 0, 0, 0);
  od = __builtin_amdgcn_mfma_f32_32x32x16_bf16(pa1, PK(l1, h1), od, 0, 0, 0);
  od = __builtin_amdgcn_mfma_f32_32x32x16_bf16(pa2, PK(l2, h2), od, 0, 0, 0);
  od = __builtin_amdgcn_mfma_f32_32x32x16_bf16(pa3, PK(l3, h3), od, 0, 0, 0);
#undef PK
}
__device__ __forceinline__ void pv_d0(f32x16* o, int vb, bf16x8 pa0, bf16x8 pa1, bf16x8 pa2, bf16x8 pa3) {
  pv_one<0>(o[0], vb, pa0, pa1, pa2, pa3); pv_one<1>(o[1], vb, pa0, pa1, pa2, pa3); pv_one<2>(o[2], vb, pa0, pa1, pa2, pa3); pv_one<3>(o[3], vb, pa0, pa1, pa2, pa3);
}
constexpr float MASKV = -3.0e4f;
__device__ __forceinline__ void bandmask(f32x16& p0, f32x16& p1, int kb, int qi, int hi, float slope_raw) {
#pragma unroll
  for (int r = 0; r < 16; ++r) {
    int d0 = kb + crow(r, hi) - qi; d0 = d0 < 0 ? -d0 : d0; int d1 = kb + 32 + crow(r, hi) - qi; d1 = d1 < 0 ? -d1 : d1;
    p0[r] = d0 > 64 ? MASKV : fmaf(-slope_raw, (float)d0, p0[r]);
    p1[r] = d1 > 64 ? MASKV : fmaf(-slope_raw, (float)d1, p1[r]);
  }
}

template <int DQK, int SD, bool BAND>
__device__ __forceinline__ void attn_unit(const bf16_t* __restrict__ Qb, long ldq, const bf16_t* __restrict__ Kh, long ldk, const bf16_t* __restrict__ Vh, long ldv,
                                          bf16_t* Ob, long ldo, int kt0, int NT, float scale, int q0, float slope_raw, float* lse, long ld_lse, char* lds) {
  constexpr int ND = DQK / 16, NKC = DQK / 8, KPT = NKC / 8;
  constexpr int SHM_V = 64 * 128 * 2, SHM_K = 64 * DQK * 2;
  int tid_ = threadIdx.x; asm volatile("" : "+v"(tid_));
  const int tid = tid_, wid = tid >> 6, lane = tid & 63, r32 = lane & 31, hi = lane >> 5;
  char* V_lds = lds; char* K_lds = lds + 2 * SHM_V;
  float* ws = (float*)(lds + 2 * SHM_V + 2 * SHM_K) + wid * 64; float* li_l = ws; float* al_l = ws + 32;
  const float C = scale * 1.4426950408889634f, thr_raw = 8.f / scale;
  float m_reg = BAND ? MASKV : -1e30f, l_reg = 0; f32x16 o[4] = {}; bf16x8 qr[ND];
  const bf16_t* Qw = Qb + (long)(wid * 32 + r32) * ldq + hi * 8;
#pragma unroll
  for (int d0 = 0; d0 < ND; ++d0) qr[d0] = *(const AGAS bf16x8*)(Qw + d0 * 16);
  static_assert(DQK == 128, "pipelined body: DQK = 128");
  const int sr = tid >> 4, sc = (tid & 15) * 8, vst0 = v_st(sr, sc);
  const unsigned vgo0 = (unsigned)(sr * (int)ldv + sc) * 2u, kgo0 = (unsigned)(sr * (int)ldk + sc) * 2u;
  const int klo0 = sr * 256 + ((sc * 2) ^ ((sr & 15) << 4));
  const int vb0 = (int)(uintptr_t)V_lds + v_rd_base(lane);
  const int qi = q0 + wid * 32 + r32;
  bf16x8 vsA0, vsA1, ksA[KPT], vsB0, vsB1, ksB[KPT];
#define KLOADS(KS, k0) do { const char* kb_ = (const char*)Kh + (long)(k0) * ldk * 2; KS[0] = *(const AGAS bf16x8*)(kb_ + kgo0); KS[1] = *(const AGAS bf16x8*)(kb_ + 32 * ldk * 2 + kgo0); } while (0)
#define KWRITES(KS, b) do { *(bf16x8*)(K_lds + (b) * SHM_K + klo0) = KS[0]; *(bf16x8*)(K_lds + (b) * SHM_K + 8192 + klo0) = KS[1]; } while (0)
#define SLOAD_A(k0) do { const char* vb_ = (const char*)Vh + (long)(k0) * ldv * 2; vsA0 = *(const AGAS bf16x8*)(vb_ + vgo0); vsA1 = *(const AGAS bf16x8*)(vb_ + 32 * ldv * 2 + vgo0); KLOADS(ksA, k0); } while (0)
#define SLOAD_B(k0) do { const char* vb_ = (const char*)Vh + (long)(k0) * ldv * 2; vsB0 = *(const AGAS bf16x8*)(vb_ + vgo0); vsB1 = *(const AGAS bf16x8*)(vb_ + 32 * ldv * 2 + vgo0); KLOADS(ksB, k0); } while (0)
#define SWRITE_A(b) do { *(bf16x8*)(V_lds + (b) * SHM_V + vst0) = vsA0; *(bf16x8*)(V_lds + (b) * SHM_V + 8192 + vst0) = vsA1; KWRITES(ksA, b); } while (0)
#define SWRITE_B(b) do { *(bf16x8*)(V_lds + (b) * SHM_V + vst0) = vsB0; *(bf16x8*)(V_lds + (b) * SHM_V + 8192 + vst0) = vsB1; KWRITES(ksB, b); } while (0)
#define SLOAD_E(k0) SLOAD_A(k0)
#define SWRITE_E(b) SWRITE_A(b)
#define SLOAD_O(k0) do { if constexpr (SD == 2) { SLOAD_B(k0); } else { SLOAD_A(k0); } } while (0)
#define SWRITE_O(b) do { if constexpr (SD == 2) { SWRITE_B(b); } else { SWRITE_A(b); } } while (0)
#define SWAIT() do { if constexpr (SD == 2) { if constexpr (KPT == 2) asm volatile("s_waitcnt vmcnt(4)" ::: "memory"); else asm volatile("s_waitcnt vmcnt(5)" ::: "memory"); } else asm volatile("s_waitcnt vmcnt(0)" ::: "memory"); } while (0)
#define RESC(a) do { if (__any((a) < 1.f)) { if (hi == 0) al_l[r32] = (a); asm volatile("s_waitcnt lgkmcnt(0)" ::: "memory"); \
    _Pragma("unroll") for (int d = 0; d < 4; ++d) _Pragma("unroll") for (int r = 0; r < 16; ++r) o[d][r] *= al_l[crow(r, hi)]; } } while (0)
#define BMASK(P0, P1, t) do { if constexpr (BAND) bandmask(P0, P1, (kt0 + (t)) * 64, qi, hi, slope_raw); } while (0)
  f32x16 pA0, pA1, pB0, pB1; float mnA, mnB, alA, alB; bf16x8 pa0, pa1, pa2, pa3;
  const int kbase = kt0 * 64;
  SLOAD_E(kbase); asm volatile("s_waitcnt vmcnt(0)" ::: "memory"); SWRITE_E(0); __syncthreads();
  qkt<DQK>(pA0, pA1, K_lds, qr, r32, hi); BMASK(pA0, pA1, 0); partialSM(pA0, pA1, m_reg, mnA, alA, C, thr_raw);
  SLOAD_O(kbase + 64); if constexpr (SD == 2) { if (2 < NT) SLOAD_E(kbase + 128); }
  SWAIT(); SWRITE_O(1); __syncthreads();
  for (int j = 1; j + 1 < NT; j += 2) {
    SBAR(); qkt<DQK>(pB0, pB1, K_lds + SHM_K, qr, r32, hi); BMASK(pB0, pB1, j);
    finishSM(pA0, pA1, alA, l_reg, pa0, pa1, pa2, pa3); SBAR();
    SLOAD_O(kbase + (j + SD) * 64); SBAR();
    pv_d0(o, vb0, pa0, pa1, pa2, pa3); partialSM(pB0, pB1, m_reg, mnB, alB, C, thr_raw);
    __syncthreads(); SWAIT(); SWRITE_E(0);
    RESC(alB); __syncthreads();
    SBAR(); qkt<DQK>(pA0, pA1, K_lds, qr, r32, hi); BMASK(pA0, pA1, j + 1);
    finishSM(pB0, pB1, alB, l_reg, pa0, pa1, pa2, pa3); SBAR();
    if (SD == 1 || j + 3 < NT) SLOAD_E(kbase + (j + 1 + SD) * 64); SBAR();
    pv_d0(o, vb0 + SHM_V, pa0, pa1, pa2, pa3); partialSM(pA0, pA1, m_reg, mnA, alA, C, thr_raw);
    __syncthreads(); SWAIT(); SWRITE_O(1);
    RESC(alA); __syncthreads();
  }
  SBAR(); qkt<DQK>(pB0, pB1, K_lds + SHM_K, qr, r32, hi); BMASK(pB0, pB1, NT - 1);
  finishSM(pA0, pA1, alA, l_reg, pa0, pa1, pa2, pa3); SBAR();
  pv_d0(o, vb0, pa0, pa1, pa2, pa3); partialSM(pB0, pB1, m_reg, mnB, alB, C, thr_raw);
  __syncthreads(); RESC(alB);
  finishSM(pB0, pB1, alB, l_reg, pa0, pa1, pa2, pa3); SBAR();
  pv_d0(o, vb0 + SHM_V, pa0, pa1, pa2, pa3);
  if (hi == 0) li_l[r32] = l_reg; asm volatile("s_waitcnt lgkmcnt(0)" ::: "memory");
  if constexpr (BAND) { if (hi == 0) *(AGAS float*)(lse + (long)(wid * 32 + r32) * ld_lse) = m_reg * scale + __logf(l_reg); }
  float rli[16];
#pragma unroll
  for (int r = 0; r < 16; ++r) rli[r] = __builtin_amdgcn_rcpf(li_l[crow(r, hi)]);
  bf16_t* Ow = Ob + (long)(wid * 32) * ldo;
  {
    char* stg = lds + 2 * SHM_V + 2 * SHM_K + 2048 + wid * 4608;
#pragma unroll
    for (int h = 0; h < 2; ++h) {
#pragma unroll
      for (int r = 0; r < 16; ++r) { const int orow = crow(r, hi);
#pragma unroll
        for (int dd = 0; dd < 2; ++dd) { const float v = o[2 * h + dd][r] * rli[r]; *(bf16_t*)(stg + orow * 144 + (dd * 32 + r32) * 2) = (bf16_t)(cvtpk(v, v) & 0xffffu); } }
      asm volatile("s_waitcnt lgkmcnt(0)" ::: "memory");
#pragma unroll
      for (int i = 0; i < 4; ++i) { const int row = i * 8 + (lane >> 3), ch = lane & 7; const u32x4 v = *(const u32x4*)(stg + row * 144 + ch * 16);
        *(AGAS u32x4*)(Ow + (long)row * ldo + h * 64 + ch * 8) = v; }
      asm volatile("s_waitcnt lgkmcnt(0)" ::: "memory");
    } }
  __syncthreads();
#undef KLOADS
#undef KWRITES
#undef SLOAD_A
#undef SLOAD_B
#undef SWRITE_A
#undef SWRITE_B
#undef SLOAD_E
#undef SWRITE_E
#undef SLOAD_O
#undef SWRITE_O
#undef SWAIT
#undef RESC
#undef BMASK
}

template <int DQK, bool BAND>
__device__ __forceinline__ void attn_unit_simple(const bf16_t* __restrict__ Qb, long ldq, const bf16_t* __restrict__ Kh, long ldk, const bf16_t* __restrict__ Vh, long ldv,
                                                 bf16_t* Ob, long ldo, int kt0, int NT, float scale, int q0, float slope_raw, float* lse, long ld_lse, char* lds) {
  constexpr int ND = DQK / 16, NKC = DQK / 8, KPT = NKC / 8;
  constexpr int KST = DQK * 2, SWM = (DQK == 128) ? 15 : 7;
  constexpr int SHM_V = 64 * 128 * 2, SHM_K = 64 * KST;
  int tid_ = threadIdx.x; asm volatile("" : "+v"(tid_));
  const int tid = tid_, wid = tid >> 6, lane = tid & 63, r32 = lane & 31, hi = lane >> 5;
  char* V_lds = lds; char* K_lds = lds + 2 * SHM_V;
  float* ws = (float*)(lds + 2 * SHM_V + 2 * SHM_K) + wid * 64; float* li_l = ws; float* al_l = ws + 32;
  const float C = scale * 1.4426950408889634f, thr_raw = 8.f / scale;
  float m_reg = BAND ? MASKV : -1e30f, l_reg = 0; f32x16 o[4] = {}; bf16x8 qr[ND];
  const bf16_t* Qw = Qb + (long)(wid * 32 + r32) * ldq + hi * 8;
#pragma unroll
  for (int d0 = 0; d0 < ND; ++d0) qr[d0] = *(const AGAS bf16x8*)(Qw + d0 * 16);
  const int sr = tid >> 4, sc = (tid & 15) * 8, vst0 = v_st(sr, sc), vst1 = v_st(32 + sr, sc);
  const unsigned vgo0 = (unsigned)(sr * (int)ldv + sc) * 2u, vgo1 = vgo0 + (unsigned)(32 * (int)ldv) * 2u;
  unsigned kgo[KPT]; int klo[KPT];
#pragma unroll
  for (int i = 0; i < KPT; ++i) { const int c = tid + 512 * i, row = c / NKC, cc = c % NKC; kgo[i] = (unsigned)(row * (int)ldk + cc * 8) * 2u; klo[i] = row * KST + ((cc * 16) ^ ((row & SWM) << 4)); }
  const int vb0 = (int)(uintptr_t)V_lds + v_rd_base(lane);
  const int qi = q0 + wid * 32 + r32;
  bf16x8 vsA0, vsA1, ksA[KPT], vsB0, vsB1, ksB[KPT];
#define SLOADX(VS0, VS1, KS, t) do { const char* vb_ = (const char*)Vh + (long)(kt0 + (t)) * 64 * ldv * 2; const char* kb_ = (const char*)Kh + (long)(kt0 + (t)) * 64 * ldk * 2; \
    VS0 = *(const AGAS bf16x8*)(vb_ + vgo0); VS1 = *(const AGAS bf16x8*)(vb_ + vgo1); \
    _Pragma("unroll") for (int i_ = 0; i_ < KPT; ++i_) KS[i_] = *(const AGAS bf16x8*)(kb_ + kgo[i_]); } while (0)
#define SWRITEX(VS0, VS1, KS, b) do { *(bf16x8*)(V_lds + (b) * SHM_V + vst0) = VS0; *(bf16x8*)(V_lds + (b) * SHM_V + vst1) = VS1; \
    _Pragma("unroll") for (int i_ = 0; i_ < KPT; ++i_) *(bf16x8*)(K_lds + (b) * SHM_K + klo[i_]) = KS[i_]; } while (0)
  f32x16 p0, p1; float mn, al; bf16x8 pa0, pa1, pa2, pa3;
#define STEP(j, b) do { \
    bool active = true; \
    if constexpr (BAND) { const int kb = (kt0 + (j)) * 64, qw0 = q0 + wid * 32; active = (kb <= qw0 + 31 + 64) && (kb + 63 >= qw0 - 64); } \
    if (active) { \
      qkt<DQK>(p0, p1, K_lds + (b) * SHM_K, qr, r32, hi); \
      if constexpr (BAND) bandmask(p0, p1, (kt0 + (j)) * 64, qi, hi, slope_raw); \
      partialSM(p0, p1, m_reg, mn, al, C, thr_raw); \
      if (__any(al < 1.f)) { if (hi == 0) al_l[r32] = al; asm volatile("s_waitcnt lgkmcnt(0)" ::: "memory"); \
        _Pragma("unroll") for (int d = 0; d < 4; ++d) _Pragma("unroll") for (int r = 0; r < 16; ++r) o[d][r] *= al_l[crow(r, hi)]; } \
      finishSM(p0, p1, al, l_reg, pa0, pa1, pa2, pa3); SBAR(); \
      pv_d0(o, vb0 + (b) * SHM_V, pa0, pa1, pa2, pa3); \
    } } while (0)
  constexpr bool TWO = (DQK == 128);
  SLOADX(vsA0, vsA1, ksA, 0); SWRITEX(vsA0, vsA1, ksA, 0);
  if constexpr (TWO) {
    if (1 < NT) SLOADX(vsB0, vsB1, ksB, 1);
    for (int j = 0; j < NT; j += 2) {
      __syncthreads();
      if (j + 2 < NT) SLOADX(vsA0, vsA1, ksA, j + 2);
      STEP(j, 0);
      if (j + 1 < NT) SWRITEX(vsB0, vsB1, ksB, 1);
      if (j + 1 >= NT) break;
      __syncthreads();
      if (j + 3 < NT) SLOADX(vsB0, vsB1, ksB, j + 3);
      STEP(j + 1, 1);
      if (j + 2 < NT) SWRITEX(vsA0, vsA1, ksA, 0);
    }
  } else {
    for (int j = 0; j < NT; ++j) {
      const int b = j & 1;
      __syncthreads();
      if (j + 1 < NT) SLOADX(vsA0, vsA1, ksA, j + 1);
      STEP(j, b);
      if (j + 1 < NT) SWRITEX(vsA0, vsA1, ksA, b ^ 1);
    }
  }
  if (hi == 0) li_l[r32] = l_reg; asm volatile("s_waitcnt lgkmcnt(0)" ::: "memory");
  if constexpr (BAND) { if (hi == 0) *(AGAS float*)(lse + (long)(wid * 32 + r32) * ld_lse) = m_reg * scale + __logf(l_reg); }
  float rli[16];
#pragma unroll
  for (int r = 0; r < 16; ++r) rli[r] = __builtin_amdgcn_rcpf(li_l[crow(r, hi)]);
  bf16_t* Ow = Ob + (long)(wid * 32) * ldo;
  if constexpr (true)
  {
    char* stg = lds + 2 * SHM_V + 2 * SHM_K + 2048 + wid * 4608;
#pragma unroll
    for (int h = 0; h < 2; ++h) {
#pragma unroll
      for (int r = 0; r < 16; ++r) { const int orow = crow(r, hi);
#pragma unroll
        for (int dd = 0; dd < 2; ++dd) { const float v = o[2 * h + dd][r] * rli[r]; *(bf16_t*)(stg + orow * 144 + (dd * 32 + r32) * 2) = (bf16_t)(cvtpk(v, v) & 0xffffu); } }
      asm volatile("s_waitcnt lgkmcnt(0)" ::: "memory");
#pragma unroll
      for (int i = 0; i < 4; ++i) { const int row = i * 8 + (lane >> 3), ch = lane & 7; const u32x4 v = *(const u32x4*)(stg + row * 144 + ch * 16);
        *(AGAS u32x4*)(Ow + (long)row * ldo + h * 64 + ch * 8) = v; }
      asm volatile("s_waitcnt lgkmcnt(0)" ::: "memory");
    } }
  else {
#pragma unroll
  for (int r = 0; r < 16; ++r) { const int orow = crow(r, hi);
#pragma unroll
    for (int d0 = 0; d0 < 4; ++d0) { const float v = o[d0][r] * rli[r]; *(AGAS bf16_t*)(Ow + (long)orow * ldo + d0 * 32 + r32) = (bf16_t)(cvtpk(v, v) & 0xffffu); } }
  }
  __syncthreads();
#undef SLOADX
#undef SWRITEX
#undef STEP
}
#undef SBAR
}

#define LAS __attribute__((address_space(3)))
#define GAS __attribute__((address_space(1)))
typedef unsigned short bf16_t;
typedef float f32x4 __attribute__((ext_vector_type(4)));
typedef unsigned u32x4 __attribute__((ext_vector_type(4)));
typedef unsigned u32x2 __attribute__((ext_vector_type(2)));

constexpr int DM = 2048, NB = 8, SEQ = 4096, M = NB * SEQ, DFF = 5632, WIN_N = 6976, ZP = 7168, DEPTH = 2;
constexpr int CQR = 512, CKVR = 256, CQW = 768, CKVW = 1024;
constexpr float EPS = 1e-6f;
constexpr int NWAVES = 8;
constexpr size_t MiB = 1u << 20;
constexpr size_t WS_ROPE_A = 0;
constexpr size_t WS_ROPE_C = 64 * 1024;
constexpr size_t WS_BAR = 1152 * 1024;
constexpr size_t WS_SS = 1216 * 1024;
constexpr size_t WS_WB = 2 * MiB;
constexpr size_t WB_GU1 = 0, WB_D1 = WB_GU1 + (size_t)2 * DFF * DM * 2, WB_IN = WB_D1 + (size_t)DM * DFF * 2, WB_OUT = WB_IN + (size_t)ZP * DM * 2,
                 WB_GU2 = WB_OUT + (size_t)DM * DM * 2, WB_D2 = WB_GU2 + (size_t)2 * DFF * DM * 2, WB_CQ = WB_D2 + (size_t)DM * DFF * 2, WB_CKV = WB_CQ + (size_t)CQW * CQR * 2,
                 WB_END = WB_CKV + (size_t)CKVW * CKVR * 2;
static_assert(WB_END <= 170 * MiB, "weights");
constexpr size_t WS_XN = 172 * MiB;
constexpr size_t WS_LSE = 300 * MiB;
constexpr size_t WS_CQA = 302 * MiB;
constexpr size_t WS_CKVA = 334 * MiB;
constexpr size_t WS_CQ = 350 * MiB;
constexpr size_t WS_CKV = 398 * MiB;
constexpr size_t WS_KC = 462 * MiB;
constexpr size_t WS_Z = 510 * MiB;
constexpr size_t WS_END = WS_Z + (size_t)M * ZP * 2;
static_assert(WS_END <= 1024 * MiB, "ws");
constexpr int LDS_BYTES = 147456;

__device__ __forceinline__ float wave_sum(float v) {
#pragma unroll
  for (int o = 1; o < 64; o <<= 1) v += __shfl_xor(v, o);
  return v;
}
__device__ __forceinline__ float bf2f(unsigned h) { return __uint_as_float(h << 16); }
__device__ __forceinline__ unsigned pk2(float lo, float hi) { return pg8::cvt_pk_bf16(lo, hi); }
__device__ __forceinline__ void unpack8(u32x4 w, float* x) {
  x[0] = __uint_as_float(w.x << 16); x[1] = __uint_as_float(w.x & 0xffff0000u); x[2] = __uint_as_float(w.y << 16); x[3] = __uint_as_float(w.y & 0xffff0000u);
  x[4] = __uint_as_float(w.z << 16); x[5] = __uint_as_float(w.z & 0xffff0000u); x[6] = __uint_as_float(w.w << 16); x[7] = __uint_as_float(w.w & 0xffff0000u);
}
__device__ __forceinline__ u32x4 pack8(const float* x) { u32x4 w; w.x = pk2(x[0], x[1]); w.y = pk2(x[2], x[3]); w.z = pk2(x[4], x[5]); w.w = pk2(x[6], x[7]); return w; }

__device__ __forceinline__ int dest_row(int n0, int mode) {
  if (mode == 0) return n0;
  return n0 < DFF ? 256 * (n0 / 128) + (n0 % 128) : 256 * ((n0 - DFF) / 128) + 128 + ((n0 - DFF) % 128);
}
__device__ __forceinline__ void transpose_item(const float* W, int K, int N, bf16_t* WT, int mode, const float* gain, LAS float* scr, int item, int lane) {
  const int nblk = N / 32, kb = item / nblk, nb = item % nblk, k0 = 64 * kb, n0 = 32 * nb;
  const int dr0 = dest_row(n0, mode);
#pragma unroll 16
  for (int i = 0; i < 32; ++i) { const int kk = 2 * i + (lane >> 5); scr[kk * 33 + (lane & 31)] = __builtin_nontemporal_load((const GAS float*)(W + (size_t)(k0 + kk) * N + n0 + (lane & 31))); }
  asm volatile("s_waitcnt lgkmcnt(0)" ::: "memory");
  const int c = lane & 7;
  f32x4 ga = (f32x4){1.f, 1.f, 1.f, 1.f}, gb = ga;
  if (gain) { ga = *(const GAS f32x4*)(gain + k0 + 8 * c); gb = *(const GAS f32x4*)(gain + k0 + 8 * c + 4); }
#pragma unroll
  for (int j = 0; j < 4; ++j) { const int n = (lane >> 3) + 8 * j; const LAS float* s = scr + (8 * c) * 33 + n;
    u32x4 o; o.x = pk2(s[0 * 33] * ga.x, s[1 * 33] * ga.y); o.y = pk2(s[2 * 33] * ga.z, s[3 * 33] * ga.w); o.z = pk2(s[4 * 33] * gb.x, s[5 * 33] * gb.y); o.w = pk2(s[6 * 33] * gb.z, s[7 * 33] * gb.w);
    *(GAS u32x4*)(WT + (size_t)(dr0 + n) * K + k0 + 8 * c) = o; }
  asm volatile("s_waitcnt lgkmcnt(0)" ::: "memory");
}

struct Args { const float* in[21]; float* out; unsigned char* ws; };
template <class T> __device__ __forceinline__ T* asglobal(T* p) { return (T*)(__attribute__((address_space(1))) T*)p; }
constexpr int LDS_PTAB = 131072;
struct PT {
  LAS const unsigned long long* t; float* out; unsigned char* ws;
  __device__ __forceinline__ const float* in(int k) const { const unsigned long long v = t[k];
    const unsigned lo = __builtin_amdgcn_readfirstlane((unsigned)v), hi = __builtin_amdgcn_readfirstlane((unsigned)(v >> 32));
    return asglobal((const float*)(((unsigned long long)hi << 32) | lo)); }
};

__device__ __forceinline__ void norm_rows(const float* X, const float* g, bf16_t* out, int gw, int NGW, int lane) {
  asm volatile("" : "+v"(lane));
  f32x4 gv[8];
#pragma unroll
  for (int j = 0; j < 8; ++j) gv[j] = ((const GAS f32x4*)g)[lane + 64 * j];
  for (int m = gw; m < M; m += NGW) {
    const GAS f32x4* xr = (const GAS f32x4*)(X + (size_t)m * DM) + lane;
    f32x4 v[8]; float s = 0.f;
#pragma unroll
    for (int j = 0; j < 8; ++j) { v[j] = xr[64 * j]; s += (v[j].x * v[j].x + v[j].y * v[j].y) + (v[j].z * v[j].z + v[j].w * v[j].w); }
    const float r = rsqrtf(wave_sum(s) * (1.f / DM) + EPS);
    GAS u32x2* o = (GAS u32x2*)(out + (size_t)m * DM) + lane;
#pragma unroll
    for (int j = 0; j < 8; ++j) { u32x2 w; w.x = pk2(v[j].x * r * gv[j].x, v[j].y * r * gv[j].y); w.y = pk2(v[j].z * r * gv[j].z, v[j].w * r * gv[j].w); o[64 * j] = w; }
  }
}

__device__ __forceinline__ void xb_init_rows(const float* X, bf16_t* xb, float* ss, int rb0, int lw, int nlw, int lane)     {
  asm volatile("" : "+v"(lane));
  for (int m = rb0 + lw; m < rb0 + SEQ; m += nlw) {
    const GAS f32x4* xr = (const GAS f32x4*)(X + (size_t)m * DM) + lane;
    f32x4 v[8]; float s = 0.f;
#pragma unroll
    for (int j = 0; j < 8; ++j) { v[j] = __builtin_nontemporal_load(xr + 64 * j); s += (v[j].x * v[j].x + v[j].y * v[j].y) + (v[j].z * v[j].z + v[j].w * v[j].w); }
    s = wave_sum(s);
    GAS u32x2* o = (GAS u32x2*)(xb + (size_t)m * DM) + lane;
#pragma unroll
    for (int j = 0; j < 8; ++j) { u32x2 w; w.x = pk2(v[j].x, v[j].y); w.y = pk2(v[j].z, v[j].w); o[64 * j] = w; }
    if (lane == 0) *(GAS unsigned long long*)((unsigned long long*)ss + m) = (unsigned long long)(s * pg8::SS_SCALE);
  }
}
__device__ __forceinline__ void zero_f32(float* p, int n, int gtid, int nthreads) { for (int i = gtid; i < n; i += nthreads) *(GAS float*)(p + i) = 0.f; }

__device__ __forceinline__ void convert_weights(const PT& a, int l, LAS unsigned char* lds, int gw, int NGW, int wave, int lane) {
  asm volatile("" : "+v"(lane));
  LAS float* scr = (LAS float*)(lds + wave * 16384);
  unsigned char* wb = a.ws + WS_WB;
  const int I_GU = (DM / 64) * (2 * DFF / 32), I_D = (DFF / 64) * (DM / 32), I_IN = (DM / 64) * (WIN_N / 32), I_OUT = (DM / 64) * (DM / 32),
            I_CQ = (CQR / 64) * (CQW / 32), I_CKV = (CKVR / 64) * (CKVW / 32);
  const int NIT = 2 * I_GU + 2 * I_D + I_IN + I_OUT + I_CQ + I_CKV;
  for (int it = gw; it < NIT; it += NGW) {
    int r = it;
    if (r < I_GU) { transpose_item(a.in(2) + (size_t)l * DM * 2 * DFF, DM, 2 * DFF, (bf16_t*)(wb + WB_GU1), 1, a.in(1) + l * DM, scr, r, lane); continue; } r -= I_GU;
    if (r < I_GU) { transpose_item(a.in(19) + (size_t)l * DM * 2 * DFF, DM, 2 * DFF, (bf16_t*)(wb + WB_GU2), 1, a.in(18) + l * DM, scr, r, lane); continue; } r -= I_GU;
    if (r < I_D) { transpose_item(a.in(3) + (size_t)l * DFF * DM, DFF, DM, (bf16_t*)(wb + WB_D1), 0, nullptr, scr, r, lane); continue; } r -= I_D;
    if (r < I_D) { transpose_item(a.in(20) + (size_t)l * DFF * DM, DFF, DM, (bf16_t*)(wb + WB_D2), 0, nullptr, scr, r, lane); continue; } r -= I_D;
    if (r < I_IN) { transpose_item(a.in(5) + (size_t)l * DM * WIN_N, DM, WIN_N, (bf16_t*)(wb + WB_IN), 0, a.in(4) + l * DM, scr, r, lane); continue; } r -= I_IN;
    if (r < I_OUT) { transpose_item(a.in(17) + (size_t)l * DM * DM, DM, DM, (bf16_t*)(wb + WB_OUT), 0, nullptr, scr, r, lane); continue; } r -= I_OUT;
    if (r < I_CQ) { transpose_item(a.in(11) + (size_t)l * CQR * CQW, CQR, CQW, (bf16_t*)(wb + WB_CQ), 0, nullptr, scr, r, lane); continue; } r -= I_CQ;
    transpose_item(a.in(13) + (size_t)l * CKVR * CKVW, CKVR, CKVW, (bf16_t*)(wb + WB_CKV), 0, nullptr, scr, r, lane);
  }
  GAS u32x4* pad = (GAS u32x4*)(wb + WB_IN + (size_t)WIN_N * DM * 2);
  for (int i = gw * 64 + lane; i < (ZP - WIN_N) * DM * 2 / 16; i += NGW * 64) pad[i] = (u32x4){0u, 0u, 0u, 0u};
}

__device__ __forceinline__ void rope_tables(unsigned char* ws, int gtid, int nthreads) {
  GAS float* ta = (GAS float*)(ws + WS_ROPE_A); GAS float* tc = (GAS float*)(ws + WS_ROPE_C);
  for (int i = gtid; i < SEQ * 32; i += nthreads) {
    const int pos = i >> 5, f = i & 31;
    const float inv = powf(10000.0f, -(float)f / 32.0f);
    const float ang = (float)pos * inv;
    const float c = cosf(ang), s = sinf(ang);
    tc[i] = c; tc[SEQ * 32 + i] = s;
    if (pos < 64) { ta[i] = c; ta[64 * 32 + i] = s; }
  }
}

__device__ __forceinline__ void ld8f(const float* p, float* g) { const f32x4 g0 = *(const GAS f32x4*)p, g1 = *(const GAS f32x4*)(p + 4);
  g[0] = g0.x; g[1] = g0.y; g[2] = g0.z; g[3] = g0.w; g[4] = g1.x; g[5] = g1.y; g[6] = g1.z; g[7] = g1.w; }
__device__ __forceinline__ void prep_rows(const PT& a, int l, int rb0, int lw, int nlw, int lane)     {
  asm volatile("" : "+v"(lane));
  bf16_t* Z = (bf16_t*)(a.ws + WS_Z); bf16_t* CQA = (bf16_t*)(a.ws + WS_CQA); bf16_t* CKVA = (bf16_t*)(a.ws + WS_CKVA);
  const float* ta = (const float*)(a.ws + WS_ROPE_A);
  const int j = lane & 15, hq = lane >> 4;
  float gaq[8], gak[8], gbq[8], gbk[8], gcq[8];
  ld8f(a.in(6) + l * 128 + 8 * j, gaq); ld8f(a.in(7) + l * 128 + 8 * j, gak); ld8f(a.in(8) + l * 128 + 8 * j, gbq); ld8f(a.in(9) + l * 128 + 8 * j, gbk);
  ld8f(a.in(10) + l * CQR + 8 * lane, gcq);
  const f32x4 gckv = *(const GAS f32x4*)(a.in(12) + l * CKVR + 4 * lane);
  constexpr int RR = 1;
  for (int m0 = rb0 + lw * RR; m0 < rb0 + SEQ; m0 += nlw * RR) {
    u32x4 raw[RR][9], rawq[RR]; u32x2 rawkv[RR]; f32x4 tcs[RR][4];
#pragma unroll
    for (int rr = 0; rr < RR; ++rr) { const int m = m0 + rr; const bf16_t* zr = Z + (size_t)m * ZP; const int t = m % SEQ, prow = t >> 6, pcol = t & 63;
#pragma unroll
      for (int it = 0; it < 9; ++it) { int hh = it * 4 + hq; hh = hh < 34 ? hh : 33; const int col = hh < 10 ? hh * 128 : 1536 + (hh - 10) * 128; raw[rr][it] = *(const GAS u32x4*)(zr + col + 8 * j); }
      rawq[rr] = *(const GAS u32x4*)(zr + 6144 + 8 * lane); rawkv[rr] = *(const GAS u32x2*)(zr + 6656 + 4 * lane);
      const int pos = (j < 8) ? prow : pcol; const int fi = 8 * (j & 3);
      tcs[rr][0] = *(const GAS f32x4*)(ta + pos * 32 + fi); tcs[rr][1] = *(const GAS f32x4*)(ta + pos * 32 + fi + 4);
      tcs[rr][2] = *(const GAS f32x4*)(ta + 2048 + pos * 32 + fi); tcs[rr][3] = *(const GAS f32x4*)(ta + 2048 + pos * 32 + fi + 4); }
#pragma unroll
    for (int rr = 0; rr < RR; ++rr) { const int m = m0 + rr; bf16_t* zr = Z + (size_t)m * ZP;
#pragma unroll
      for (int it = 0; it < 9; ++it) {
        const int hh = it * 4 + hq; const bool act = hh < 34; const bool isA = hh < 10; const int hb = hh - 10;
        const int col = isA ? hh * 128 : 1536 + hb * 128;
        float x[8]; unpack8(raw[rr][it], x);
        float ss = 0.f;
#pragma unroll
        for (int e = 0; e < 8; ++e) ss += x[e] * x[e];
        ss += __shfl_xor(ss, 1); ss += __shfl_xor(ss, 2); ss += __shfl_xor(ss, 4); ss += __shfl_xor(ss, 8);
        const float r = rsqrtf(ss * (1.f / 128.f) + EPS);
        float y[8];
#pragma unroll
        for (int e = 0; e < 8; ++e) { const float g = isA ? (hh < 8 ? gaq[e] : gak[e]) : (hb < 12 ? gbq[e] : gbk[e]); y[e] = x[e] * r * g; }
        if (it < 3) {
          float xp[8];
#pragma unroll
          for (int e = 0; e < 8; ++e) xp[e] = __shfl_xor(y[e], 4);
          if (isA) {
            const float cs[8] = {tcs[rr][0].x, tcs[rr][0].y, tcs[rr][0].z, tcs[rr][0].w, tcs[rr][1].x, tcs[rr][1].y, tcs[rr][1].z, tcs[rr][1].w};
            const float sn[8] = {tcs[rr][2].x, tcs[rr][2].y, tcs[rr][2].z, tcs[rr][2].w, tcs[rr][3].x, tcs[rr][3].y, tcs[rr][3].z, tcs[rr][3].w};
            const bool first = (j & 4) == 0;
#pragma unroll
            for (int e = 0; e < 8; ++e) y[e] = first ? (y[e] * cs[e] - xp[e] * sn[e]) : (xp[e] * sn[e] + y[e] * cs[e]);
          }
        }
        if (act) *(GAS u32x4*)(zr + col + 8 * j) = pack8(y);
      }
      { float x[8]; unpack8(rawq[rr], x); float ss = 0.f;
#pragma unroll
        for (int e = 0; e < 8; ++e) ss += x[e] * x[e];
        const float r = rsqrtf(wave_sum(ss) * (1.f / CQR) + EPS);
        float y[8];
#pragma unroll
        for (int e = 0; e < 8; ++e) y[e] = x[e] * r * gcq[e];
        *(GAS u32x4*)(CQA + (size_t)m * CQR + 8 * lane) = pack8(y); }
      { const u32x2 w = rawkv[rr];
        const float x0 = __uint_as_float(w.x << 16), x1 = __uint_as_float(w.x & 0xffff0000u), x2 = __uint_as_float(w.y << 16), x3 = __uint_as_float(w.y & 0xffff0000u);
        const float r = rsqrtf(wave_sum((x0 * x0 + x1 * x1) + (x2 * x2 + x3 * x3)) * (1.f / CKVR) + EPS);
        u32x2 o; o.x = pk2(x0 * r * gckv.x, x1 * r * gckv.y); o.y = pk2(x2 * r * gckv.z, x3 * r * gckv.w);
        *(GAS u32x2*)(CKVA + (size_t)m * CKVR + 4 * lane) = o; }
    }
  }
}

__device__ __forceinline__ void cpost_rows(const PT& a, int l, int rb0, int lw, int nlw, int lane)     {
  asm volatile("" : "+v"(lane));
  bf16_t* Z = (bf16_t*)(a.ws + WS_Z); bf16_t* CQ = (bf16_t*)(a.ws + WS_CQ); bf16_t* CKV = (bf16_t*)(a.ws + WS_CKV); bf16_t* KC = (bf16_t*)(a.ws + WS_KC);
  const float* tc = (const float*)(a.ws + WS_ROPE_C);
  const bool act = lane < 48; const int e0 = 4 * lane; const bool isrope = lane >= 32 && act, first = lane < 40;
  const int ri = 4 * ((lane - 32) & 7);
  const f32x4 z4 = {0.f, 0.f, 0.f, 0.f};
  const f32x4 gqv = act ? *(const GAS f32x4*)(a.in(14) + l * 192 + e0) : z4, gkv = act ? *(const GAS f32x4*)(a.in(15) + l * 192 + e0) : z4;
  constexpr int RR = 4;
  for (int m0 = rb0 + lw * RR; m0 < rb0 + SEQ; m0 += nlw * RR) {
    u32x2 rq[RR][4], rk[RR][4]; f32x4 csv[RR], snv[RR]; const u32x2 zz = {0u, 0u};
#pragma unroll
    for (int rr = 0; rr < RR; ++rr) { const int m = m0 + rr, t = m % SEQ;
      csv[rr] = *(const GAS f32x4*)(tc + t * 32 + ri); snv[rr] = *(const GAS f32x4*)(tc + SEQ * 32 + t * 32 + ri);
#pragma unroll
      for (int h = 0; h < 4; ++h) {
        rq[rr][h] = act ? *(const GAS u32x2*)(CQ + (size_t)m * CQW + h * 192 + e0) : zz;
        const bf16_t* ksrc = lane < 32 ? CKV + (size_t)m * CKVW + h * 256 + e0 : Z + (size_t)m * ZP + 6912 + (e0 - 128);
        rk[rr][h] = act ? *(const GAS u32x2*)ksrc : zz; } }
#pragma unroll
    for (int rr = 0; rr < RR; ++rr) { const int m = m0 + rr;
#pragma unroll
      for (int h = 0; h < 4; ++h) {
#pragma unroll
        for (int qk = 0; qk < 2; ++qk) {
          const u32x2 w = qk == 0 ? rq[rr][h] : rk[rr][h]; const f32x4 g = qk == 0 ? gqv : gkv;
          const f32x4 x = {__uint_as_float(w.x << 16), __uint_as_float(w.x & 0xffff0000u), __uint_as_float(w.y << 16), __uint_as_float(w.y & 0xffff0000u)};
          const float r = rsqrtf(wave_sum((x.x * x.x + x.y * x.y) + (x.z * x.z + x.w * x.w)) * (1.f / 192.f) + EPS);
          f32x4 y = x * r * g;
          f32x4 yp; yp.x = __shfl_xor(y.x, 8); yp.y = __shfl_xor(y.y, 8); yp.z = __shfl_xor(y.z, 8); yp.w = __shfl_xor(y.w, 8);
          if (isrope) y = first ? (y * csv[rr] - yp * snv[rr]) : (yp * snv[rr] + y * csv[rr]);
          u32x2 o; o.x = pk2(y.x, y.y); o.y = pk2(y.z, y.w);
          bf16_t* dst = qk == 0 ? CQ + (size_t)m * CQW + h * 192 + e0 : KC + (size_t)m * CQW + h * 192 + e0;
          if (act) *(GAS u32x2*)dst = o;
        }
      }
    }
  }
}

__device__ __forceinline__ void ynorm_rows(const PT& a, int l, bf16_t* Y, int rb0, int lw, int nlw, int lane)     {
  asm volatile("" : "+v"(lane));
  const bf16_t* Z = (const bf16_t*)(a.ws + WS_Z); const bf16_t* OC = (const bf16_t*)(a.ws + WS_CQA); const GAS float* LSE = (const GAS float*)(a.ws + WS_LSE);
  const float* gn = a.in(16) + l * DM;
  float gA0[8], gA1[8], gB[8], gC[8];
  ld8f(gn + 8 * lane, gA0); ld8f(gn + 512 + 8 * lane, gA1); ld8f(gn + 1024 + 8 * lane, gB); ld8f(gn + 1536 + 8 * lane, gC);
  const int jh = lane >> 4, d = (lane & 15) * 8;
  constexpr int RR = 2;
  for (int m0 = rb0 + lw * RR; m0 < rb0 + SEQ; m0 += nlw * RR) {
    u32x4 ra0[RR], ra1[RR], rb0[RR], rb1[RR], rb2[RR], rc[RR]; float l0[RR], l1[RR], l2[RR];
#pragma unroll
    for (int rr = 0; rr < RR; ++rr) { const int m = m0 + rr; const bf16_t* zr = Z + (size_t)m * ZP;
      ra0[rr] = __builtin_nontemporal_load((const GAS u32x4*)(zr + 8 * lane)); ra1[rr] = __builtin_nontemporal_load((const GAS u32x4*)(zr + 512 + 8 * lane));
      rb0[rr] = __builtin_nontemporal_load((const GAS u32x4*)(zr + 1536 + jh * 128 + d)); rb1[rr] = __builtin_nontemporal_load((const GAS u32x4*)(zr + 1536 + (4 + jh) * 128 + d)); rb2[rr] = __builtin_nontemporal_load((const GAS u32x4*)(zr + 1536 + (8 + jh) * 128 + d));
      rc[rr] = __builtin_nontemporal_load((const GAS u32x4*)(OC + (size_t)m * 512 + jh * 128 + d));
      l0[rr] = LSE[(size_t)m * 12 + jh]; l1[rr] = LSE[(size_t)m * 12 + 4 + jh]; l2[rr] = LSE[(size_t)m * 12 + 8 + jh]; }
#pragma unroll
    for (int rr = 0; rr < RR; ++rr) { const int m = m0 + rr; bf16_t* yr = Y + (size_t)m * DM;
      { float x[16]; unpack8(ra0[rr], x); unpack8(ra1[rr], x + 8); float ss = 0.f;
#pragma unroll
        for (int e = 0; e < 16; ++e) ss += x[e] * x[e];
        const float r = rsqrtf(wave_sum(ss) * (1.f / 1024.f) + EPS);
        float y0[8], y1[8];
#pragma unroll
        for (int e = 0; e < 8; ++e) { y0[e] = x[e] * r * gA0[e]; y1[e] = x[8 + e] * r * gA1[e]; }
        *(GAS u32x4*)(yr + 8 * lane) = pack8(y0); *(GAS u32x4*)(yr + 512 + 8 * lane) = pack8(y1); }
      { const float mx = fmaxf(l0[rr], fmaxf(l1[rr], l2[rr])); const float e0 = __expf(l0[rr] - mx), e1 = __expf(l1[rr] - mx), e2 = __expf(l2[rr] - mx); const float inv = 1.f / (e0 + e1 + e2);
        float x0[8], x1[8], x2[8], ob[8]; unpack8(rb0[rr], x0); unpack8(rb1[rr], x1); unpack8(rb2[rr], x2);
        float ss = 0.f;
#pragma unroll
        for (int e = 0; e < 8; ++e) { ob[e] = (e0 * inv) * x0[e] + (e1 * inv) * x1[e] + (e2 * inv) * x2[e]; ss += ob[e] * ob[e]; }
        const float r = rsqrtf(wave_sum(ss) * (1.f / 512.f) + EPS);
        float y[8];
#pragma unroll
        for (int e = 0; e < 8; ++e) y[e] = ob[e] * r * gB[e];
        *(GAS u32x4*)(yr + 1024 + 8 * lane) = pack8(y); }
      { float x[8]; unpack8(rc[rr], x); float ss = 0.f;
#pragma unroll
        for (int e = 0; e < 8; ++e) ss += x[e] * x[e];
        const float r = rsqrtf(wave_sum(ss) * (1.f / 512.f) + EPS);
        float y[8];
#pragma unroll
        for (int e = 0; e < 8; ++e) y[e] = x[e] * r * gC[e];
        *(GAS u32x4*)(yr + 1536 + 8 * lane) = pack8(y); }
    }
  }
}

__device__ __forceinline__ void attention_phase(const PT& a, char* lds, int bid, int G) {
  bf16_t* Z = (bf16_t*)(a.ws + WS_Z); bf16_t* CQ = (bf16_t*)(a.ws + WS_CQ); const bf16_t* CKV = (const bf16_t*)(a.ws + WS_CKV); const bf16_t* KC = (const bf16_t*)(a.ws + WS_KC);
  float* LSE = (float*)(a.ws + WS_LSE);
  const int xcd = bid & 7, li = bid >> 3, nloc = G >> 3;
  const size_t rb = (size_t)xcd * SEQ;
#ifndef ATM
#define ATM 7
#endif
#ifndef REPA
#define REPA 0
#endif
#ifndef REPC
#define REPC 0
#endif
#ifndef REPB
#define REPB 0
#endif
  bf16_t* OC = (bf16_t*)(a.ws + WS_CQA);
  if constexpr (ATM & 1) for (int u = li; u < 128; u += nloc) { const int h = u >> 4, qb = u & 15, kvh = h >> 2;
    bf16_t* q = Z + (rb + (size_t)qb * 256) * ZP + h * 128;
    att::attn_unit<128, 2, false>(q, ZP, Z + rb * ZP + 1024 + kvh * 128, ZP, Z + rb * ZP + 1280 + kvh * 128, ZP, q, ZP, 0, SEQ / 64, 0.08838834764831845f, 0, 0.f, nullptr, 0, lds); }
  if constexpr (ATM & 2) for (int u = li; u < 64; u += nloc) { const int h = u >> 4, qb = u & 15;
    const bf16_t* q = CQ + (rb + (size_t)qb * 256) * CQW + h * 192;
    att::attn_unit_simple<192, false>(q, CQW, KC + rb * CQW + h * 192, CQW, CKV + rb * CKVW + h * 256 + 128, CKVW, OC + (rb + (size_t)qb * 256) * 512 + h * 128, 512, 0, SEQ / 64, 0.07216878364870323f, 0, 0.f, nullptr, 0, lds); }
  if constexpr (ATM & 4) for (int u = li; u < 192; u += nloc) { const int g = u >> 6, jh = (u >> 4) & 3, w = u & 15;
    const int dil = g == 0 ? 1 : (g == 1 ? 4 : 16), ups = 16 / dil, r = w / ups, qb = w % ups, L = SEQ / dil, hb = g * 4 + jh;
    const int q0 = qb * 256; int lo = q0 / 64 - 1; if (lo < 0) lo = 0; int hi = q0 / 64 + 5; if (hi > L / 64) hi = L / 64;
    if ((hi - lo) & 1) { if (lo > 0) --lo; else ++hi; }
    const float slope = exp2f(-8.0f * (float)(hb + 1) / 12.0f);
    const float slope_raw = slope * (float)dil * 11.313708498984761f;
    const long ld = (long)dil * ZP; const size_t base = (rb + r) * ZP;
    bf16_t* q = Z + base + (size_t)q0 * ld + 1536 + hb * 128;
    att::attn_unit_simple<128, true>(q, ld, Z + base + 3072 + hb * 128, ld, Z + base + 4608 + hb * 128, ld, q, ld, lo, hi - lo, 0.08838834764831845f, q0, slope_raw,
                                 LSE + (rb + r + (size_t)q0 * dil) * 12 + hb, (long)dil * 12, lds); }
}


#define XB_TMO      128
#define XB_XCNT(j)  (256  + 64 * (j))
#define XB_XSUB(j)  (1280 + 64 * (j))
#define XB_XGEN(j)  (2304 + 64 * (j))
#define XB_TOP      3328
#define XB_TOPGEN   3392
#define XB_LSUB(j)  (3456 + 64 * (j))
#define XB_LGEN(j)  (4480 + 64 * (j))
#define XCD_BAR_WORDS 5504
#define XB_SPIN_CAP (1u << 18)
__device__ __forceinline__ unsigned xb_ld(unsigned* p)              { return __hip_atomic_load(p, __ATOMIC_RELAXED, __HIP_MEMORY_SCOPE_AGENT); }
__device__ __forceinline__ unsigned xb_add(unsigned* p, unsigned v) { return __hip_atomic_fetch_add(p, v, __ATOMIC_RELAXED, __HIP_MEMORY_SCOPE_AGENT); }
__device__ __forceinline__ unsigned xb_xcc_id() { return (unsigned)__builtin_amdgcn_s_getreg((3 << 11) | 20) & 0xFu; }
#define XB_SPIN(cond, bar) do { unsigned _sp = 0; while (cond) { __builtin_amdgcn_s_sleep(1); \
    if ((++_sp & 255u) == 0u) { if (xb_ld(&(bar)[XB_TMO])) break; if (_sp > XB_SPIN_CAP) { atomicAdd(&(bar)[XB_TMO], 1u); break; } } } } while (0)
struct XcdBarrier { unsigned* bar; unsigned x; volatile LAS unsigned* st; };
__device__ __forceinline__ XcdBarrier xcd_barrier_post(unsigned* bar, volatile LAS unsigned* st) {
    XcdBarrier b; b.bar = bar; b.x = xb_xcc_id(); b.st = st;
    if (threadIdx.x == 0) st[4] = xb_add(&bar[XB_XCNT(b.x)], 1u);
    return b;
}
__device__ __forceinline__ void xcd_barrier_complete(unsigned* bar, unsigned x, unsigned& nloc, unsigned& nx, unsigned& even8) {
    const unsigned G = gridDim.x * gridDim.y * gridDim.z;
    unsigned sum, cnt, mine, sp = 0u;
    for (;;) {
        sum = 0u; cnt = 0u; mine = 0u;
#pragma unroll
        for (unsigned j = 0; j < 16; ++j) { const unsigned c = xb_ld(&bar[XB_XCNT(j)]); sum += c; cnt += (c > 0u) ? 1u : 0u; mine = (j == x) ? c : mine; }
        if (sum == G) break;
        __builtin_amdgcn_s_sleep(1);
        if ((++sp & 255u) == 0u) { if (xb_ld(&bar[XB_TMO])) break; if (sp > XB_SPIN_CAP) { atomicAdd(&bar[XB_TMO], 1u); break; } }
    }
    nloc = mine > 0u ? mine : 1u; nx = cnt > 0u ? cnt : 1u;
    unsigned eq = (cnt == 8u && sum == G) ? 1u : 0u;
#pragma unroll
    for (unsigned j = 0; j < 8; ++j) { if (xb_ld(&bar[XB_XCNT(j)]) * 8u != G) eq = 0u; }
    even8 = eq;
}
__device__ __forceinline__ void xcd_barrier(const XcdBarrier& b) {
    asm volatile("s_waitcnt vmcnt(0)" ::: "memory");
    __syncthreads();
    if (threadIdx.x == 0) {
        unsigned* bar = b.bar;
        __builtin_amdgcn_s_waitcnt(0);
        unsigned nloc = b.st[0], nx = b.st[1];
        if (nloc == 0u) { unsigned e8; xcd_barrier_complete(bar, b.x, nloc, nx, e8); b.st[0] = nloc; b.st[1] = nx; b.st[2] = e8; b.st[3] = e8 ? (b.x + 8u * b.st[4]) : blockIdx.x; }
        const unsigned old = xb_add(&bar[XB_XSUB(b.x)], 1u);
        const unsigned gen = old / nloc;
        if (old + 1u == (gen + 1u) * nloc) {
            __builtin_amdgcn_fence(__ATOMIC_RELEASE, "agent");
            asm volatile("s_waitcnt vmcnt(0)" ::: "memory");
            const unsigned og = xb_add(&bar[XB_TOP], 1u);
            const unsigned tg = og / nx;
            if (og + 1u == (tg + 1u) * nx) xb_add(&bar[XB_TOPGEN], 1u);
            else XB_SPIN(xb_ld(&bar[XB_TOPGEN]) == tg, bar);
            __builtin_amdgcn_fence(__ATOMIC_ACQUIRE, "agent");
            xb_add(&bar[XB_XGEN(b.x)], 1u);
            asm volatile("s_waitcnt vmcnt(0)" ::: "memory");
        } else {
            XB_SPIN(xb_ld(&bar[XB_XGEN(b.x)]) == gen, bar);
            __builtin_amdgcn_fence(__ATOMIC_ACQUIRE, "agent");
            asm volatile("s_waitcnt vmcnt(0)" ::: "memory");
        }
    }
    __syncthreads();
}

__device__ __forceinline__ void xcd_local_barrier(const XcdBarrier& b) {
    asm volatile("s_waitcnt vmcnt(0)" ::: "memory");
    __syncthreads();
    if (threadIdx.x == 0) {
        unsigned* bar = b.bar;
        __builtin_amdgcn_s_waitcnt(0);
        const unsigned nloc = b.st[0];
        const unsigned old = xb_add(&bar[XB_LSUB(b.x)], 1u);
        const unsigned gen = old / nloc;
        if (old + 1u == (gen + 1u) * nloc) xb_add(&bar[XB_LGEN(b.x)], 1u);
        else XB_SPIN(xb_ld(&bar[XB_LGEN(b.x)]) == gen, bar);
        __builtin_amdgcn_fence(__ATOMIC_ACQUIRE, "agent");
        asm volatile("s_waitcnt vmcnt(0)" ::: "memory");
    }
    __syncthreads();
}

#ifndef PHM
#define PHM 0xFFFF
#endif
#define PH(k) if constexpr ((PHM >> (k)) & 1)
#ifndef WGM_GU
#define WGM_GU 4
#endif
#ifndef WGM_IN
#define WGM_IN 4
#endif
#ifndef REPGU
#define REPGU 1
#endif
#ifndef REPIN
#define REPIN 1
#endif
#ifndef REPNC
#define REPNC 1
#endif
__global__ void __launch_bounds__(NWAVES * 64, 2) fwd_megakernel(Args ka) {
  extern __shared__ __attribute__((aligned(16))) unsigned char lds[];
  cg::grid_group grid = cg::this_grid();
  LAS unsigned char* ldsl = (LAS unsigned char*)lds;
  const int tid = threadIdx.x, lane = tid & 63, wave = __builtin_amdgcn_readfirstlane(tid >> 6);
  int G = gridDim.x, bid = blockIdx.x;
  int gw = bid * NWAVES + wave, NGW = G * NWAVES;
#define FRESH() do { asm volatile("" : "+s"(G), "+s"(bid), "+s"(gw), "+s"(NGW), "+s"(ws), "+s"(wb), "+s"(out), "+s"(XN), "+s"(Z), "+s"(H)); \
    ws = asglobal(ws); wb = asglobal(wb); out = asglobal(out); XN = asglobal(XN); Z = asglobal(Z); H = asglobal(H); } while (0)
  { LAS unsigned long long* pt = (LAS unsigned long long*)(ldsl + LDS_PTAB);
    if (tid == 0) {
#define PTS(k) pt[k] = (unsigned long long)ka.in[k]
      PTS(0); PTS(1); PTS(2); PTS(3); PTS(4); PTS(5); PTS(6); PTS(7); PTS(8); PTS(9); PTS(10); PTS(11); PTS(12); PTS(13); PTS(14); PTS(15); PTS(16); PTS(17); PTS(18); PTS(19); PTS(20);
#undef PTS
      pt[32] = 0ull; pt[33] = 0ull;
    } }
  if (blockIdx.x == 0) for (int i = tid; i < XCD_BAR_WORDS; i += NWAVES * 64) *(GAS unsigned*)((unsigned*)(ka.ws + WS_BAR) + i) = 0u;
  __syncthreads();
  unsigned char* ws = ka.ws; unsigned char* wb = ws + WS_WB;
  PT a; a.t = (LAS const unsigned long long*)(ldsl + LDS_PTAB); a.out = ka.out; a.ws = ka.ws;
  bf16_t* XN = (bf16_t*)(ws + WS_XN); bf16_t* Z = (bf16_t*)(ws + WS_Z); bf16_t* H = Z;
  float* out = a.out;
  PH(0) rope_tables(ws, bid * (NWAVES * 64) + tid, G * NWAVES * 64);
  XcdBarrier xbar; xbar.bar = (unsigned*)(ka.ws + WS_BAR); xbar.x = 0; xbar.st = (volatile LAS unsigned*)(ldsl + LDS_PTAB + 256);
#define GSYNC() do { xcd_barrier(xbar); FRESH(); a.ws = ws; a.out = out; } while (0)
#define LSYNC() do { if (xlocal) xcd_local_barrier(xbar); else xcd_barrier(xbar); FRESH(); a.ws = ws; a.out = out; } while (0)
  bool xlocal = false;
  float* SSa = (float*)(ws + WS_SS);
  PH(2) xb_init_rows(a.in(0), XN, SSa, (bid & 7) * SEQ, (bid >> 3) * NWAVES + wave, (G >> 3) * NWAVES, lane);
#pragma unroll 1
  for (int l = 0; l < DEPTH; ++l) {
    FRESH(); a.ws = ws; a.out = out;
    for (int rep_ = 0; rep_ < REPNC; ++rep_) { PH(1) convert_weights(a, l, ldsl, gw, NGW, wave, lane); }
    zero_f32((float*)(ws + WS_SS) + 2 * M, 4 * M, bid * (NWAVES * 64) + tid, G * NWAVES * 64);
    if (l == 0) { grid.sync(); xbar = xcd_barrier_post((unsigned*)(ka.ws + WS_BAR), (volatile LAS unsigned*)(ldsl + LDS_PTAB + 256)); xcd_barrier(xbar);
      bid = __builtin_amdgcn_readfirstlane((int)xbar.st[3]); gw = bid * NWAVES + wave; xlocal = false  ; FRESH(); a.ws = ws; a.out = out; }
    else GSYNC();
    for (int rep_ = 0; rep_ < REPGU; ++rep_) PH(3) { pg8::Gemm g{XN, (const bf16_t*)(wb + WB_GU1), M, 2 * DFF, DM, DM}; pg8::StaticOrder S; S.init(M, 2 * DFF, G, bid, WGM_GU); pg8::EpiSwiGLU E{H, DFF, (const float*)(ws + WS_SS)};
      pg8::gemm_phase(ldsl, g, S, E); }
    LSYNC();
    PH(4) { pg8::Gemm g{H, (const bf16_t*)(wb + WB_D1), M, DM, DFF, DFF}; pg8::StaticOrder S; S.init(M, DM, G, bid); pg8::EpiResid<1, WS_XN, WS_SS + (size_t)M * 8, false> E{out, ws};
      pg8::gemm_phase(ldsl, g, S, E); }
    LSYNC();
    for (int rep_ = 0; rep_ < REPIN; ++rep_) PH(5) { pg8::Gemm g{XN, (const bf16_t*)(wb + WB_IN), M, ZP, DM, DM}; pg8::StaticOrder S; S.init(M, ZP, G, bid, WGM_IN); pg8::EpiBf16 E{Z, ZP, (const float*)(ws + WS_SS + (size_t)M * 8)};
      pg8::gemm_phase(ldsl, g, S, E); }
    LSYNC();
    PH(6) prep_rows(a, l, (bid & 7) * SEQ, (bid >> 3) * NWAVES + wave, (G >> 3) * NWAVES, lane);
    { unsigned long long* ssa = (unsigned long long*)(ws + WS_SS) + (bid & 7) * SEQ;
      for (int i = (bid >> 3) * (NWAVES * 64) + tid; i < SEQ; i += (G >> 3) * (NWAVES * 64)) __hip_atomic_store(ssa + i, 0ull, __ATOMIC_RELAXED, __HIP_MEMORY_SCOPE_AGENT); }
    LSYNC();
    PH(5) { pg8::Gemm g{(const bf16_t*)(ws + WS_CQA), (const bf16_t*)(wb + WB_CQ), M, CQW, CQR, CQR}; pg8::StaticOrder S; S.init(M, CQW, G, bid); pg8::EpiBf16 E{(bf16_t*)(ws + WS_CQ), CQW, nullptr};
      pg8::gemm_phase(ldsl, g, S, E); }
    PH(5) { pg8::Gemm g{(const bf16_t*)(ws + WS_CKVA), (const bf16_t*)(wb + WB_CKV), M, CKVW, CKVR, CKVR}; pg8::StaticOrder S; S.init(M, CKVW, G, bid); pg8::EpiBf16 E{(bf16_t*)(ws + WS_CKV), CKVW, nullptr};
      pg8::gemm_phase(ldsl, g, S, E); }
    LSYNC();
    PH(7) cpost_rows(a, l, (bid & 7) * SEQ, (bid >> 3) * NWAVES + wave, (G >> 3) * NWAVES, lane);
    LSYNC();
    PH(8) attention_phase(a, (char*)lds, bid, G);
    LSYNC();
    PH(9) ynorm_rows(a, l, (bf16_t*)(ws + WS_CQ), (bid & 7) * SEQ, (bid >> 3) * NWAVES + wave, (G >> 3) * NWAVES, lane);
    LSYNC();
    PH(4) { pg8::Gemm g{(const bf16_t*)(ws + WS_CQ), (const bf16_t*)(wb + WB_OUT), M, DM, DM, DM}; pg8::StaticOrder S; S.init(M, DM, G, bid); pg8::EpiResid<2, WS_XN, WS_SS + (size_t)M * 16, false> E{out, ws};
      pg8::gemm_phase(ldsl, g, S, E); }
    LSYNC();
    for (int rep_ = 0; rep_ < REPGU; ++rep_) PH(3) { pg8::Gemm g{XN, (const bf16_t*)(wb + WB_GU2), M, 2 * DFF, DM, DM}; pg8::StaticOrder S; S.init(M, 2 * DFF, G, bid, WGM_GU); pg8::EpiSwiGLU E{H, DFF, (const float*)(ws + WS_SS + (size_t)M * 16)};
      pg8::gemm_phase(ldsl, g, S, E); }
    LSYNC();
    if (l + 1 < DEPTH) { pg8::Gemm g{H, (const bf16_t*)(wb + WB_D2), M, DM, DFF, DFF}; pg8::StaticOrder S; S.init(M, DM, G, bid); pg8::EpiResid<1, WS_XN, WS_SS, false> E{out, ws};
      pg8::gemm_phase(ldsl, g, S, E); }
    else { pg8::Gemm g{H, (const bf16_t*)(wb + WB_D2), M, DM, DFF, DFF}; pg8::StaticOrder S; S.init(M, DM, G, bid); pg8::EpiResid<1, WS_XN, WS_SS, true> E{out, ws};
      pg8::gemm_phase(ldsl, g, S, E); }
    if (l + 1 < DEPTH) GSYNC();
  }
}

extern "C" void kernel_launch(void* const* d_in, const int* in_sizes, int n_in, void* d_out, int out_size, void* d_ws, size_t ws_size, hipStream_t stream) {
  static int grid = 0;
  if (grid == 0) {
    if (n_in != 21 || in_sizes[0] != M * DM || out_size != M * DM || ws_size < WS_END) { fprintf(stderr, "kernel_launch: unexpected shapes (n_in %d, ws %zu)\n", n_in, ws_size); grid = -1; return; }
    int dev = 0, cus = 0, per_cu = 0;
    hipGetDevice(&dev); hipDeviceGetAttribute(&cus, hipDeviceAttributeMultiprocessorCount, dev);
    hipFuncSetAttribute((const void*)fwd_megakernel, hipFuncAttributeMaxDynamicSharedMemorySize, LDS_BYTES);
    hipOccupancyMaxActiveBlocksPerMultiprocessor(&per_cu, (const void*)fwd_megakernel, NWAVES * 64, LDS_BYTES);
    if (per_cu < 1) { fprintf(stderr, "kernel_launch: occupancy query says %d blocks per CU\n", per_cu); per_cu = 1; }
    (void)hipGetLastError();
    grid = cus * 1;
    grid -= grid % 8;
  }
  if (grid < 0) return;
  Args a{};
  for (int i = 0; i < 21; ++i) a.in[i] = (const float*)d_in[i];
  a.out = (float*)d_out; a.ws = (unsigned char*)d_ws;
  void* args[] = {&a};
  hipError_t e = hipLaunchCooperativeKernel((const void*)fwd_megakernel, dim3(grid), dim3(NWAVES * 64), args, LDS_BYTES, stream);
  if (e != hipSuccess) fprintf(stderr, "cooperative launch failed: %s (grid %d)\n", hipGetErrorString(e), grid);
}
```
